# Optimizing an MI355X kernel written in HIP

```python
import jax, jax.numpy as jnp
from jax import lax
import numpy as np

D_MODEL = 2048
BATCH = 2
SEQ = 16384
DEPTH = 2

CTX_LEN = 256
GRID_W = 64
N_MIXERS = 2
N_A = (DEPTH + N_MIXERS - 1) // N_MIXERS
N_B = DEPTH // N_MIXERS
EPS = 1e-6
D_RNN = D_MODEL
LRU_HEADS = 16
LRU_HEAD_DIM = D_RNN // LRU_HEADS
LRU_CONV_W = 4
LRU_CONV_PAD_LEFT = 2
LRU_C = 8.0
D_SC = D_MODEL
SC_CONV_W = 3
SC_CONV_PAD_LEFT = 1
PEER_HEADS = 8
PEER_N_KEYS = 128
PEER_EXPERTS = PEER_N_KEYS * PEER_N_KEYS
PEER_TOPK = 16
PEER_D_QUERY = 256
PEER_D_KEY = PEER_D_QUERY // 2
PEER_BLOCK = 128

kernel_name = 'hybrid_rglru_shortconv_peer_dit'


def rms_norm(x, g):
    xf = x.astype(jnp.float32)
    y = xf * lax.rsqrt(jnp.mean(xf * xf, axis=-1, keepdims=True) + EPS)
    return (y * g.astype(jnp.float32)).astype(x.dtype)


def modulate(h, shift, scale):
    return h * (1 + scale) + shift


def depthwise_conv(x, w, b, pad_left):
    k_w, length = w.shape[0], x.shape[-2]
    pad = [(0, 0)] * (x.ndim - 2) + [(pad_left, k_w - 1 - pad_left), (0, 0)]
    xp = jnp.pad(x, pad)
    y = b + w[0] * xp[..., 0:length, :]
    for k in range(1, k_w):
        y = y + w[k] * xp[..., k:k + length, :]
    return y


def grid_conv(x, w, b, pad_left):
    bsz, length, ch = x.shape
    rows = length // GRID_W
    y = depthwise_conv(x.reshape(bsz, rows, GRID_W, ch), w, b, pad_left)
    return y.reshape(bsz, length, ch)


def rglru_coeffs(xc, w_a, b_a, w_x, b_x, lam):
    bsz, length, ch = xc.shape
    xh = xc.reshape(bsz, length, LRU_HEADS, LRU_HEAD_DIM)
    r = jax.nn.sigmoid(jnp.einsum('blhd,hde->blhe', xh, w_a).reshape(bsz, length, ch) + b_a)
    i = jax.nn.sigmoid(jnp.einsum('blhd,hde->blhe', xh, w_x).reshape(bsz, length, ch) + b_x)
    log_a = -LRU_C * r.astype(jnp.float32) * jax.nn.softplus(-lam.astype(jnp.float32))
    a = jnp.exp(log_a)
    b = jnp.sqrt(-jnp.expm1(2.0 * log_a)) * (i * xc).astype(jnp.float32)
    return a, b


def _combine(e1, e2):
    a1, b1 = e1
    a2, b2 = e2
    return a1 * a2, a2 * b1 + b2


def linear_scan(a, b, h0, reverse):
    if h0 is not None:
        edge = -1 if reverse else 0
        b = b.at[:, edge].add(a[:, edge] * h0)
    _, h = lax.associative_scan(_combine, (a, b), reverse=reverse, axis=1)
    return h


def rglru_mixer(h_lat, h_ctx, w_in, conv_w, conv_b, w_a, b_a, w_x, b_x, lam, w_out):
    gate, xb = jnp.split(h_lat @ w_in, 2, axis=-1)
    xc = grid_conv(xb, conv_w, conv_b, LRU_CONV_PAD_LEFT)
    xc_ctx = depthwise_conv(h_ctx @ w_in[:, D_RNN:], conv_w, conv_b, LRU_CONV_PAD_LEFT)
    ys = []
    for d, reverse in enumerate((False, True)):
        a_c, b_c = rglru_coeffs(xc_ctx, w_a[d], b_a[d], w_x[d], b_x[d], lam[d])
        h_c = linear_scan(a_c, b_c, None, reverse)
        h0 = h_c[:, 0] if reverse else h_c[:, -1]
        a_l, b_l = rglru_coeffs(xc, w_a[d], b_a[d], w_x[d], b_x[d], lam[d])
        ys.append(linear_scan(a_l, b_l, h0, reverse))
    y = (ys[0] + ys[1]).astype(h_lat.dtype)
    return (jax.nn.gelu(gate) * y) @ w_out


def shortconv_mixer(h_lat, w_in, conv_w, conv_b, w_out):
    bg, cg, v = jnp.split(h_lat @ w_in, 3, axis=-1)
    return (bg * grid_conv(cg * v, conv_w, conv_b, SC_CONV_PAD_LEFT)) @ w_out


def peer_ffn(h, w_q, sub_keys, u, v):
    bsz, length, dm = h.shape
    blocks = h.reshape(-1, PEER_BLOCK, dm)

    def block(xt):
        q = (xt @ w_q).reshape(PEER_BLOCK, PEER_HEADS, 2, PEER_D_KEY)
        s = jnp.einsum('thpd,hpkd->thpk', q, sub_keys)
        sv, si = lax.top_k(s, PEER_TOPK)
        cand = sv[:, :, 0, :, None] + sv[:, :, 1, None, :]
        cv, ci = lax.top_k(cand.reshape(PEER_BLOCK, PEER_HEADS, PEER_TOPK * PEER_TOPK), PEER_TOPK)
        i1 = jnp.take_along_axis(si[:, :, 0], ci // PEER_TOPK, axis=-1)
        i2 = jnp.take_along_axis(si[:, :, 1], ci % PEER_TOPK, axis=-1)
        expert = i1 * PEER_N_KEYS + i2
        g = jax.nn.softmax(cv.astype(jnp.float32), axis=-1)
        ue = jnp.take(u, expert, axis=0)
        ve = jnp.take(v, expert, axis=0)
        act = jax.nn.gelu(jnp.einsum('thkd,td->thk', ue, xt).astype(jnp.float32))
        return jnp.einsum('thk,thkd->td', (g * act).astype(xt.dtype), ve)

    return lax.map(block, blocks).reshape(bsz, length, dm)


def setup_inputs(seed: int = 0) -> dict:
    key = jax.random.key(seed)
    ks = jax.random.split(key, 26)

    def nrm(k, shape, scale):
        return scale * jax.random.normal(k, shape, jnp.float32)

    a0 = jax.random.uniform(ks[16], (N_A, 2, D_RNN), jnp.float32, 0.9, 0.999)
    s0 = a0 ** (1.0 / LRU_C)
    lru_lambda = jnp.log(s0) - jnp.log1p(-s0)
    return {
        'x': nrm(ks[0], (BATCH, SEQ, D_MODEL), 1.0),
        'c': nrm(ks[1], (BATCH, D_MODEL), 1.0),
        'ctx': nrm(ks[2], (BATCH, CTX_LEN, D_MODEL), 1.0),
        'c_ctx': nrm(ks[3], (D_MODEL,), 1.0),
        'w_mod': nrm(ks[4], (DEPTH, D_MODEL, 6 * D_MODEL), 0.5 * D_MODEL ** -0.5),
        'b_mod': nrm(ks[5], (DEPTH, 6 * D_MODEL), 0.02),
        'norm_mix_g': 1.0 + nrm(ks[6], (DEPTH, D_MODEL), 0.02),
        'norm_ffn_g': 1.0 + nrm(ks[7], (DEPTH, D_MODEL), 0.02),
        'norm_final_g': 1.0 + nrm(ks[8], (D_MODEL,), 0.02),
        'lru_w_in': nrm(ks[9], (N_A, D_MODEL, 2 * D_RNN), D_MODEL ** -0.5),
        'lru_conv_w': nrm(ks[10], (N_A, LRU_CONV_W, D_RNN), LRU_CONV_W ** -0.5),
        'lru_conv_b': nrm(ks[11], (N_A, D_RNN), 0.02),
        'lru_w_a': nrm(ks[12], (N_A, 2, LRU_HEADS, LRU_HEAD_DIM, LRU_HEAD_DIM), LRU_HEAD_DIM ** -0.5),
        'lru_b_a': nrm(ks[13], (N_A, 2, D_RNN), 0.02),
        'lru_w_x': nrm(ks[14], (N_A, 2, LRU_HEADS, LRU_HEAD_DIM, LRU_HEAD_DIM), LRU_HEAD_DIM ** -0.5),
        'lru_b_x': nrm(ks[15], (N_A, 2, D_RNN), 0.02),
        'lru_lambda': lru_lambda,
        'lru_w_out': nrm(ks[17], (N_A, D_RNN, D_MODEL), D_RNN ** -0.5),
        'sc_w_in': nrm(ks[18], (N_B, D_MODEL, 3 * D_SC), D_MODEL ** -0.5),
        'sc_conv_w': nrm(ks[19], (N_B, SC_CONV_W, D_SC), SC_CONV_W ** -0.5),
        'sc_conv_b': nrm(ks[20], (N_B, D_SC), 0.02),
        'sc_w_out': nrm(ks[21], (N_B, D_SC, D_MODEL), D_SC ** -0.5),
        'peer_w_q': nrm(ks[22], (DEPTH, D_MODEL, PEER_HEADS * PEER_D_QUERY), D_MODEL ** -0.5),
        'peer_sub_keys': nrm(ks[23], (DEPTH, PEER_HEADS, 2, PEER_N_KEYS, PEER_D_KEY), PEER_D_KEY ** -0.5),
        'peer_u': nrm(ks[24], (DEPTH, PEER_EXPERTS, D_MODEL), D_MODEL ** -0.5),
        'peer_v': nrm(ks[25], (DEPTH, PEER_EXPERTS, D_MODEL), PEER_HEADS ** -0.5),
    }


def reference(x, c, ctx, c_ctx, w_mod, b_mod, norm_mix_g, norm_ffn_g, norm_final_g,
              lru_w_in, lru_conv_w, lru_conv_b, lru_w_a, lru_b_a, lru_w_x, lru_b_x, lru_lambda, lru_w_out,
              sc_w_in, sc_conv_w, sc_conv_b, sc_w_out,
              peer_w_q, peer_sub_keys, peer_u, peer_v):
    silu_c = jax.nn.silu(c)
    silu_c_ctx = jax.nn.silu(c_ctx)
    for i in range(DEPTH):
        mixer, j = i % N_MIXERS, i // N_MIXERS
        mod = (silu_c @ w_mod[i] + b_mod[i])[:, None, :]
        sh1, sc1, g1, sh2, sc2, g2 = jnp.split(mod, 6, axis=-1)
        h = modulate(rms_norm(x, norm_mix_g[i]), sh1, sc1)
        if mixer == 0:
            mod_c = silu_c_ctx @ w_mod[i] + b_mod[i]
            h_ctx = modulate(rms_norm(ctx, norm_mix_g[i]), mod_c[:D_MODEL], mod_c[D_MODEL:2 * D_MODEL])
            out = rglru_mixer(h, h_ctx, lru_w_in[j], lru_conv_w[j], lru_conv_b[j], lru_w_a[j], lru_b_a[j],
                              lru_w_x[j], lru_b_x[j], lru_lambda[j], lru_w_out[j])
        else:
            out = shortconv_mixer(h, sc_w_in[j], sc_conv_w[j], sc_conv_b[j], sc_w_out[j])
        x = x + g1 * out
        h = modulate(rms_norm(x, norm_ffn_g[i]), sh2, sc2)
        x = x + g2 * peer_ffn(h, peer_w_q[i], peer_sub_keys[i], peer_u[i], peer_v[i])
    return rms_norm(x, norm_final_g)
```

```cpp
#include <hip/hip_runtime.h>
#include <cstdio>
#include <cstdint>
namespace pg8 {
#define PG8_LAS __attribute__((address_space(3)))
typedef unsigned short bf16_t;
typedef short bf16x8 __attribute__((ext_vector_type(8)));
typedef float f32x4 __attribute__((ext_vector_type(4)));
typedef unsigned u32x4 __attribute__((ext_vector_type(4)));
typedef int i32x4 __attribute__((ext_vector_type(4)));
template <bool I8> struct AccSel { typedef f32x4 type; }; template <> struct AccSel<true> { typedef i32x4 type; };
constexpr int BM = 256, BK = 64, HALF = 128, HTB = HALF * BK * 2  , STAGE_BYTES = 8 * HTB, NXCD = 8, WGM = 8;

__host__ __device__ __forceinline__ int lds_byte(int r, int c) { const int st = (r >> 4) * 2 + (c >> 5), rr = r & 15, cc = c & 31, ob = rr * 64 + cc * 2; return st * 1024 + (ob ^ (((ob >> 9) & 1) << 5)); }
__host__ __device__ __forceinline__ void stage_rc(int b, int& R, int& C) { const int st = b / 1024, sb = b % 1024, swz = sb ^ (((sb >> 9) & 1) << 5); R = (st >> 1) * 16 + swz / 64; C = (st & 1) * 32 + (swz % 64) / 2; }
__host__ __device__ __forceinline__ int perm32(int rho) { const int n = rho >> 4, i = rho & 15; return 8 * (i >> 2) + 4 * n + (i & 3); }

struct Unit { int pm, pn; };
struct Gemm { const bf16_t* A; const bf16_t* Bt; int M, N, K; };

struct StaticOrder {
    int nM, nN, nwg, G, c;
    __host__ __device__ void init(int M, int N, int G_, int c_) { nM = M / BM; nN = N / BM; nwg = nM * nN; G = G_; c = c_; }
    __host__ __device__ bool next(int i, Unit& u) const {
        const long L = (long)i * G + c; if (L >= nwg) return false;
        int wgid = (int)L; { const int q = nwg / NXCD, r = nwg % NXCD, xcd = wgid % NXCD, off = wgid / NXCD; wgid = (xcd < r ? xcd * (q + 1) : r * (q + 1) + (xcd - r) * q) + off; }
        const int nig = WGM * nN, gid = wgid / nig, fm = gid * WGM, gsz = (nM - fm) < WGM ? (nM - fm) : WGM;
        u.pm = fm + ((wgid % nig) % gsz); u.pn = (wgid % nig) / gsz; return true;
    }
    __device__ __forceinline__ void a_ready(const Unit&) const {}
    __device__ __forceinline__ void done(const Unit&) const {}
};

typedef float f32x2 __attribute__((ext_vector_type(2)));
__device__ __forceinline__ unsigned cvt_pk_bf16(float lo, float hi) { unsigned r; asm volatile("v_cvt_pk_bf16_f32 %0, %1, %2" : "=v"(r) : "v"(lo), "v"(hi)); return r; }
__device__ __forceinline__ float gelu_tanh(float x) {
    const float e = __builtin_amdgcn_exp2f(-2.302208198f * x * (1.0f + 0.044715f * x * x));
    return x * __builtin_amdgcn_rcpf(1.0f + e);
}
struct EpiGateXb {
    static constexpr bool PERM = true, AFTER_DRAIN = false, I8 = false;
    bf16_t* GG; bf16_t* XB;
    __device__ __forceinline__ void operator()(const f32x4 (&acc)[2][2][4][2], const Unit& u, int wr, int wc, int fr, int fq) const {
        const int row0 = u.pm * BM + wr * 64 + fr; const bool is_gate = u.pn < 8;
        bf16_t* base = is_gate ? GG : XB; const int col0 = (u.pn & 7) * BM + wc * 32 + 8 * fq;
#pragma unroll
        for (int ai = 0; ai < 2; ++ai)
#pragma unroll
            for (int m = 0; m < 4; ++m) { bf16_t* rowp = base + (size_t)(row0 + ai * HALF + m * 16) * 2048 + col0;
#pragma unroll
                for (int bj = 0; bj < 2; ++bj) { f32x4 v0 = acc[ai][bj][m][0], v1 = acc[ai][bj][m][1];
                    if (is_gate) {
#pragma unroll
                        for (int j = 0; j < 4; ++j) { v0[j] = gelu_tanh(v0[j]); v1[j] = gelu_tanh(v1[j]); } }
                    u32x4 w; w.x = cvt_pk_bf16(v0[0], v0[1]); w.y = cvt_pk_bf16(v0[2], v0[3]); w.z = cvt_pk_bf16(v1[0], v1[1]); w.w = cvt_pk_bf16(v1[2], v1[3]);
                    *(u32x4*)(rowp + bj * HALF) = w; } }
    }
};
struct EpiGateXbI8 {
    static constexpr bool PERM = true, AFTER_DRAIN = false, I8 = true;
    bf16_t* GG; bf16_t* XB; const float* rs; const float* cs;
    __device__ __forceinline__ void operator()(const i32x4 (&acc)[2][2][4][2], const Unit& u, int wr, int wc, int fr, int fq) const {
        const int row0 = u.pm * BM + wr * 64 + fr; const bool is_gate = u.pn < 8;
        bf16_t* base = is_gate ? GG : XB; const int col0 = (u.pn & 7) * BM + wc * 32 + 8 * fq, ccol0 = u.pn * BM + wc * 32 + 8 * fq;
        f32x4 cv[2][2];
#pragma unroll
        for (int bj = 0; bj < 2; ++bj)
#pragma unroll
            for (int n = 0; n < 2; ++n) cv[bj][n] = *(const f32x4*)(cs + ccol0 + bj * HALF + 4 * n);
#pragma unroll
        for (int ai = 0; ai < 2; ++ai)
#pragma unroll
            for (int m = 0; m < 4; ++m) { const int row = row0 + ai * HALF + m * 16; const float r = rs[row]; bf16_t* rowp = base + (size_t)row * 2048 + col0;
#pragma unroll
                for (int bj = 0; bj < 2; ++bj) { f32x4 v0, v1;
#pragma unroll
                    for (int j = 0; j < 4; ++j) { v0[j] = (float)acc[ai][bj][m][0][j] * r * cv[bj][0][j]; v1[j] = (float)acc[ai][bj][m][1][j] * r * cv[bj][1][j]; }
                    if (is_gate) {
#pragma unroll
                        for (int j = 0; j < 4; ++j) { v0[j] = gelu_tanh(v0[j]); v1[j] = gelu_tanh(v1[j]); } }
                    u32x4 w; w.x = cvt_pk_bf16(v0[0], v0[1]); w.y = cvt_pk_bf16(v0[2], v0[3]); w.z = cvt_pk_bf16(v1[0], v1[1]); w.w = cvt_pk_bf16(v1[2], v1[3]);
                    *(u32x4*)(rowp + bj * HALF) = w; } }
    }
};
struct EpiPlainI8 {
    static constexpr bool PERM = true, AFTER_DRAIN = false, I8 = true;
    bf16_t* O; int ldc; const float* rs; const float* cs;
    __device__ __forceinline__ void operator()(const i32x4 (&acc)[2][2][4][2], const Unit& u, int wr, int wc, int fr, int fq) const {
        const int row0 = u.pm * BM + wr * 64 + fr; const int col0 = u.pn * BM + wc * 32 + 8 * fq;
        f32x4 cv[2][2];
#pragma unroll
        for (int bj = 0; bj < 2; ++bj)
#pragma unroll
            for (int n = 0; n < 2; ++n) cv[bj][n] = *(const f32x4*)(cs + col0 + bj * HALF + 4 * n);
#pragma unroll
        for (int ai = 0; ai < 2; ++ai)
#pragma unroll
            for (int m = 0; m < 4; ++m) { const int row = row0 + ai * HALF + m * 16; const float r = rs[row]; bf16_t* rowp = O + (size_t)row * ldc + col0;
#pragma unroll
                for (int bj = 0; bj < 2; ++bj) { f32x4 v0, v1;
#pragma unroll
                    for (int j = 0; j < 4; ++j) { v0[j] = (float)acc[ai][bj][m][0][j] * r * cv[bj][0][j]; v1[j] = (float)acc[ai][bj][m][1][j] * r * cv[bj][1][j]; }
                    u32x4 w; w.x = cvt_pk_bf16(v0[0], v0[1]); w.y = cvt_pk_bf16(v0[2], v0[3]); w.z = cvt_pk_bf16(v1[0], v1[1]); w.w = cvt_pk_bf16(v1[2], v1[3]);
                    *(u32x4*)(rowp + bj * HALF) = w; } }
    }
};
struct EpiRawI8 {
    static constexpr bool PERM = true, AFTER_DRAIN = false, I8 = true;
    bf16_t* O; int ldc;
    __device__ __forceinline__ void operator()(const i32x4 (&acc)[2][2][4][2], const Unit& u, int wr, int wc, int fr, int fq) const {
        const int row0 = u.pm * BM + wr * 64 + fr; const int col0 = u.pn * BM + wc * 32 + 8 * fq;
#pragma unroll
        for (int ai = 0; ai < 2; ++ai)
#pragma unroll
            for (int m = 0; m < 4; ++m) { bf16_t* rowp = O + (size_t)(row0 + ai * HALF + m * 16) * ldc + col0;
#pragma unroll
                for (int bj = 0; bj < 2; ++bj) { u32x4 w;
                    w.x = cvt_pk_bf16((float)acc[ai][bj][m][0][0], (float)acc[ai][bj][m][0][1]); w.y = cvt_pk_bf16((float)acc[ai][bj][m][0][2], (float)acc[ai][bj][m][0][3]);
                    w.z = cvt_pk_bf16((float)acc[ai][bj][m][1][0], (float)acc[ai][bj][m][1][1]); w.w = cvt_pk_bf16((float)acc[ai][bj][m][1][2], (float)acc[ai][bj][m][1][3]);
                    *(u32x4*)(rowp + bj * HALF) = w; } }
    }
};
struct EpiCvI8 {
    static constexpr bool PERM = true, AFTER_DRAIN = false, I8 = true;
    bf16_t* CV; const float* rs; const float* cs;
    __device__ __forceinline__ void operator()(const i32x4 (&acc)[2][2][4][2], const Unit& u, int wr, int wc, int fr, int fq) const {
        const int row0 = u.pm * BM + wr * 64 + fr; const int col0 = u.pn * HALF + wc * 32 + 8 * fq, ccol0 = u.pn * BM + wc * 32 + 8 * fq;
        f32x4 cv[2][2];
#pragma unroll
        for (int bj = 0; bj < 2; ++bj)
#pragma unroll
            for (int n = 0; n < 2; ++n) cv[bj][n] = *(const f32x4*)(cs + ccol0 + bj * HALF + 4 * n);
#pragma unroll
        for (int ai = 0; ai < 2; ++ai)
#pragma unroll
            for (int m = 0; m < 4; ++m) { const int row = row0 + ai * HALF + m * 16; const float r = rs[row], r2 = r * r; bf16_t* rowp = CV + (size_t)row * 2048 + col0;
                f32x4 v0, v1;
#pragma unroll
                for (int j = 0; j < 4; ++j) { v0[j] = ((float)acc[ai][0][m][0][j] * cv[0][0][j]) * ((float)acc[ai][1][m][0][j] * cv[1][0][j]) * r2;
                                              v1[j] = ((float)acc[ai][0][m][1][j] * cv[0][1][j]) * ((float)acc[ai][1][m][1][j] * cv[1][1][j]) * r2; }
                u32x4 w; w.x = cvt_pk_bf16(v0[0], v0[1]); w.y = cvt_pk_bf16(v0[2], v0[3]); w.z = cvt_pk_bf16(v1[0], v1[1]); w.w = cvt_pk_bf16(v1[2], v1[3]);
                *(u32x4*)rowp = w; }
    }
};
struct EpiResidI8 {
    static constexpr bool PERM = true, AFTER_DRAIN = false, I8 = true;
    const bf16_t* baseh; bf16_t* out; const float* gvec; int gstride; const float* rs; const float* cs;
    __device__ __forceinline__ void operator()(const i32x4 (&acc)[2][2][4][2], const Unit& u, int wr, int wc, int fr, int fq) const {
        const int row0 = u.pm * BM + wr * 64 + fr, col0 = u.pn * BM + wc * 32 + 8 * fq; const int b = u.pm >> 6;
        f32x4 gv[2][2];
#pragma unroll
        for (int bj = 0; bj < 2; ++bj)
#pragma unroll
            for (int n = 0; n < 2; ++n) gv[bj][n] = *(const f32x4*)(gvec + (size_t)b * gstride + col0 + bj * HALF + n * 4) * *(const f32x4*)(cs + col0 + bj * HALF + n * 4);
#pragma unroll
        for (int ai = 0; ai < 2; ++ai)
#pragma unroll
            for (int m = 0; m < 4; ++m) { const int row = row0 + ai * HALF + m * 16; const float r = rs[row]; const size_t off = (size_t)row * 2048 + col0;
#pragma unroll
                for (int bj = 0; bj < 2; ++bj) { const u32x4 bb = *(const u32x4*)(baseh + off + bj * HALF); f32x4 o0, o1;
                    o0[0] = __uint_as_float(bb.x << 16) + gv[bj][0][0] * (r * (float)acc[ai][bj][m][0][0]); o0[1] = __uint_as_float(bb.x & 0xffff0000u) + gv[bj][0][1] * (r * (float)acc[ai][bj][m][0][1]);
                    o0[2] = __uint_as_float(bb.y << 16) + gv[bj][0][2] * (r * (float)acc[ai][bj][m][0][2]); o0[3] = __uint_as_float(bb.y & 0xffff0000u) + gv[bj][0][3] * (r * (float)acc[ai][bj][m][0][3]);
                    o1[0] = __uint_as_float(bb.z << 16) + gv[bj][1][0] * (r * (float)acc[ai][bj][m][1][0]); o1[1] = __uint_as_float(bb.z & 0xffff0000u) + gv[bj][1][1] * (r * (float)acc[ai][bj][m][1][1]);
                    o1[2] = __uint_as_float(bb.w << 16) + gv[bj][1][2] * (r * (float)acc[ai][bj][m][1][2]); o1[3] = __uint_as_float(bb.w & 0xffff0000u) + gv[bj][1][3] * (r * (float)acc[ai][bj][m][1][3]);
                    u32x4 w; w.x = cvt_pk_bf16(o0[0], o0[1]); w.y = cvt_pk_bf16(o0[2], o0[3]); w.z = cvt_pk_bf16(o1[0], o1[1]); w.w = cvt_pk_bf16(o1[2], o1[3]);
                    *(u32x4*)(out + off + bj * HALF) = w; } }
    }
};
struct EpiPlainBf16 {
    static constexpr bool PERM = true, AFTER_DRAIN = false, I8 = false;
    bf16_t* O; int ldc;
    __device__ __forceinline__ void operator()(const f32x4 (&acc)[2][2][4][2], const Unit& u, int wr, int wc, int fr, int fq) const {
        const int row0 = u.pm * BM + wr * 64 + fr; const int col0 = u.pn * BM + wc * 32 + 8 * fq;
#pragma unroll
        for (int ai = 0; ai < 2; ++ai)
#pragma unroll
            for (int m = 0; m < 4; ++m) { bf16_t* rowp = O + (size_t)(row0 + ai * HALF + m * 16) * ldc + col0;
#pragma unroll
                for (int bj = 0; bj < 2; ++bj) { const f32x4 v0 = acc[ai][bj][m][0], v1 = acc[ai][bj][m][1];
                    u32x4 w; w.x = cvt_pk_bf16(v0[0], v0[1]); w.y = cvt_pk_bf16(v0[2], v0[3]); w.z = cvt_pk_bf16(v1[0], v1[1]); w.w = cvt_pk_bf16(v1[2], v1[3]);
                    *(u32x4*)(rowp + bj * HALF) = w; } }
    }
};
struct EpiCv {
    static constexpr bool PERM = true, AFTER_DRAIN = false, I8 = false;
    bf16_t* CV;
    __device__ __forceinline__ void operator()(const f32x4 (&acc)[2][2][4][2], const Unit& u, int wr, int wc, int fr, int fq) const {
        const int row0 = u.pm * BM + wr * 64 + fr; const int col0 = u.pn * HALF + wc * 32 + 8 * fq;
#pragma unroll
        for (int ai = 0; ai < 2; ++ai)
#pragma unroll
            for (int m = 0; m < 4; ++m) { bf16_t* rowp = CV + (size_t)(row0 + ai * HALF + m * 16) * 2048 + col0;
                const f32x4 v0 = acc[ai][0][m][0] * acc[ai][1][m][0], v1 = acc[ai][0][m][1] * acc[ai][1][m][1];
                u32x4 w; w.x = cvt_pk_bf16(v0[0], v0[1]); w.y = cvt_pk_bf16(v0[2], v0[3]); w.z = cvt_pk_bf16(v1[0], v1[1]); w.w = cvt_pk_bf16(v1[2], v1[3]);
                *(u32x4*)rowp = w; }
    }
};
template <bool BASE_F32> struct EpiResidBf {
    static constexpr bool PERM = true, AFTER_DRAIN = false, I8 = false;
    const float* basef; const bf16_t* baseh; bf16_t* out; const float* gvec; int gstride;
    __device__ __forceinline__ void operator()(const f32x4 (&acc)[2][2][4][2], const Unit& u, int wr, int wc, int fr, int fq) const {
        const int row0 = u.pm * BM + wr * 64 + fr, col0 = u.pn * BM + wc * 32 + 8 * fq; const int b = u.pm >> 6;
        f32x4 gv[2][2];
#pragma unroll
        for (int bj = 0; bj < 2; ++bj)
#pragma unroll
            for (int n = 0; n < 2; ++n) gv[bj][n] = *(const f32x4*)(gvec + (size_t)b * gstride + col0 + bj * HALF + n * 4);
#pragma unroll
        for (int ai = 0; ai < 2; ++ai)
#pragma unroll
            for (int m = 0; m < 4; ++m) { const size_t off = (size_t)(row0 + ai * HALF + m * 16) * 2048 + col0;
#pragma unroll
                for (int bj = 0; bj < 2; ++bj) { f32x4 b0, b1;
                    if (BASE_F32) { b0 = *(const f32x4*)(basef + off + bj * HALF); b1 = *(const f32x4*)(basef + off + bj * HALF + 4); }
                    else { const u32x4 bb = *(const u32x4*)(baseh + off + bj * HALF);
                        b0 = (f32x4){__uint_as_float(bb.x << 16), __uint_as_float(bb.x & 0xffff0000u), __uint_as_float(bb.y << 16), __uint_as_float(bb.y & 0xffff0000u)};
                        b1 = (f32x4){__uint_as_float(bb.z << 16), __uint_as_float(bb.z & 0xffff0000u), __uint_as_float(bb.w << 16), __uint_as_float(bb.w & 0xffff0000u)}; }
                    const f32x4 o0 = b0 + gv[bj][0] * acc[ai][bj][m][0], o1 = b1 + gv[bj][1] * acc[ai][bj][m][1];
                    u32x4 w; w.x = cvt_pk_bf16(o0[0], o0[1]); w.y = cvt_pk_bf16(o0[2], o0[3]); w.z = cvt_pk_bf16(o1[0], o1[1]); w.w = cvt_pk_bf16(o1[2], o1[3]);
                    *(u32x4*)(out + off + bj * HALF) = w; } }
    }
};


template <class Epi, class Sched, bool ALIGN_EPI = false, bool SP2 = false>
__device__ __forceinline__ void gemm_phase(PG8_LAS unsigned char* lds, const Gemm g, const Sched& S, const Epi& E) {
    const int tid = threadIdx.x, wid = __builtin_amdgcn_readfirstlane(tid >> 6), lane = tid & 63, wr = wid >> 2, wc = wid & 3, fr = lane & 15, fq = lane >> 4;
    const int K = g.K, nt = K / BK;
    unsigned voffA[2], voffB[2];
#pragma unroll
    for (int i = 0; i < 2; ++i) { int R, C; stage_rc(tid * 16 + i * 8192, R, C); const int Rb = Epi::PERM ? ((R & ~31) + perm32(R & 31)) : R;
        voffA[i] = (unsigned)(R * K + C) * 2u; voffB[i] = (unsigned)(Rb * K + C) * 2u; }
    const size_t kstep = (size_t)(BK * 2);
    const size_t hstep = (size_t)HALF * K * 2;
    const size_t tstep = 2 * hstep;
    const unsigned ldsw = (unsigned)wid * 1024u;
    const int aoff = lds_byte(wr * 64 + fr, fq * 8), boff = lds_byte(wc * 32 + fr, fq * 8);
#define PG8_SA(b, h) (((b) * 2 + (h)) * HTB)
#define PG8_SB(b, h) ((4 + (b) * 2 + (h)) * HTB)
#define PG8_STAGE(bufoff, gbase, voff) do { _Pragma("unroll") for (int _i = 0; _i < 2; ++_i) \
        __builtin_amdgcn_global_load_lds((const unsigned*)((const char*)(gbase) + (voff)[_i]), (PG8_LAS unsigned*)(lds + (bufoff) + ldsw + _i * 8192), 16, 0, 0); } while (0)
#define PG8_LDA(dst, b, h) do { _Pragma("unroll") for (int m = 0; m < 4; ++m) _Pragma("unroll") for (int k = 0; k < 2; ++k) dst[m][k] = *(const PG8_LAS bf16x8*)(lds + PG8_SA(b, h) + aoff + m * 2048 + k * 1024); } while (0)
#define PG8_LDB(dst, b, h) do { _Pragma("unroll") for (int n = 0; n < 2; ++n) _Pragma("unroll") for (int k = 0; k < 2; ++k) dst[n][k] = *(const PG8_LAS bf16x8*)(lds + PG8_SB(b, h) + boff + n * 2048 + k * 1024); } while (0)
#define PG8_MMA(ai, bj, At, Bt) do { __builtin_amdgcn_s_setprio(1); _Pragma("unroll") for (int m = 0; m < 4; ++m) _Pragma("unroll") for (int n = 0; n < 2; ++n) _Pragma("unroll") for (int k = 0; k < 2; ++k) \
        { if constexpr (Epi::I8) acc[ai][bj][m][n] = __builtin_amdgcn_mfma_i32_16x16x64_i8(__builtin_bit_cast(i32x4, Bt[n][k]), __builtin_bit_cast(i32x4, At[m][k]), acc[ai][bj][m][n], 0, 0, 0); \
          else acc[ai][bj][m][n] = __builtin_amdgcn_mfma_f32_16x16x32_bf16(Bt[n][k], At[m][k], acc[ai][bj][m][n], 0, 0, 0); } __builtin_amdgcn_s_setprio(0); } while (0)
#define PG8_WAIT_V(n) asm volatile("s_waitcnt vmcnt(" #n ")" ::: "memory")
#define PG8_WAIT_L(n) asm volatile("s_waitcnt lgkmcnt(" #n ")" ::: "memory")
#define PG8_BAR __builtin_amdgcn_s_barrier()
#define PG8_SCHED __builtin_amdgcn_sched_barrier(0)
    Unit cur, nxt; int ui = 0;
    if (!S.next(0, cur)) return;
    typedef typename AccSel<Epi::I8>::type acc_t;
    acc_t acc[2][2][4][2];
#pragma unroll
    for (int a = 0; a < 2; ++a)
#pragma unroll
        for (int b = 0; b < 2; ++b)
#pragma unroll
            for (int m = 0; m < 4; ++m)
#pragma unroll
                for (int n = 0; n < 2; ++n) acc[a][b][m][n] = (acc_t){0, 0, 0, 0};
    bf16x8 At[4][2], B0[2][2], B1[2][2];
    const char* cA = (const char*)g.A + (size_t)cur.pm * tstep; const char* cB = (const char*)g.Bt + (size_t)cur.pn * tstep;
    S.a_ready(cur);
    if constexpr (SP2) {
        PG8_STAGE(PG8_SB(0, 0), cB, voffB); PG8_STAGE(PG8_SB(0, 1), cB + hstep, voffB); PG8_STAGE(PG8_SA(0, 0), cA, voffA); PG8_STAGE(PG8_SA(0, 1), cA + hstep, voffA);
        if (wr == 1) PG8_BAR;
        PG8_WAIT_V(2); PG8_BAR;
        PG8_STAGE(PG8_SB(1, 0), cB + kstep, voffB); PG8_STAGE(PG8_SA(1, 0), cA + kstep, voffA); PG8_STAGE(PG8_SB(1, 1), cB + hstep + kstep, voffB);
        PG8_WAIT_V(6); PG8_BAR;
    } else {
        PG8_STAGE(PG8_SB(0, 0), cB, voffB); PG8_STAGE(PG8_SA(0, 0), cA, voffA); PG8_STAGE(PG8_SB(0, 1), cB + hstep, voffB); PG8_STAGE(PG8_SA(0, 1), cA + hstep, voffA);
        if (wr == 1) PG8_BAR;
        PG8_WAIT_V(4); PG8_BAR;
        PG8_STAGE(PG8_SB(1, 0), cB + kstep, voffB); PG8_STAGE(PG8_SA(1, 0), cA + kstep, voffA); PG8_STAGE(PG8_SB(1, 1), cB + hstep + kstep, voffB);
        PG8_WAIT_V(6); PG8_BAR;
    }
    for (;;) {
        const bool has_next = S.next(ui + 1, nxt);
        const char* nA = has_next ? (const char*)g.A + (size_t)nxt.pm * tstep : cA; const char* nB = has_next ? (const char*)g.Bt + (size_t)nxt.pn * tstep : cB;
        for (int t = 0; t < nt; t += 2) {
            const bool last = (t == nt - 2);
            const char* a1 = cA + (size_t)(t + 1) * kstep;
            const char* a2 = last ? nA : cA + (size_t)(t + 2) * kstep; const char* b2 = last ? nB : cB + (size_t)(t + 2) * kstep;
            const char* a3 = a2 + kstep; const char* b3 = b2 + kstep;
            if (last && has_next) S.a_ready(nxt);
            if constexpr (SP2) {
            PG8_LDB(B0, 0, 0); PG8_LDB(B1, 0, 1); PG8_SCHED; PG8_LDA(At, 0, 0); PG8_STAGE(PG8_SA(1, 1), a1 + hstep, voffA);
            PG8_WAIT_V(8); PG8_WAIT_L(0); PG8_BAR; PG8_MMA(0, 0, At, B0); PG8_MMA(0, 1, At, B1); PG8_BAR; PG8_SCHED;
            PG8_LDA(At, 0, 1); PG8_STAGE(PG8_SB(0, 0), b2, voffB); PG8_STAGE(PG8_SB(0, 1), b2 + hstep, voffB); PG8_STAGE(PG8_SA(0, 0), a2, voffA);
            PG8_WAIT_V(8); PG8_WAIT_L(0); PG8_BAR; PG8_MMA(1, 0, At, B0); PG8_MMA(1, 1, At, B1); PG8_BAR; PG8_SCHED;
            PG8_LDB(B0, 1, 0); PG8_LDB(B1, 1, 1); PG8_SCHED; PG8_LDA(At, 1, 0); PG8_STAGE(PG8_SA(0, 1), a2 + hstep, voffA);
            PG8_WAIT_V(8); PG8_WAIT_L(0); PG8_BAR; PG8_MMA(0, 0, At, B0); PG8_MMA(0, 1, At, B1); PG8_BAR; PG8_SCHED;
            PG8_LDA(At, 1, 1); PG8_STAGE(PG8_SB(1, 0), b3, voffB); PG8_STAGE(PG8_SB(1, 1), b3 + hstep, voffB); PG8_STAGE(PG8_SA(1, 0), a3, voffA);
            PG8_WAIT_V(8); PG8_WAIT_L(0); PG8_BAR; PG8_MMA(1, 0, At, B0); PG8_MMA(1, 1, At, B1); PG8_BAR; PG8_SCHED;
            } else {
            PG8_LDB(B0, 0, 0); PG8_SCHED; PG8_LDA(At, 0, 0); PG8_STAGE(PG8_SA(1, 1), a1 + hstep, voffA);
            PG8_WAIT_L(8); PG8_BAR; PG8_WAIT_L(0); PG8_MMA(0, 0, At, B0); PG8_BAR; PG8_SCHED;
            PG8_LDB(B1, 0, 1); PG8_STAGE(PG8_SB(0, 0), b2, voffB);
            PG8_BAR; PG8_WAIT_L(0); PG8_MMA(0, 1, At, B1); PG8_BAR;
            PG8_LDA(At, 0, 1); PG8_STAGE(PG8_SA(0, 0), a2, voffA);
            PG8_BAR; PG8_WAIT_L(0); PG8_MMA(1, 0, At, B0); PG8_BAR; PG8_SCHED;
            PG8_STAGE(PG8_SB(0, 1), b2 + hstep, voffB);
            PG8_WAIT_V(6); PG8_BAR; PG8_MMA(1, 1, At, B1); PG8_BAR;
            PG8_LDB(B0, 1, 0); PG8_SCHED; PG8_LDA(At, 1, 0); PG8_STAGE(PG8_SA(0, 1), a2 + hstep, voffA);
            PG8_WAIT_L(8); PG8_BAR; PG8_WAIT_L(0); PG8_MMA(0, 0, At, B0); PG8_BAR; PG8_SCHED;
            PG8_LDB(B1, 1, 1); PG8_STAGE(PG8_SB(1, 0), b3, voffB);
            PG8_BAR; PG8_WAIT_L(0); PG8_MMA(0, 1, At, B1); PG8_BAR;
            PG8_LDA(At, 1, 1); PG8_STAGE(PG8_SA(1, 0), a3, voffA);
            PG8_BAR; PG8_WAIT_L(0); PG8_MMA(1, 0, At, B0); PG8_BAR; PG8_SCHED;
            PG8_STAGE(PG8_SB(1, 1), b3 + hstep, voffB);
            PG8_WAIT_V(6); PG8_BAR; PG8_MMA(1, 1, At, B1); PG8_BAR;
            }
        }
        if constexpr (ALIGN_EPI) { if (wr == 0) PG8_BAR; }
        if constexpr (!Epi::AFTER_DRAIN) { E(acc, cur, wr, wc, fr, fq); S.done(cur); }
        if (!has_next) break;
#pragma unroll
        for (int a = 0; a < 2; ++a)
#pragma unroll
            for (int b = 0; b < 2; ++b)
#pragma unroll
                for (int m = 0; m < 4; ++m)
#pragma unroll
                    for (int n = 0; n < 2; ++n) acc[a][b][m][n] = (acc_t){0, 0, 0, 0};
        cur = nxt; cA = nA; cB = nB; ++ui;
        if constexpr (ALIGN_EPI) { if (wr == 1) PG8_BAR; }
    }
    PG8_WAIT_V(0);
    if constexpr (!ALIGN_EPI) { if (wr == 0) PG8_BAR; }
    PG8_BAR;
    if constexpr (Epi::AFTER_DRAIN) { E.fused(acc, cur, wr, wc, fr, fq, lds, wid, lane); S.done(cur); }
#undef PG8_SA
#undef PG8_SB
#undef PG8_STAGE
#undef PG8_LDA
#undef PG8_LDB
#undef PG8_MMA
#undef PG8_WAIT_V
#undef PG8_WAIT_L
#undef PG8_BAR
#undef PG8_SCHED
}
}
#define XB_TMO      128
#define XB_XCNT(j)  (256  + 64 * (j))
#define XB_XSUB(j)  (1280 + 64 * (j))
#define XB_XGEN(j)  (2304 + 64 * (j))
#define XB_TOP      3328
#define XB_TOPGEN   3392
#define XCD_BAR_WORDS 3456
#define XB_SPIN_CAP (1u << 18)
#define LAS __attribute__((address_space(3)))

__device__ __forceinline__ unsigned xb_ld(unsigned* p)              { return __hip_atomic_load(p, __ATOMIC_RELAXED, __HIP_MEMORY_SCOPE_AGENT); }
__device__ __forceinline__ unsigned xb_add(unsigned* p, unsigned v) { return __hip_atomic_fetch_add(p, v, __ATOMIC_RELAXED, __HIP_MEMORY_SCOPE_AGENT); }
__device__ __forceinline__ unsigned xb_xcc_id() { return (unsigned)__builtin_amdgcn_s_getreg((3 << 11) | 20) & 0xFu; }
#define XB_SPIN(cond, bar) do { unsigned _sp = 0; while (cond) { __builtin_amdgcn_s_sleep(1); \
    if ((++_sp & 255u) == 0u) { if (xb_ld(&(bar)[XB_TMO])) break; if (_sp > XB_SPIN_CAP) { atomicAdd(&(bar)[XB_TMO], 1u); break; } } } } while (0)

struct XcdBarrier {
    unsigned* bar; unsigned x;
    volatile LAS unsigned* st;
};

__device__ __forceinline__ XcdBarrier xcd_barrier_post(unsigned* bar, volatile LAS unsigned* st) {
    XcdBarrier b; b.bar = bar; b.x = xb_xcc_id(); b.st = st;
    if (threadIdx.x == 0) (void)xb_add(&bar[XB_XCNT(b.x)], 1u);
    return b;
}
__device__ __forceinline__ void xcd_barrier_complete(unsigned* bar, unsigned x, unsigned& nloc, unsigned& nx) {
    const unsigned G = gridDim.x * gridDim.y * gridDim.z;
    unsigned sum, cnt, mine, sp = 0u;
    for (;;) {
        sum = 0u; cnt = 0u; mine = 0u;
#pragma unroll
        for (unsigned j = 0; j < 16; ++j) { const unsigned c = xb_ld(&bar[XB_XCNT(j)]); sum += c; cnt += (c > 0u) ? 1u : 0u; mine = (j == x) ? c : mine; }
        if (sum == G) break;
        __builtin_amdgcn_s_sleep(1);
        if ((++sp & 255u) == 0u) { if (xb_ld(&bar[XB_TMO])) break; if (sp > XB_SPIN_CAP) { atomicAdd(&bar[XB_TMO], 1u); break; } }
    }
    nloc = mine > 0u ? mine : 1u; nx = cnt > 0u ? cnt : 1u;
}

__device__ __forceinline__ void xcd_barrier(const XcdBarrier& b) {
    asm volatile("s_waitcnt vmcnt(0)" ::: "memory");
    __syncthreads();
    if (threadIdx.x == 0) {
        unsigned* bar = b.bar;
        __builtin_amdgcn_s_waitcnt(0);
        unsigned nloc = b.st[0], nx = b.st[1];
        if (nloc == 0u) { xcd_barrier_complete(bar, b.x, nloc, nx); b.st[0] = nloc; b.st[1] = nx; }
        const unsigned old = xb_add(&bar[XB_XSUB(b.x)], 1u);
        const unsigned gen = old / nloc;
        if (old + 1u == (gen + 1u) * nloc) {
            __builtin_amdgcn_fence(__ATOMIC_RELEASE, "agent");
            asm volatile("s_waitcnt vmcnt(0)" ::: "memory");
            const unsigned og = xb_add(&bar[XB_TOP], 1u);
            const unsigned tg = og / nx;
            if (og + 1u == (tg + 1u) * nx) xb_add(&bar[XB_TOPGEN], 1u);
            else XB_SPIN(xb_ld(&bar[XB_TOPGEN]) == tg, bar);
            __builtin_amdgcn_fence(__ATOMIC_ACQUIRE, "agent");
            xb_add(&bar[XB_XGEN(b.x)], 1u);
            asm volatile("s_waitcnt vmcnt(0)" ::: "memory");
        } else {
            XB_SPIN(xb_ld(&bar[XB_XGEN(b.x)]) == gen, bar);
            __builtin_amdgcn_fence(__ATOMIC_ACQUIRE, "agent");
            asm volatile("s_waitcnt vmcnt(0)" ::: "memory");
        }
    }
    __syncthreads();
}
constexpr int D = 2048, NBATCH = 2, SEQ = 16384, T = NBATCH * SEQ, CTXL = 256, TC = NBATCH * CTXL;
constexpr float EPS = 1e-6f;
constexpr int NTHREADS = 512, NWAVES = 8;
constexpr float LOG2E = 1.4426950408889634f;

constexpr size_t MiB = 1u << 20;
constexpr size_t WS_CTL = 0, CTL_BYTES = 1 * MiB;
constexpr size_t WS_MOD = 1 * MiB;
constexpr size_t WS_MODC = WS_MOD + 256 * 1024;
constexpr size_t WS_SUMA = 2 * MiB;
constexpr size_t WS_SUMB = WS_SUMA + 256 * 1024;
constexpr size_t WS_CSA = WS_SUMA + 576 * 1024, WS_CSB = WS_SUMA + 704 * 1024;
constexpr size_t WS_H0 = WS_SUMA + 512 * 1024;
constexpr size_t WS_GW = 3 * MiB;
constexpr size_t WS_KEYS = 5 * MiB;
constexpr size_t WS_WIN0 = 6 * MiB, WS_WOUT0 = 22 * MiB, WS_WIN1 = 30 * MiB, WS_WOUT1 = 54 * MiB, WS_WQ = 62 * MiB;
constexpr size_t WS_HC = 78 * MiB, WS_XBC = 80 * MiB, WS_IDX = 82 * MiB, WS_GATE = 98 * MiB;
constexpr size_t WS_SCL = 114 * MiB;
constexpr size_t WS_U = 128 * MiB, WS_V = 192 * MiB;
constexpr size_t WS_H = 384 * MiB, WS_GG = 512 * MiB, WS_XB = 640 * MiB, WS_XR = 768 * MiB  , WS_END = 896 * MiB;
constexpr size_t WS_WE = WS_XB + 96 * MiB;
constexpr size_t WS_WSC = WS_XB + 112 * MiB;
constexpr size_t WS_HQ = WS_XB;
constexpr size_t WS_ENT = 480 * MiB;
constexpr size_t WS_POS = WS_XB + 80 * MiB;
constexpr size_t WS_HSC = WS_XB + 113 * MiB;
constexpr size_t WS_SEG = WS_XB + 114 * MiB;
constexpr size_t WS_PART = 256 * MiB;
constexpr int POOLU = 20480;
constexpr int NPOOL = (T / 128) * POOLU;
constexpr size_t WS_HSA = 115 * MiB;
constexpr size_t WS_CS0 = 116 * MiB;
constexpr size_t WS_WIN0C = WS_WIN0 + 8 * MiB;
constexpr int CW_BAR = 4096;

constexpr int SCRATCH_BYTES = 131072, MISC_OFF = SCRATCH_BYTES, LDS_BYTES = 147456;

#define LAS __attribute__((address_space(3)))
using pg8::bf16_t; using pg8::bf16x8; using pg8::f32x4; using pg8::u32x4;
typedef unsigned u32x2 __attribute__((ext_vector_type(2)));
struct __attribute__((packed, aligned(4))) u32x3 { unsigned x, y, z; };
typedef __bf16 bf16v2 __attribute__((ext_vector_type(2)));

__device__ __forceinline__ float bflo(unsigned u) { return __uint_as_float(u << 16); }
__device__ __forceinline__ float bfhi(unsigned u) { return __uint_as_float(u & 0xffff0000u); }
__device__ __forceinline__ unsigned pk2(float lo, float hi) { return pg8::cvt_pk_bf16(lo, hi); }
__device__ __forceinline__ float wave_sum(float v) {
#pragma unroll
    for (int o = 1; o < 64; o <<= 1) v += __shfl_xor(v, o);
    return v;
}
__device__ __forceinline__ float dot2bf(unsigned a, unsigned b, float c) { return __builtin_amdgcn_fdot2_f32_bf16(__builtin_bit_cast(bf16v2, a), __builtin_bit_cast(bf16v2, b), c, false); }
__device__ __forceinline__ float silu_f(float v) { return v / (1.0f + __expf(-v)); }
__device__ __forceinline__ float sigmoid_f(float z) { return __builtin_amdgcn_rcpf(1.0f + __builtin_amdgcn_exp2f(-z * LOG2E)); }
#define DPP_ROR(x, n) __builtin_amdgcn_update_dpp(0, (x), 0x120 + (n), 0xf, 0xf, false)
__device__ __forceinline__ unsigned row_max_u32(unsigned m) {
    m = max(m, (unsigned)DPP_ROR((int)m, 8)); m = max(m, (unsigned)DPP_ROR((int)m, 4)); m = max(m, (unsigned)DPP_ROR((int)m, 2)); m = max(m, (unsigned)DPP_ROR((int)m, 1)); return m; }
__device__ __forceinline__ float row_sum_f32(float v) {
    v += __int_as_float(DPP_ROR(__float_as_int(v), 8)); v += __int_as_float(DPP_ROR(__float_as_int(v), 4)); v += __int_as_float(DPP_ROR(__float_as_int(v), 2)); v += __int_as_float(DPP_ROR(__float_as_int(v), 1)); return v; }
__device__ __forceinline__ float wave_sum_rows(float v) {
    v = row_sum_f32(v);
    const float a = __int_as_float(__builtin_amdgcn_readlane(__float_as_int(v), 0)), b = __int_as_float(__builtin_amdgcn_readlane(__float_as_int(v), 16));
    const float c = __int_as_float(__builtin_amdgcn_readlane(__float_as_int(v), 32)), d = __int_as_float(__builtin_amdgcn_readlane(__float_as_int(v), 48));
    return (a + b) + (c + d);
}

__device__ __forceinline__ void p0_transpose_item(const float* W, int K, int N, int ldw, bf16_t* WT, int row_off, LAS float* scr, int item, int lane, float scale = 1.0f) {
    const int nblk = N / 32, kb = item / nblk, nb = item % nblk, k0 = 64 * kb, n0 = 32 * nb;
#pragma unroll 8
    for (int i = 0; i < 32; ++i) { const int kk = 2 * i + (lane >> 5); scr[kk * 33 + (lane & 31)] = W[(size_t)(k0 + kk) * ldw + n0 + (lane & 31)] * scale; }
    asm volatile("s_waitcnt lgkmcnt(0)" ::: "memory");
    const int c = lane & 7;
#pragma unroll
    for (int j = 0; j < 4; ++j) { const int n = (lane >> 3) + 8 * j; const LAS float* s = scr + (8 * c) * 33 + n;
        u32x4 o; o.x = pk2(s[0 * 33], s[1 * 33]); o.y = pk2(s[2 * 33], s[3 * 33]); o.z = pk2(s[4 * 33], s[5 * 33]); o.w = pk2(s[6 * 33], s[7 * 33]);
        *(u32x4*)(WT + (size_t)(row_off + n0 + n) * K + k0 + 8 * c) = o; }
    asm volatile("s_waitcnt lgkmcnt(0)" ::: "memory");
}
__device__ __forceinline__ void p0_convert(const float* src, bf16_t* dst, size_t n, size_t gtid, size_t nthr) {
#pragma unroll 4
    for (size_t i = gtid * 8; i < n; i += nthr * 8) { const f32x4 a = *(const f32x4*)(src + i), b = *(const f32x4*)(src + i + 4);
        u32x4 o; o.x = pk2(a.x, a.y); o.y = pk2(a.z, a.w); o.z = pk2(b.x, b.y); o.w = pk2(b.z, b.w); *(u32x4*)(dst + i) = o; }
}
__device__ __forceinline__ void p0_row_load(f32x4 (&v)[2][4], const float* src, int lane) {
#pragma unroll
    for (int c = 0; c < 2; ++c)
#pragma unroll
        for (int j = 0; j < 4; ++j) v[c][j] = *(const f32x4*)(src + 1024 * c + 16 * lane + 4 * j);
}
__device__ __forceinline__ void p0_row_quant(const f32x4 (&v)[2][4], unsigned char* dst, float* scale_out, int bias, int lane, bool to_lds, int erow, LAS unsigned char* lds) {
    float am = 0.f;
#pragma unroll
    for (int c = 0; c < 2; ++c)
#pragma unroll
        for (int j = 0; j < 4; ++j) am = fmaxf(am, fmaxf(fmaxf(fabsf(v[c][j].x), fabsf(v[c][j].y)), fmaxf(fabsf(v[c][j].z), fabsf(v[c][j].w))));
#pragma unroll
    for (int o = 1; o < 64; o <<= 1) am = fmaxf(am, __shfl_xor(am, o));
    const float sc = am > 0.f ? am * (1.0f / 127.0f) : 1.0f, inv = 1.0f / sc;
    if (lane == 0) *scale_out = sc;
#pragma unroll
    for (int c = 0; c < 2; ++c) { u32x4 o;
#pragma unroll
        for (int j = 0; j < 4; ++j) { const f32x4 x = v[c][j];
            const unsigned q0 = (unsigned)((int)rintf(x.x * inv) + bias) & 255u, q1 = (unsigned)((int)rintf(x.y * inv) + bias) & 255u, q2 = (unsigned)((int)rintf(x.z * inv) + bias) & 255u, q3 = (unsigned)((int)rintf(x.w * inv) + bias) & 255u;
            o[j] = q0 | (q1 << 8) | (q2 << 16) | (q3 << 24); }
        if (!to_lds) *(u32x4*)(dst + 1024 * c + 16 * lane) = o;
        else *(LAS u32x4*)(lds + erow * 2048 + 1024 * c + 16 * lane) = o; }
}
__device__ __forceinline__ void p0_quant_row(const float* src, unsigned char* dst, float* scale_out, int bias, int lane, bool to_lds, int erow, LAS unsigned char* lds) {
    f32x4 v[2][4]; p0_row_load(v, src, lane); p0_row_quant(v, dst, scale_out, bias, lane, to_lds, erow, lds);
}
__device__ __forceinline__ void p0_quant_strip(LAS unsigned char* lds, const float* W, int N, int col0, unsigned char* WT8, float* cs, int row_off, int tid) {
    LAS float* red = (LAS float*)lds; LAS float* inv = (LAS float*)(lds + 4096);
    const int lane = tid & 63, w = tid >> 6;
    { float m0 = 0.f, m1 = 0.f; const float* Wp = W + col0 + 2 * lane;
#pragma unroll 8
      for (int k = 256 * w; k < 256 * w + 256; ++k) { const float2 x = *(const float2*)(Wp + (size_t)k * N); m0 = fmaxf(m0, fabsf(x.x)); m1 = fmaxf(m1, fabsf(x.y)); }
      red[w * 128 + 2 * lane] = m0; red[w * 128 + 2 * lane + 1] = m1; }
    __syncthreads();
    if (tid < 128) { float am = 0.f;
#pragma unroll
        for (int ww = 0; ww < 8; ++ww) am = fmaxf(am, red[ww * 128 + tid]);
        const float sc = am > 0.f ? am * (1.0f / 127.0f) : 1.0f; cs[row_off + tid] = sc; inv[tid] = 1.0f / sc; }
    __syncthreads();
    LAS float* scr = (LAS float*)(lds + 8192 + w * 8448);
    for (int it = w; it < 128; it += NWAVES) { const int k0 = 64 * (it >> 2), n0 = 32 * (it & 3);
#pragma unroll 8
        for (int i = 0; i < 32; ++i) { const int kk = 2 * i + (lane >> 5); scr[kk * 33 + (lane & 31)] = W[(size_t)(k0 + kk) * N + col0 + n0 + (lane & 31)]; }
        asm volatile("s_waitcnt lgkmcnt(0)" ::: "memory");
        const int c = lane & 3;
#pragma unroll
        for (int j = 0; j < 2; ++j) { const int n = (lane >> 2) + 16 * j; const float iv = inv[n0 + n]; const LAS float* sp = scr + (16 * c) * 33 + n; u32x4 o;
#pragma unroll
            for (int d = 0; d < 4; ++d) o[d] = ((unsigned)(int)rintf(sp[(4 * d + 0) * 33] * iv) & 255u) | (((unsigned)(int)rintf(sp[(4 * d + 1) * 33] * iv) & 255u) << 8)
                                             | (((unsigned)(int)rintf(sp[(4 * d + 2) * 33] * iv) & 255u) << 16) | (((unsigned)(int)rintf(sp[(4 * d + 3) * 33] * iv) & 255u) << 24);
            *(u32x4*)(WT8 + (size_t)(row_off + n0 + n) * 2048 + k0 + 16 * c) = o; }
        asm volatile("s_waitcnt lgkmcnt(0)" ::: "memory"); }
    __syncthreads();
}
__device__ __forceinline__ void p0_gemv(LAS unsigned char* lds, const float* c, const float* cctx, const float* w_mod, const float* b_mod, float* MOD, float* MODC, int item, int tid) {
    LAS float* sv = (LAS float*)lds; LAS float* red = (LAS float*)(lds + 24576);
    for (int i = tid; i < 2048; i += NTHREADS) { sv[i] = silu_f(c[i]); sv[2048 + i] = silu_f(c[2048 + i]); sv[4096 + i] = silu_f(cctx[i]); }
    __syncthreads();
    const int layer = item / 96, col0 = (item % 96) * 128, w = tid >> 6, l = tid & 63;
    const float* W = w_mod + (size_t)layer * 2048 * 12288 + col0 + 2 * l;
    float a00 = 0.f, a01 = 0.f, a10 = 0.f, a11 = 0.f, a20 = 0.f, a21 = 0.f;
#pragma unroll 8
    for (int k = 256 * w; k < 256 * w + 256; ++k) { const float2 wv = *(const float2*)(W + (size_t)k * 12288); const float s0 = sv[k], s1 = sv[2048 + k], s2 = sv[4096 + k];
        a00 += s0 * wv.x; a01 += s0 * wv.y; a10 += s1 * wv.x; a11 += s1 * wv.y; a20 += s2 * wv.x; a21 += s2 * wv.y; }
    red[(w * 3 + 0) * 128 + 2 * l] = a00; red[(w * 3 + 0) * 128 + 2 * l + 1] = a01;
    red[(w * 3 + 1) * 128 + 2 * l] = a10; red[(w * 3 + 1) * 128 + 2 * l + 1] = a11;
    red[(w * 3 + 2) * 128 + 2 * l] = a20; red[(w * 3 + 2) * 128 + 2 * l + 1] = a21;
    __syncthreads();
    if (tid < 384) { const int r = tid >> 7, cc = tid & 127; float s = 0.f;
#pragma unroll
        for (int ww = 0; ww < 8; ++ww) s += red[(ww * 3 + r) * 128 + cc];
        const int col = col0 + cc; const float val = s + b_mod[layer * 12288 + col];
        if (r < 2) MOD[(layer * 2 + r) * 12288 + col] = val; else if (layer == 0 && col < 4096) MODC[col] = val; }
    __syncthreads();
}

__device__ __forceinline__ void norm_row_store(const float* xrow, const LAS float* Gv, const LAS float* Sv, bf16_t* orow, int lane) {
    f32x4 v[8]; float ss = 0.f;
#pragma unroll
    for (int j = 0; j < 8; ++j) { v[j] = *(const f32x4*)(xrow + 4 * lane + 256 * j); ss += (v[j].x * v[j].x + v[j].y * v[j].y) + (v[j].z * v[j].z + v[j].w * v[j].w); }
    ss = wave_sum(ss);
    const float rstd = rsqrtf(ss * (1.0f / D) + EPS);
#pragma unroll
    for (int j = 0; j < 8; ++j) { const f32x4 g = *(const LAS f32x4*)(Gv + 4 * lane + 256 * j), s = *(const LAS f32x4*)(Sv + 4 * lane + 256 * j);
        const f32x4 o = v[j] * rstd * g + s; u32x2 p; p.x = pk2(o.x, o.y); p.y = pk2(o.z, o.w); *(u32x2*)(orow + 4 * lane + 256 * j) = p; }
}
__device__ __forceinline__ void norm_row_store_q(const float* xrow, const LAS float* Gv, const LAS float* Sv, bf16_t* orow, unsigned* hqrow, float* hsc, int lane) {
    f32x4 v[8]; float ss = 0.f;
#pragma unroll
    for (int j = 0; j < 8; ++j) { v[j] = *(const f32x4*)(xrow + 4 * lane + 256 * j); ss += (v[j].x * v[j].x + v[j].y * v[j].y) + (v[j].z * v[j].z + v[j].w * v[j].w); }
    ss = wave_sum(ss);
    const float rstd = rsqrtf(ss * (1.0f / D) + EPS); float am = 0.f;
#pragma unroll
    for (int j = 0; j < 8; ++j) { const f32x4 g = *(const LAS f32x4*)(Gv + 4 * lane + 256 * j), s = *(const LAS f32x4*)(Sv + 4 * lane + 256 * j);
        const f32x4 o = v[j] * rstd * g + s; v[j] = o; u32x2 p; p.x = pk2(o.x, o.y); p.y = pk2(o.z, o.w); *(u32x2*)(orow + 4 * lane + 256 * j) = p;
        am = fmaxf(am, fmaxf(fmaxf(fabsf(o.x), fabsf(o.y)), fmaxf(fabsf(o.z), fabsf(o.w)))); }
#pragma unroll
    for (int o = 1; o < 64; o <<= 1) am = fmaxf(am, __shfl_xor(am, o));
    const float hs = am > 0.f ? am * (1.0f / 127.0f) : 1.0f, inv = 1.0f / hs;
    if (lane == 0) *hsc = hs;
#pragma unroll
    for (int j = 0; j < 8; ++j) { const f32x4 o = v[j];
        hqrow[64 * j + lane] = ((unsigned)(int)rintf(o.x * inv) & 255u) | (((unsigned)(int)rintf(o.y * inv) & 255u) << 8) | (((unsigned)(int)rintf(o.z * inv) & 255u) << 16) | (((unsigned)(int)rintf(o.w * inv) & 255u) << 24); }
}
__device__ __forceinline__ void norm_row_q8(const float* xrow, const LAS float* Gv, const LAS float* Sv, unsigned* hqrow, float* hsc, int lane) {
    f32x4 v[8]; float ss = 0.f;
#pragma unroll
    for (int j = 0; j < 8; ++j) { v[j] = *(const f32x4*)(xrow + 4 * lane + 256 * j); ss += (v[j].x * v[j].x + v[j].y * v[j].y) + (v[j].z * v[j].z + v[j].w * v[j].w); }
    ss = wave_sum(ss);
    const float rstd = rsqrtf(ss * (1.0f / D) + EPS); float am = 0.f;
#pragma unroll
    for (int j = 0; j < 8; ++j) { const f32x4 g = *(const LAS f32x4*)(Gv + 4 * lane + 256 * j), sft = *(const LAS f32x4*)(Sv + 4 * lane + 256 * j);
        const f32x4 o = v[j] * rstd * g + sft; v[j] = o; am = fmaxf(am, fmaxf(fmaxf(fabsf(o.x), fabsf(o.y)), fmaxf(fabsf(o.z), fabsf(o.w)))); }
#pragma unroll
    for (int o = 1; o < 64; o <<= 1) am = fmaxf(am, __shfl_xor(am, o));
    const float hs = am > 0.f ? am * (1.0f / 127.0f) : 1.0f, inv = 1.0f / hs;
    if (lane == 0) *hsc = hs;
#pragma unroll
    for (int j = 0; j < 8; ++j) { const f32x4 o = v[j];
        hqrow[64 * j + lane] = ((unsigned)(int)rintf(o.x * inv) & 255u) | (((unsigned)(int)rintf(o.y * inv) & 255u) << 8) | (((unsigned)(int)rintf(o.z * inv) & 255u) << 16) | (((unsigned)(int)rintf(o.w * inv) & 255u) << 24); }
}
__device__ __forceinline__ float load_row_h(const bf16_t* xrow, float (&v)[4][8], int lane) {
    float ss = 0.f;
#pragma unroll
    for (int j = 0; j < 4; ++j) { const u32x4 x = *(const u32x4*)(xrow + 8 * lane + 512 * j);
        v[j][0] = bflo(x.x); v[j][1] = bfhi(x.x); v[j][2] = bflo(x.y); v[j][3] = bfhi(x.y); v[j][4] = bflo(x.z); v[j][5] = bfhi(x.z); v[j][6] = bflo(x.w); v[j][7] = bfhi(x.w);
#pragma unroll
        for (int i = 0; i < 8; ++i) ss += v[j][i] * v[j][i]; }
    return wave_sum(ss);
}
template <bool QUANT, bool BF16OUT = true>
__device__ __forceinline__ void norm_row_store_h(const bf16_t* xrow, const LAS float* Gv, const LAS float* Sv, bf16_t* orow, unsigned* hqrow, float* hsc, int lane) {
    float v[4][8]; const float ss = load_row_h(xrow, v, lane);
    const float rstd = rsqrtf(ss * (1.0f / D) + EPS); float am = 0.f;
#pragma unroll
    for (int j = 0; j < 4; ++j) { const int e = 8 * lane + 512 * j; const f32x4 g0 = *(const LAS f32x4*)(Gv + e), g1 = *(const LAS f32x4*)(Gv + e + 4), s0 = *(const LAS f32x4*)(Sv + e), s1 = *(const LAS f32x4*)(Sv + e + 4);
        v[j][0] = v[j][0] * rstd * g0.x + s0.x; v[j][1] = v[j][1] * rstd * g0.y + s0.y; v[j][2] = v[j][2] * rstd * g0.z + s0.z; v[j][3] = v[j][3] * rstd * g0.w + s0.w;
        v[j][4] = v[j][4] * rstd * g1.x + s1.x; v[j][5] = v[j][5] * rstd * g1.y + s1.y; v[j][6] = v[j][6] * rstd * g1.z + s1.z; v[j][7] = v[j][7] * rstd * g1.w + s1.w;
        u32x4 p; p.x = pk2(v[j][0], v[j][1]); p.y = pk2(v[j][2], v[j][3]); p.z = pk2(v[j][4], v[j][5]); p.w = pk2(v[j][6], v[j][7]); if (BF16OUT) *(u32x4*)(orow + e) = p;
        if (QUANT) {
#pragma unroll
            for (int i = 0; i < 8; ++i) am = fmaxf(am, fabsf(v[j][i])); } }
    if (QUANT) {
#pragma unroll
        for (int o = 1; o < 64; o <<= 1) am = fmaxf(am, __shfl_xor(am, o));
        const float hs = am > 0.f ? am * (1.0f / 127.0f) : 1.0f, inv = 1.0f / hs;
        if (lane == 0) *hsc = hs;
#pragma unroll
        for (int j = 0; j < 4; ++j) { u32x2 q;
            q.x = ((unsigned)(int)rintf(v[j][0] * inv) & 255u) | (((unsigned)(int)rintf(v[j][1] * inv) & 255u) << 8) | (((unsigned)(int)rintf(v[j][2] * inv) & 255u) << 16) | (((unsigned)(int)rintf(v[j][3] * inv) & 255u) << 24);
            q.y = ((unsigned)(int)rintf(v[j][4] * inv) & 255u) | (((unsigned)(int)rintf(v[j][5] * inv) & 255u) << 8) | (((unsigned)(int)rintf(v[j][6] * inv) & 255u) << 16) | (((unsigned)(int)rintf(v[j][7] * inv) & 255u) << 24);
            *(u32x2*)(hqrow + 2 * lane + 128 * j) = q; } }
}
__device__ __forceinline__ void norm_row_final_h(const bf16_t* xrow, const float* g, float* orow, int lane) {
    float v[4][8]; const float ss = load_row_h(xrow, v, lane);
    const float rstd = rsqrtf(ss * (1.0f / D) + EPS);
#pragma unroll
    for (int j = 0; j < 4; ++j) { const int e = 8 * lane + 512 * j; const f32x4 g0 = *(const f32x4*)(g + e), g1 = *(const f32x4*)(g + e + 4);
        f32x4 o0, o1; o0.x = v[j][0] * rstd * g0.x; o0.y = v[j][1] * rstd * g0.y; o0.z = v[j][2] * rstd * g0.z; o0.w = v[j][3] * rstd * g0.w;
        o1.x = v[j][4] * rstd * g1.x; o1.y = v[j][5] * rstd * g1.y; o1.z = v[j][6] * rstd * g1.z; o1.w = v[j][7] * rstd * g1.w;
        *(f32x4*)(orow + e) = o0; *(f32x4*)(orow + e + 4) = o1; }
}
__device__ __forceinline__ void fill_mod_lds(LAS float* Gs, LAS float* Ss, const float* g, const float* mod, int shift_idx, int scale_idx, int tid) {
    for (int i = tid; i < 2 * D; i += NTHREADS) { const int b = i >> 11, d = i & 2047; const float* mb = mod + (size_t)b * 12288;
        Gs[i] = g[d] * (1.0f + mb[scale_idx * D + d]); Ss[i] = mb[shift_idx * D + d]; }
}
__device__ __forceinline__ void ctx_gemm_tile(const bf16_t* HC, const bf16_t* Bt, bf16_t* XBC, int tile, int tid) {
    const int lane = tid & 63, w = tid >> 6, n = lane & 15, q = lane >> 4, rt = tile >> 4, ct = tile & 15;
    const bf16_t* a0 = HC + (size_t)(rt * 32 + n) * D + 8 * q; const bf16_t* a1 = a0 + (size_t)16 * D;
    const bf16_t* bp = Bt + (size_t)(ct * 128 + 16 * w + n) * D + 8 * q;
    f32x4 acc0 = {0.f, 0.f, 0.f, 0.f}, acc1 = {0.f, 0.f, 0.f, 0.f};
#pragma unroll 1
    for (int k0 = 0; k0 < D; k0 += 256) { bf16x8 A0[8], A1[8], B[8];
#pragma unroll
        for (int s8 = 0; s8 < 8; ++s8) { A0[s8] = *(const bf16x8*)(a0 + k0 + 32 * s8); A1[s8] = *(const bf16x8*)(a1 + k0 + 32 * s8); B[s8] = *(const bf16x8*)(bp + k0 + 32 * s8); }
#pragma unroll
        for (int s8 = 0; s8 < 8; ++s8) { acc0 = __builtin_amdgcn_mfma_f32_16x16x32_bf16(A0[s8], B[s8], acc0, 0, 0, 0); acc1 = __builtin_amdgcn_mfma_f32_16x16x32_bf16(A1[s8], B[s8], acc1, 0, 0, 0); } }
    bf16_t* o = XBC + (size_t)(rt * 32 + 4 * q) * D + ct * 128 + 16 * w + n;
#pragma unroll
    for (int i = 0; i < 4; ++i) { o[(size_t)i * D] = (bf16_t)(pk2(acc0[i], 0.f) & 0xffffu); o[(size_t)(16 + i) * D] = (bf16_t)(pk2(acc1[i], 0.f) & 0xffffu); }
}
constexpr int SC_RAW = 0, SC_XC = 18432, SC_Y = 35840, SC_CARRY = 69632, SC_CW = 70656  , SC_PITCH = 272, SC_YPITCH = 528;

__device__ __forceinline__ void scan_load_raw(u32x4 (&pre)[3], const bf16_t* src, int t0, bool is_ctx, int tid) {
#pragma unroll
    for (int j = 0; j < 3; ++j) { const int cidx = tid + NTHREADS * j, rr = (cidx >> 4) - 2, c16 = cidx & 15, tok = t0 + rr;
        const bool valid = (cidx < 1072) && (is_ctx ? (tok >= 0 && tok < CTXL) : (rr >= 0 && rr < 64));
        const u32x4 z = *(const u32x4*)(src + (ptrdiff_t)(valid ? tok : t0) * D + 8 * c16);
        pre[j] = valid ? z : (u32x4){0u, 0u, 0u, 0u}; }
}
__device__ __forceinline__ void gate_ab(float za, float zx, float sp8l, float xcv, float& a, float& b) {
    const float r = __builtin_amdgcn_rcpf(1.0f + __builtin_amdgcn_exp2f(za)), ig = __builtin_amdgcn_rcpf(1.0f + __builtin_amdgcn_exp2f(zx));
    a = __builtin_amdgcn_exp2f(sp8l * r);
    const float om = __builtin_fmaf(-a, a, 1.0f);
    b = __builtin_amdgcn_sqrtf(om) * ig * xcv;
}

template <int PASS, int DIR, bool CONV>
__device__ __forceinline__ void scan_sweep(LAS unsigned char* lds, const bf16_t* src, int t_begin, int ntiles, bool is_ctx, const bf16_t* gwd,
                                           float ba, float bx, float sp8, float S_in, float& S_out, float& P_out,
                                           bf16_t* Mrow, const bf16_t* GGrow, int tid) {
    const int lane = tid & 63, w = tid >> 6, n = lane & 15, q = lane >> 4, cg = tid & 15, tq = tid >> 4;
    bf16x8 Bf[2][4];
#pragma unroll
    for (int g = 0; g < 2; ++g)
#pragma unroll
        for (int ks = 0; ks < 4; ++ks) Bf[g][ks] = *(const bf16x8*)(gwd + (size_t)g * 16 * 16384 + (16 * w + n) * 128 + 32 * ks + 8 * q);
    float S = S_in, P = 1.0f;
    u32x4 pre[3];
    if (CONV) scan_load_raw(pre, src, t_begin + 64 * (DIR ? ntiles - 1 : 0), is_ctx, tid);
    else {
#pragma unroll
        for (int jj = 0; jj < 2; ++jj) pre[jj] = *(const u32x4*)(src + (size_t)(t_begin + 64 * (DIR ? ntiles - 1 : 0) + tq + 32 * jj) * D + 8 * cg); }
    for (int it = 0; it < ntiles; ++it) {
        const int ti = DIR ? ntiles - 1 - it : it, t0 = t_begin + 64 * ti;
        const int tin = (it + 1 < ntiles) ? (DIR ? ti - 1 : ti + 1) : ti;
        const int xcoff = CONV ? SC_XC : ((it & 1) ? SC_RAW : SC_XC);
        if (CONV) {
#pragma unroll
            for (int j = 0; j < 3; ++j) { const int cidx = tid + NTHREADS * j; if (cidx < 1072) *(LAS u32x4*)(lds + SC_RAW + (cidx >> 4) * SC_PITCH + (cidx & 15) * 16) = pre[j]; }
            __syncthreads();
            scan_load_raw(pre, src, t_begin + 64 * tin, is_ctx, tid);
#pragma unroll
            for (int jj = 0; jj < 2; ++jj) { const int tt = tq + 32 * jj; float xc[8];
                { const f32x4 c0 = *(const LAS f32x4*)(lds + SC_CW + (4 * 128 + 8 * cg) * 4), c1 = *(const LAS f32x4*)(lds + SC_CW + (4 * 128 + 8 * cg + 4) * 4);
                  xc[0] = c0.x; xc[1] = c0.y; xc[2] = c0.z; xc[3] = c0.w; xc[4] = c1.x; xc[5] = c1.y; xc[6] = c1.z; xc[7] = c1.w; }
#pragma unroll
                for (int k = 0; k < 4; ++k) { const u32x4 rv = *(const LAS u32x4*)(lds + SC_RAW + (tt + k) * SC_PITCH + cg * 16);
                    const f32x4 w0 = *(const LAS f32x4*)(lds + SC_CW + (k * 128 + 8 * cg) * 4), w1 = *(const LAS f32x4*)(lds + SC_CW + (k * 128 + 8 * cg + 4) * 4);
                    xc[0] += w0.x * bflo(rv.x); xc[1] += w0.y * bfhi(rv.x); xc[2] += w0.z * bflo(rv.y); xc[3] += w0.w * bfhi(rv.y);
                    xc[4] += w1.x * bflo(rv.z); xc[5] += w1.y * bfhi(rv.z); xc[6] += w1.z * bflo(rv.w); xc[7] += w1.w * bfhi(rv.w); }
                u32x4 o; o.x = pk2(xc[0], xc[1]); o.y = pk2(xc[2], xc[3]); o.z = pk2(xc[4], xc[5]); o.w = pk2(xc[6], xc[7]);
                *(LAS u32x4*)(lds + SC_XC + tt * SC_PITCH + cg * 16) = o;
                if (!is_ctx) *(u32x4*)(const_cast<bf16_t*>(src) + (size_t)(t0 + tt) * D + 8 * cg) = o; }
            __syncthreads();
        } else {
#pragma unroll
            for (int jj = 0; jj < 2; ++jj) *(LAS u32x4*)(lds + xcoff + (tq + 32 * jj) * SC_PITCH + cg * 16) = pre[jj];
            __syncthreads();
#pragma unroll
            for (int jj = 0; jj < 2; ++jj) pre[jj] = *(const u32x4*)(src + (size_t)(t_begin + 64 * tin + tq + 32 * jj) * D + 8 * cg);
        }
        u32x4 yfp[2], ggp[2];
        if (PASS == 2 && DIR == 1) {
#pragma unroll
            for (int jj = 0; jj < 2; ++jj) { const size_t gi = (size_t)(t0 + tq + 32 * jj) * D + 8 * cg; yfp[jj] = *(const u32x4*)(Mrow + gi); ggp[jj] = *(const u32x4*)(GGrow + gi); } }
        f32x4 acc_a[4], acc_x[4];
#pragma unroll
        for (int mt = 0; mt < 4; ++mt) { acc_a[mt] = (f32x4){ba, ba, ba, ba}; acc_x[mt] = (f32x4){bx, bx, bx, bx};
#pragma unroll
            for (int ks = 0; ks < 4; ++ks) { const bf16x8 Af = *(const LAS bf16x8*)(lds + xcoff + (16 * mt + n) * SC_PITCH + (32 * ks + 8 * q) * 2);
                acc_a[mt] = __builtin_amdgcn_mfma_f32_16x16x32_bf16(Af, Bf[0][ks], acc_a[mt], 0, 0, 0);
                acc_x[mt] = __builtin_amdgcn_mfma_f32_16x16x32_bf16(Af, Bf[1][ks], acc_x[mt], 0, 0, 0); } }
#pragma unroll
        for (int mi = 0; mi < 4; ++mi) { const int mt = DIR ? 3 - mi : mi;
            float a[4], b[4];
#pragma unroll
            for (int i = 0; i < 4; ++i) { const unsigned short xh = *(const LAS unsigned short*)(lds + xcoff + (16 * mt + 4 * q + i) * SC_PITCH + (16 * w + n) * 2);
                gate_ab(acc_a[mt][i], acc_x[mt][i], sp8, __uint_as_float((unsigned)xh << 16), a[i], b[i]); }
            const float A4 = (a[0] * a[1]) * (a[2] * a[3]); float l;
            if (DIR == 0) { l = b[0]; l = a[1] * l + b[1]; l = a[2] * l + b[2]; l = a[3] * l + b[3]; }
            else          { l = b[3]; l = a[2] * l + b[2]; l = a[1] * l + b[1]; l = a[0] * l + b[0]; }
            float Aq[4], Bq[4];
#pragma unroll
            for (int qq = 0; qq < 4; ++qq) { Aq[qq] = __shfl(A4, n + 16 * qq); Bq[qq] = __shfl(l, n + 16 * qq); }
            float c = S, mine = S;
#pragma unroll
            for (int s = 0; s < 4; ++s) { const int qq = DIR ? 3 - s : s; if (qq == q) mine = c; c = Aq[qq] * c + Bq[qq]; }
            S = c; P *= (Aq[0] * Aq[1]) * (Aq[2] * Aq[3]);
            if (PASS == 2) { float y[4], h = mine;
                if (DIR == 0) { h = a[0] * h + b[0]; y[0] = h; h = a[1] * h + b[1]; y[1] = h; h = a[2] * h + b[2]; y[2] = h; h = a[3] * h + b[3]; y[3] = h; }
                else          { h = a[3] * h + b[3]; y[3] = h; h = a[2] * h + b[2]; y[2] = h; h = a[1] * h + b[1]; y[1] = h; h = a[0] * h + b[0]; y[0] = h; }
#pragma unroll
                for (int i = 0; i < 4; ++i) *(LAS float*)(lds + SC_Y + (16 * mt + 4 * q + i) * SC_YPITCH + (16 * w + n) * 4) = y[i]; }
        }
        if (PASS == 2) {
            __syncthreads();
#pragma unroll
            for (int jj = 0; jj < 2; ++jj) { const int row = tq + 32 * jj; const LAS f32x4* yp = (const LAS f32x4*)(lds + SC_Y + row * SC_YPITCH + cg * 32);
                f32x4 y0 = yp[0], y1 = yp[1]; const size_t gi = (size_t)(t0 + row) * D + 8 * cg;
                if (DIR == 1) { const u32x4 f = yfp[jj], g = ggp[jj];
                    y0.x = (y0.x + bflo(f.x)) * bflo(g.x); y0.y = (y0.y + bfhi(f.x)) * bfhi(g.x); y0.z = (y0.z + bflo(f.y)) * bflo(g.y); y0.w = (y0.w + bfhi(f.y)) * bfhi(g.y);
                    y1.x = (y1.x + bflo(f.z)) * bflo(g.z); y1.y = (y1.y + bfhi(f.z)) * bfhi(g.z); y1.z = (y1.z + bflo(f.w)) * bflo(g.w); y1.w = (y1.w + bfhi(f.w)) * bfhi(g.w); }
                u32x4 o; o.x = pk2(y0.x, y0.y); o.y = pk2(y0.z, y0.w); o.z = pk2(y1.x, y1.y); o.w = pk2(y1.z, y1.w);
                *(u32x4*)(Mrow + gi) = o; }
        }
    }
    S_out = S; P_out = P;
}

template <int PASS>
__device__ __forceinline__ void scan_unit(LAS unsigned char* lds, const float* conv_w, const float* conv_b, const float* b_a, const float* b_x, const float* lam,
                                          unsigned char* ws, bool is_ctx, int b, int hd, int r, int tid) {
    const int lane = tid & 63, w = tid >> 6, n = lane & 15, q = lane >> 4;
    const bf16_t* GW = (const bf16_t*)(ws + WS_GW);
    float* SUMA = (float*)(ws + WS_SUMA); float* SUMB = (float*)(ws + WS_SUMB); float* H0 = (float*)(ws + WS_H0);
    for (int i = tid; i < 640; i += NTHREADS) { const int k = i >> 7, ch = hd * 128 + (i & 127); *(LAS float*)(lds + SC_CW + i * 4) = (k < 4) ? conv_w[k * D + ch] : conv_b[ch]; }
    __syncthreads();
    const int gch = hd * 128 + 16 * w + n;
    const bf16_t* src = is_ctx ? (const bf16_t*)(ws + WS_XBC) + (size_t)b * CTXL * D + hd * 128 : (const bf16_t*)(ws + WS_XB) + (size_t)b * SEQ * D + hd * 128;
    const int t_begin = is_ctx ? 0 : r * 2048, ntiles = is_ctx ? 4 : 32;
    bf16_t* Mrow = (bf16_t*)(ws + WS_H) + (size_t)b * SEQ * D + hd * 128; const bf16_t* GGrow = (const bf16_t*)(ws + WS_GG) + (size_t)b * SEQ * D + hd * 128;
    if (PASS == 2) {
        if (tid < 256) { const int dir = tid >> 7, ch = hd * 128 + (tid & 127); float S = 0.f;
            { const float* CSA = (const float*)(ws + WS_CSA); const float* CSB = (const float*)(ws + WS_CSB);
              if (dir == 0) { for (int k = 0; k < 4; ++k) S = CSA[(size_t)((0 * 2 + b) * 4 + k) * D + ch] * S + CSB[(size_t)((0 * 2 + b) * 4 + k) * D + ch]; }
              else          { for (int k = 3; k >= 0; --k) S = CSA[(size_t)((1 * 2 + b) * 4 + k) * D + ch] * S + CSB[(size_t)((1 * 2 + b) * 4 + k) * D + ch]; } }
            if (dir == 0) { for (int rr = 0; rr < r; ++rr) S = SUMA[((0 * 2 + b) * 8 + rr) * D + ch] * S + SUMB[((0 * 2 + b) * 8 + rr) * D + ch]; }
            else          { for (int rr = 7; rr > r; --rr) S = SUMA[((1 * 2 + b) * 8 + rr) * D + ch] * S + SUMB[((1 * 2 + b) * 8 + rr) * D + ch]; }
            *(LAS float*)(lds + SC_CARRY + tid * 4) = S; }
        __syncthreads();
    }
#pragma unroll
    for (int dir = 0; dir < 2; ++dir) {
        const float ba = -LOG2E * b_a[dir * D + gch], bx = -LOG2E * b_x[dir * D + gch];
        const float sp8 = -LOG2E * 8.0f * log1pf(expf(-lam[dir * D + gch]));
        const bf16_t* gwd = GW + (size_t)((dir * 2) * 16 + hd) * 16384;
        float S_in = 0.f, S_out, P_out;
        if (PASS == 2) S_in = *(const LAS float*)(lds + SC_CARRY + (dir * 128 + 16 * w + n) * 4);
        if (PASS == 1 && is_ctx) { if (dir == 0) scan_sweep<PASS, 0, true>(lds, src, t_begin, ntiles, true, gwd, ba, bx, sp8, S_in, S_out, P_out, Mrow, GGrow, tid);
                                   else          scan_sweep<PASS, 1, true>(lds, src, t_begin, ntiles, true, gwd, ba, bx, sp8, S_in, S_out, P_out, Mrow, GGrow, tid); }
        else if (PASS == 1 && dir == 0) scan_sweep<PASS, 0, true>(lds, src, t_begin, ntiles, false, gwd, ba, bx, sp8, S_in, S_out, P_out, Mrow, GGrow, tid);
        else if (dir == 0) scan_sweep<PASS, 0, false>(lds, src, t_begin, ntiles, false, gwd, ba, bx, sp8, S_in, S_out, P_out, Mrow, GGrow, tid);
        else               scan_sweep<PASS, 1, false>(lds, src, t_begin, ntiles, false, gwd, ba, bx, sp8, S_in, S_out, P_out, Mrow, GGrow, tid);
        if (PASS == 1 && q == 0) {
            if (is_ctx) H0[(dir * 2 + b) * D + gch] = S_out;
            else { SUMA[((dir * 2 + b) * 8 + r) * D + gch] = P_out; SUMB[((dir * 2 + b) * 8 + r) * D + gch] = S_out; } }
        asm volatile("s_waitcnt vmcnt(0)" ::: "memory");
        __syncthreads();
        if (PASS == 1 && dir == 0) {
            __builtin_amdgcn_fence(__ATOMIC_ACQUIRE, "agent");
            asm volatile("s_waitcnt vmcnt(0)" ::: "memory");
            __syncthreads(); }
    }
}
__device__ __forceinline__ void scan_ctx_tile(LAS unsigned char* lds, const float* conv_w, const float* conv_b, const float* b_a, const float* b_x, const float* lam,
                                              unsigned char* ws, int b, int hd, int dir, int tile, int tid) {
    const int lane = tid & 63, w = tid >> 6, n = lane & 15, q = lane >> 4;
    const bf16_t* GW = (const bf16_t*)(ws + WS_GW);
    __syncthreads();
    for (int i = tid; i < 640; i += NTHREADS) { const int k = i >> 7, ch = hd * 128 + (i & 127); *(LAS float*)(lds + SC_CW + i * 4) = (k < 4) ? conv_w[k * D + ch] : conv_b[ch]; }
    __syncthreads();
    const int gch = hd * 128 + 16 * w + n;
    const bf16_t* src = (const bf16_t*)(ws + WS_XBC) + (size_t)b * CTXL * D + hd * 128;
    bf16_t* Mrow = (bf16_t*)(ws + WS_H) + (size_t)b * SEQ * D + hd * 128; const bf16_t* GGrow = (const bf16_t*)(ws + WS_GG) + (size_t)b * SEQ * D + hd * 128;
    const float ba = -LOG2E * b_a[dir * D + gch], bx = -LOG2E * b_x[dir * D + gch];
    const float sp8 = -LOG2E * 8.0f * log1pf(expf(-lam[dir * D + gch]));
    const bf16_t* gwd = GW + (size_t)((dir * 2) * 16 + hd) * 16384;
    float S_out, P_out;
    if (dir == 0) scan_sweep<1, 0, true>(lds, src, 64 * tile, 1, true, gwd, ba, bx, sp8, 0.f, S_out, P_out, Mrow, GGrow, tid);
    else          scan_sweep<1, 1, true>(lds, src, 64 * tile, 1, true, gwd, ba, bx, sp8, 0.f, S_out, P_out, Mrow, GGrow, tid);
    if (q == 0) { ((float*)(ws + WS_CSA))[(size_t)((dir * 2 + b) * 4 + tile) * D + gch] = P_out; ((float*)(ws + WS_CSB))[(size_t)((dir * 2 + b) * 4 + tile) * D + gch] = S_out; }
    asm volatile("s_waitcnt vmcnt(0)" ::: "memory");
    __syncthreads();
}
__device__ __forceinline__ void sc_conv_mul(const bf16_t* BG, const bf16_t* CV, const float* conv_w, const float* conv_b, bf16_t* M, int gtid, int nthr) {
    const int cgp = gtid & 255, ch0 = 8 * cgp; float cw[3][8], cb[8];
#pragma unroll
    for (int j = 0; j < 8; ++j) { cb[j] = conv_b[ch0 + j];
#pragma unroll
        for (int k = 0; k < 3; ++k) cw[k][j] = conv_w[k * D + ch0 + j]; }
    for (int t = gtid >> 8; t < T; t += (nthr >> 8)) { const int tl = t & 63; const size_t gi = (size_t)t * D + ch0;
        u32x4 c[3]; c[0] = (u32x4){0u, 0u, 0u, 0u}; c[2] = c[0];
        if (tl > 0) c[0] = *(const u32x4*)(CV + gi - D);
        c[1] = *(const u32x4*)(CV + gi);
        if (tl < 63) c[2] = *(const u32x4*)(CV + gi + D);
        const u32x4 g = *(const u32x4*)(BG + gi);
        float y[8];
#pragma unroll
        for (int j = 0; j < 8; ++j) y[j] = cb[j];
#pragma unroll
        for (int k = 0; k < 3; ++k) { y[0] += cw[k][0] * bflo(c[k].x); y[1] += cw[k][1] * bfhi(c[k].x); y[2] += cw[k][2] * bflo(c[k].y); y[3] += cw[k][3] * bfhi(c[k].y);
            y[4] += cw[k][4] * bflo(c[k].z); y[5] += cw[k][5] * bfhi(c[k].z); y[6] += cw[k][6] * bflo(c[k].w); y[7] += cw[k][7] * bfhi(c[k].w); }
        u32x4 o; o.x = pk2(y[0] * bflo(g.x), y[1] * bfhi(g.x)); o.y = pk2(y[2] * bflo(g.y), y[3] * bfhi(g.y)); o.z = pk2(y[4] * bflo(g.z), y[5] * bfhi(g.z)); o.w = pk2(y[6] * bflo(g.w), y[7] * bfhi(g.w));
        *(u32x4*)(M + gi) = o; }
}

__device__ __forceinline__ void sc_conv_mul_row(const bf16_t* BG, const bf16_t* CV, const LAS float* cwl, unsigned* mq, float* msc, int t, int lane) {
    const int tl = t & 63; const int tm = (tl > 0) ? t - 1 : t, tp = (tl < 63) ? t + 1 : t;
    const float zm = (tl > 0) ? 1.f : 0.f, zp = (tl < 63) ? 1.f : 0.f;
    const float rbg = *msc;
    float v[4][8]; float am = 0.f;
#pragma unroll
    for (int j = 0; j < 4; ++j) { const int e = 8 * lane + 512 * j;
        const u32x4 c0 = *(const u32x4*)(CV + (size_t)tm * D + e), c1 = *(const u32x4*)(CV + (size_t)t * D + e), c2 = *(const u32x4*)(CV + (size_t)tp * D + e), g = *(const u32x4*)(BG + (size_t)t * D + e);
        float y[8];
#pragma unroll
        for (int h = 0; h < 2; ++h) { const f32x4 w0 = *(const LAS f32x4*)(cwl + e + 4 * h), w1 = *(const LAS f32x4*)(cwl + D + e + 4 * h), w2 = *(const LAS f32x4*)(cwl + 2 * D + e + 4 * h), bb = *(const LAS f32x4*)(cwl + 3 * D + e + 4 * h);
            const unsigned a0 = h ? c0.z : c0.x, a1 = h ? c0.w : c0.y, b0 = h ? c1.z : c1.x, b1 = h ? c1.w : c1.y, d0 = h ? c2.z : c2.x, d1 = h ? c2.w : c2.y;
            y[4 * h + 0] = bb.x + zm * w0.x * bflo(a0) + w1.x * bflo(b0) + zp * w2.x * bflo(d0); y[4 * h + 1] = bb.y + zm * w0.y * bfhi(a0) + w1.y * bfhi(b0) + zp * w2.y * bfhi(d0);
            y[4 * h + 2] = bb.z + zm * w0.z * bflo(a1) + w1.z * bflo(b1) + zp * w2.z * bflo(d1); y[4 * h + 3] = bb.w + zm * w0.w * bfhi(a1) + w1.w * bfhi(b1) + zp * w2.w * bfhi(d1); }
        v[j][0] = y[0] * bflo(g.x); v[j][1] = y[1] * bfhi(g.x); v[j][2] = y[2] * bflo(g.y); v[j][3] = y[3] * bfhi(g.y); v[j][4] = y[4] * bflo(g.z); v[j][5] = y[5] * bfhi(g.z); v[j][6] = y[6] * bflo(g.w); v[j][7] = y[7] * bfhi(g.w);
#pragma unroll
        for (int i = 0; i < 8; ++i) am = fmaxf(am, fabsf(v[j][i])); }
#pragma unroll
    for (int o = 1; o < 64; o <<= 1) am = fmaxf(am, __shfl_xor(am, o));
    const float sc = am > 0.f ? am * (1.0f / 127.0f) : 1.0f, inv = 1.0f / sc;
    if (lane == 0) *msc = sc * rbg;
#pragma unroll
    for (int j = 0; j < 4; ++j) { u32x2 q;
        q.x = ((unsigned)(int)rintf(v[j][0] * inv) & 255u) | (((unsigned)(int)rintf(v[j][1] * inv) & 255u) << 8) | (((unsigned)(int)rintf(v[j][2] * inv) & 255u) << 16) | (((unsigned)(int)rintf(v[j][3] * inv) & 255u) << 24);
        q.y = ((unsigned)(int)rintf(v[j][4] * inv) & 255u) | (((unsigned)(int)rintf(v[j][5] * inv) & 255u) << 8) | (((unsigned)(int)rintf(v[j][6] * inv) & 255u) << 16) | (((unsigned)(int)rintf(v[j][7] * inv) & 255u) << 24);
        *(u32x2*)(mq + 2 * lane + 128 * j) = q; }
}

__device__ __forceinline__ unsigned gmix(unsigned el) { return ((el >> 2) ^ (el >> 7) ^ ((el & 3u) * 11u)) & 31u; }
__device__ __forceinline__ unsigned ord_f32(float f) { const unsigned u = __float_as_uint(f); return u ^ ((unsigned)((int)u >> 31) | 0x80000000u); }
__device__ __forceinline__ float unord_f32(unsigned o) { return __uint_as_float((o & 0x80000000u) ? (o ^ 0x80000000u) : ~o); }
__device__ __forceinline__ bool stair_ij(int reg, int n, int& i, int& j) {
    bool ok = true; i = 0; j = 0;
    if (reg == 0) { i = 0; j = n; }
    else if (reg == 1) { if (n < 8) { i = 1; j = n; } else if (n < 13) { i = 2; j = n - 8; } else ok = false; }
    else if (reg == 2) { if (n < 4) { i = 3; j = n; } else if (n < 7) { i = 4; j = n - 4; } else if (n < 9) { i = 5; j = n - 7; } else if (n < 11) { i = 6; j = n - 9; } else if (n < 13) { i = 7; j = n - 11; } else { i = 8 + (n - 13); j = 0; } }
    else { if (n < 5) { i = 11 + n; j = 0; } else ok = false; }
    return ok;
}
constexpr int SEL_KT = 0, SEL_PITCH = 272, SEL_KTBYTES = 34816, SEL_LIST = 73728  ;
__device__ __forceinline__ void peer_select_unit(LAS unsigned char* lds, const bf16_t* Q, const bf16_t* KEYS, const float* HSC, int* IDX, float* GATE, unsigned* ENT, unsigned* POS, unsigned* SEG, int unit, int tid) {
    const int lane = tid & 63, w = tid >> 6, n = lane & 15, q = lane >> 4, rowbase = lane & 48;
    const int tok0 = unit * 128 + 16 * w;
    int stA0[4], stA1[4]; unsigned stTag[4], stOk[4];
#pragma unroll
    for (int reg = 0; reg < 4; ++reg) { int ci, cj; const bool ok = stair_ij(reg, n, ci, cj); stA0[reg] = (rowbase + ci) * 4; stA1[reg] = (rowbase + cj) * 4; stTag[reg] = (unsigned)(255 - (16 * ci + cj)); stOk[reg] = ok ? 0xffffffffu : 0u; }
    u32x4 kn[4]; bf16x8 An[4];
#pragma unroll
    for (int j = 0; j < 4; ++j) kn[j] = *(const u32x4*)(KEYS + (size_t)(tid + NTHREADS * j) * 8);
#pragma unroll
    for (int ks = 0; ks < 4; ++ks) An[ks] = *(const bf16x8*)(Q + (size_t)(tok0 + n) * D + 32 * ks + 8 * q);
    for (int h = 0; h < 8; ++h) {
        unsigned topk[2][4];
#pragma unroll
        for (int p = 0; p < 2; ++p) {
            const int ktoff = SEL_KT + p * SEL_KTBYTES;
            bf16x8 Aq[4];
#pragma unroll
            for (int ks = 0; ks < 4; ++ks) Aq[ks] = An[ks];
#pragma unroll
            for (int j = 0; j < 4; ++j) { const int cidx = tid + NTHREADS * j; *(LAS u32x4*)(lds + ktoff + (cidx >> 4) * SEL_PITCH + (cidx & 15) * 16) = kn[j]; }
            __syncthreads();
            { const int hpn = (2 * h + p + 1 < 16) ? 2 * h + p + 1 : 15;
              const bf16_t* kp = KEYS + (size_t)hpn * 16384;
#pragma unroll
              for (int j = 0; j < 4; ++j) kn[j] = *(const u32x4*)(kp + (size_t)(tid + NTHREADS * j) * 8);
#pragma unroll
              for (int ks = 0; ks < 4; ++ks) An[ks] = *(const bf16x8*)(Q + (size_t)(tok0 + n) * D + hpn * 128 + 32 * ks + 8 * q); }
            f32x4 acc[8];
#pragma unroll
            for (int nt = 0; nt < 8; ++nt) { acc[nt] = (f32x4){0.f, 0.f, 0.f, 0.f};
#pragma unroll
                for (int ks = 0; ks < 4; ++ks) { const bf16x8 Bk = *(const LAS bf16x8*)(lds + ktoff + (16 * nt + n) * SEL_PITCH + (32 * ks + 8 * q) * 2);
                    acc[nt] = __builtin_amdgcn_mfma_f32_16x16x32_bf16(Aq[ks], Bk, acc[nt], 0, 0, 0); } }
#pragma unroll
            for (int i2 = 0; i2 < 4; i2 += 2) { unsigned hd[2]; unsigned pt[2];
#pragma unroll
                for (int s2 = 0; s2 < 2; ++s2) { unsigned kv[8];
#pragma unroll
                    for (int nt = 0; nt < 8; ++nt) kv[nt] = (ord_f32(acc[nt][i2 + s2]) & ~127u) | (unsigned)(127 - (16 * nt + n));
#define CE(a, b) { const unsigned hi_ = max(kv[a], kv[b]), lo_ = min(kv[a], kv[b]); kv[a] = hi_; kv[b] = lo_; }
                    CE(0, 1) CE(2, 3) CE(4, 5) CE(6, 7)  CE(0, 2) CE(1, 3) CE(4, 6) CE(5, 7)  CE(1, 2) CE(5, 6) CE(0, 4) CE(3, 7)  CE(1, 5) CE(2, 6)  CE(1, 4) CE(3, 6)  CE(2, 4) CE(3, 5)  CE(3, 4)
#undef CE
                    pt[s2] = (unsigned)(SEL_LIST + w * 4608 + s2 * 2304 + lane * 4);
#pragma unroll
                    for (int r = 0; r < 8; ++r) *(LAS unsigned*)(lds + pt[s2] + 256 * r) = kv[r];
                    *(LAS unsigned*)(lds + pt[s2] + 256 * 8) = 0u;
                    hd[s2] = kv[0]; }
                unsigned res0 = 0u, res1 = 0u;
#pragma unroll 1
                for (int rnd = 0; rnd < 16; ++rnd) {
                    const unsigned m0 = row_max_u32(hd[0]), m1 = row_max_u32(hd[1]);
                    pt[0] += (hd[0] == m0) ? 256u : 0u; pt[1] += (hd[1] == m1) ? 256u : 0u;
                    hd[0] = *(const LAS unsigned*)(lds + pt[0]); hd[1] = *(const LAS unsigned*)(lds + pt[1]);
                    res0 = (n == rnd) ? m0 : res0; res1 = (n == rnd) ? m1 : res1; }
                topk[p][i2] = res0; topk[p][i2 + 1] = res1; }
        }
#pragma unroll
        for (int i2 = 0; i2 < 4; i2 += 2) { unsigned hd[2], pt[2], res[2] = {0u, 0u};
#pragma unroll
            for (int s2 = 0; s2 < 2; ++s2) { const unsigned v0 = topk[0][i2 + s2], v1 = topk[1][i2 + s2]; unsigned cv[4];
#pragma unroll
                for (int reg = 0; reg < 4; ++reg) {
                    const unsigned a0 = (unsigned)__builtin_amdgcn_ds_bpermute(stA0[reg], (int)v0), a1 = (unsigned)__builtin_amdgcn_ds_bpermute(stA1[reg], (int)v1);
                    const float sm = unord_f32(a0 & ~127u) + unord_f32(a1 & ~127u);
                    cv[reg] = ((ord_f32(sm) & ~255u) | stTag[reg]) & stOk[reg]; }
#define CE(a, b) { const unsigned hi_ = max(cv[a], cv[b]), lo_ = min(cv[a], cv[b]); cv[a] = hi_; cv[b] = lo_; }
                CE(0, 1) CE(2, 3) CE(0, 2) CE(1, 3) CE(1, 2)
#undef CE
                pt[s2] = (unsigned)(SEL_LIST + w * 4608 + s2 * 2304 + lane * 4);
#pragma unroll
                for (int r = 0; r < 4; ++r) *(LAS unsigned*)(lds + pt[s2] + 256 * r) = cv[r];
                *(LAS unsigned*)(lds + pt[s2] + 256 * 4) = 0u;
                hd[s2] = cv[0]; }
#pragma unroll 1
            for (int rnd = 0; rnd < 16; ++rnd) {
                const unsigned m0 = row_max_u32(hd[0]), m1 = row_max_u32(hd[1]);
                pt[0] += (hd[0] == m0) ? 256u : 0u; pt[1] += (hd[1] == m1) ? 256u : 0u;
                hd[0] = *(const LAS unsigned*)(lds + pt[0]); hd[1] = *(const LAS unsigned*)(lds + pt[1]);
                res[0] = (n == rnd) ? m0 : res[0]; res[1] = (n == rnd) ? m1 : res[1]; }
#pragma unroll
            for (int s2 = 0; s2 < 2; ++s2) { const int i = i2 + s2; const unsigned v0 = topk[0][i], v1 = topk[1][i], rs = res[s2];
                const int flat = 255 - (int)(rs & 255u), fi = flat >> 4, fj = flat & 15;
                const unsigned k0 = (unsigned)__builtin_amdgcn_ds_bpermute((rowbase + fi) * 4, (int)v0), k1 = (unsigned)__builtin_amdgcn_ds_bpermute((rowbase + fj) * 4, (int)v1);
                const int expert = (127 - (int)(k0 & 127u)) * 128 + (127 - (int)(k1 & 127u));
                const float sc = unord_f32(rs & ~255u);
                const float mx = __int_as_float(__builtin_amdgcn_ds_bpermute(rowbase * 4, __float_as_int(sc)));
                const float e = __builtin_amdgcn_exp2f((sc - mx) * (LOG2E * HSC[tok0 + 4 * q + i]));
                const float g = e * __builtin_amdgcn_rcpf(row_sum_f32(e));
                const size_t oi = (size_t)(tok0 + 4 * q + i) * 128 + h * 16 + n;
                IDX[oi] = expert; GATE[oi] = g; } }
    }
    asm volatile("s_waitcnt vmcnt(0)" ::: "memory");
    __syncthreads();
    volatile LAS unsigned* hist = (volatile LAS unsigned*)(lds + 69632); LAS unsigned* pref = (LAS unsigned*)(lds + 69632) + 256; LAS unsigned* tot = (LAS unsigned*)(lds + 69632) + 512;
    if (tid < 256) hist[tid] = 0u;
    __syncthreads();
    unsigned myj[32], pads[16];
#pragma unroll
    for (int tt = 0; tt < 16; ++tt) {
#pragma unroll
        for (int hf = 0; hf < 2; ++hf) { const int i = 2 * tt + hf, p = (16 * w + tt) * 128 + hf * 64 + lane; const unsigned e = (unsigned)IDX[(size_t)unit * 16384 + p] & 16383u;
            myj[i] = e | (__hip_atomic_fetch_add((LAS unsigned*)(lds + 69632) + w * 32 + (int)((e & 31u) ^ gmix(e >> 5)), 1u, __ATOMIC_RELAXED, __HIP_MEMORY_SCOPE_WORKGROUP) << 14); }
        const unsigned c = hist[w * 32 + (lane & 31)]; const bool pad = (lane < 32) && (c & 1u);
        pads[tt] = pad ? c : 0xffffffffu;
        if (pad) hist[w * 32 + lane] = c + 1u; }
    __syncthreads();
    if (tid < 32) { unsigned t = 0u;
#pragma unroll
        for (int ww = 0; ww < 8; ++ww) t += hist[ww * 32 + tid];
        tot[tid] = t; }
    __syncthreads();
    if (tid < 32) { unsigned off = 0u; for (int j = 0; j < tid; ++j) off += tot[j];
        SEG[((size_t)unit * 32 + tid) * 2] = (unsigned)unit * (unsigned)POOLU + off; SEG[((size_t)unit * 32 + tid) * 2 + 1] = tot[tid];
#pragma unroll
        for (int ww = 0; ww < 8; ++ww) { pref[ww * 32 + tid] = off; off += hist[ww * 32 + tid]; } }
    __syncthreads();
#pragma unroll
    for (int i = 0; i < 32; ++i) { const int p = (16 * w + (i >> 1)) * 128 + (i & 1) * 64 + lane; const unsigned e = myj[i] & 16383u, j = (e & 31u) ^ gmix(e >> 5);
        const unsigned pos = (unsigned)unit * (unsigned)POOLU + pref[w * 32 + (int)j] + (myj[i] >> 14);
        ENT[pos] = ((unsigned)unit * 128u + ((unsigned)p >> 7)) | ((e >> 5) << 15); POS[(size_t)unit * 16384 + p] = pos; }
    if (lane < 32) { const unsigned pb_ = (unsigned)unit * (unsigned)POOLU + pref[w * 32 + lane];
#pragma unroll
        for (int tt = 0; tt < 16; ++tt) if (pads[tt] != 0xffffffffu) ENT[pb_ + pads[tt]] = (unsigned)unit * 128u + (unsigned)(16 * w + tt); }
    __syncthreads();
}
constexpr int EX_G1 = 0, EX_S1 = 16384, EX_G2 = 32768;
constexpr int EXG = 4;
#define DPP_ROR_I(x, n) __builtin_amdgcn_update_dpp(0, (x), 0x120 + (n), 0xf, 0xf, false)
__device__ __forceinline__ int wave_isum(int v) {
    v += DPP_ROR_I(v, 8); v += DPP_ROR_I(v, 4); v += DPP_ROR_I(v, 2); v += DPP_ROR_I(v, 1);
    return (__builtin_amdgcn_readlane(v, 0) + __builtin_amdgcn_readlane(v, 16)) + (__builtin_amdgcn_readlane(v, 32) + __builtin_amdgcn_readlane(v, 48));
}
__device__ __forceinline__ void ex_load_rows(u32x4 (&buf)[EXG][2], const unsigned char* tab, int e0reg, int e1reg, int grp, int lane) {
    const int ereg = (grp < 16) ? e0reg : e1reg; const int k0 = (grp & 15) * EXG;
#pragma unroll
    for (int j = 0; j < EXG; ++j) { const int e = __builtin_amdgcn_readlane(ereg, k0 + j) & 16383; const u32x4* rp = (const u32x4*)(tab + (size_t)e * D) + lane;
        buf[j][0] = rp[0]; buf[j][1] = rp[64]; }
}
__device__ __forceinline__ void ex_dots(const u32x4 (&buf)[EXG][2], const u32x4 (&hq)[2], int& d0, int& d1, int grp, int lane) {
#pragma unroll
    for (int j = 0; j < EXG; ++j) { int a = 0;
#pragma unroll
        for (int c = 0; c < 2; ++c) { a = __builtin_amdgcn_sdot4((int)buf[j][c].x, (int)hq[c].x, a, false); a = __builtin_amdgcn_sdot4((int)buf[j][c].y, (int)hq[c].y, a, false);
            a = __builtin_amdgcn_sdot4((int)buf[j][c].z, (int)hq[c].z, a, false); a = __builtin_amdgcn_sdot4((int)buf[j][c].w, (int)hq[c].w, a, false); }
        a = wave_isum(a);
        const int kk = grp * EXG + j;
        d0 = (lane == kk) ? a : d0; d1 = (lane + 64 == kk) ? a : d1; }
}
__device__ __forceinline__ void peer_u_phase(const bf16_t* H, const int* IDX, const float* GATE, const unsigned char* U, const float* SU, const float* SV, unsigned* WE, float* WSC, int bx, int G, int wave, int lane) {
    for (int tt = bx * 64 + wave * 8; tt < T; tt += ((tt & 7) == 7) ? (G * 64 - 7) : 1) { const int t = tt;
        u32x4 hq[2]; float hs;
        { u32x4 hv[2][2]; float am = 0.f;
#pragma unroll
          for (int c = 0; c < 2; ++c) { const u32x4* hp = (const u32x4*)(H + (size_t)t * D + 1024 * c + 16 * lane); hv[c][0] = hp[0]; hv[c][1] = hp[1];
#pragma unroll
              for (int i = 0; i < 2; ++i)
#pragma unroll
                  for (int d = 0; d < 4; ++d) am = fmaxf(am, fmaxf(fabsf(bflo(hv[c][i][d])), fabsf(bfhi(hv[c][i][d])))); }
#pragma unroll
          for (int o = 1; o < 64; o <<= 1) am = fmaxf(am, __shfl_xor(am, o));
          hs = am > 0.f ? am * (1.0f / 127.0f) : 1.0f; const float inv = 1.0f / hs;
#pragma unroll
          for (int c = 0; c < 2; ++c)
#pragma unroll
              for (int i = 0; i < 2; ++i)
#pragma unroll
                  for (int dd = 0; dd < 2; ++dd) { const unsigned p0 = hv[c][i][2 * dd], p1 = hv[c][i][2 * dd + 1];
                      const unsigned q0 = (unsigned)(int)rintf(bflo(p0) * inv) & 255u, q1 = (unsigned)(int)rintf(bfhi(p0) * inv) & 255u, q2 = (unsigned)(int)rintf(bflo(p1) * inv) & 255u, q3 = (unsigned)(int)rintf(bfhi(p1) * inv) & 255u;
                      hq[c][2 * i + dd] = q0 | (q1 << 8) | (q2 << 16) | (q3 << 24); } }
        const int e0 = IDX[(size_t)t * 128 + lane] & 16383, e1 = IDX[(size_t)t * 128 + 64 + lane] & 16383;
        const float g0 = GATE[(size_t)t * 128 + lane], g1 = GATE[(size_t)t * 128 + 64 + lane];
        const float su0 = SU[e0], su1 = SU[e1], sv0 = SV[e0], sv1 = SV[e1];
        int d0 = 0, d1 = 0;
        u32x4 bA[EXG][2], bB[EXG][2];
        ex_load_rows(bA, U, e0, e1, 0, lane);
#pragma unroll 1
        for (int g = 0; g < 32; g += 2) {
            ex_load_rows(bB, U, e0, e1, g + 1, lane); ex_dots(bA, hq, d0, d1, g, lane);
            ex_load_rows(bA, U, e0, e1, (g + 2 < 32) ? g + 2 : 31, lane); ex_dots(bB, hq, d0, d1, g + 1, lane); }
        asm volatile("s_waitcnt vmcnt(0)" ::: "memory");
        const float w0 = g0 * pg8::gelu_tanh((float)d0 * su0 * hs) * sv0, w1 = g1 * pg8::gelu_tanh((float)d1 * su1 * hs) * sv1;
        float wam = fmaxf(fabsf(w0), fabsf(w1));
#pragma unroll
        for (int o = 1; o < 64; o <<= 1) wam = fmaxf(wam, __shfl_xor(wam, o));
        const float wsc = wam > 0.f ? wam * (1.0f / 127.0f) : 1.0f, winv = 1.0f / wsc;
        const int q0 = (int)rintf(w0 * winv) & 255, q1 = (int)rintf(w1 * winv) & 255;
#define QB(v, j) __builtin_amdgcn_update_dpp(0, (v), (j) * 0x55, 0xf, 0xf, false)
        u32x4 qa, qb;
        qa.x = (unsigned)(q0 | (QB(q0, 1) << 8) | (QB(q0, 2) << 16) | (QB(q0, 3) << 24)); qa.y = (unsigned)(e0 | (QB(e0, 1) << 16)); qa.z = (unsigned)(QB(e0, 2) | (QB(e0, 3) << 16)); qa.w = 0u;
        qb.x = (unsigned)(q1 | (QB(q1, 1) << 8) | (QB(q1, 2) << 16) | (QB(q1, 3) << 24)); qb.y = (unsigned)(e1 | (QB(e1, 1) << 16)); qb.z = (unsigned)(QB(e1, 2) | (QB(e1, 3) << 16)); qb.w = 0u;
#undef QB
        if ((lane & 3) == 0) { u32x4* qp = (u32x4*)WE + (size_t)(t >> 6) * 2048 + (t & 63);
            qp[(lane >> 2) * 64] = qa; qp[(16 + (lane >> 2)) * 64] = qb; }
        if (lane == 0) WSC[t] = wsc;
    }
}
__device__ __forceinline__ void peer_u_lds(LAS unsigned char* lds, const unsigned char* U, const unsigned char* HQ, const unsigned* ENT, const unsigned* SEG, int* PART, int j, int sl, int tid) {
#pragma unroll 4
    for (int i = 0; i < 16; ++i) { const int id = tid + NTHREADS * i, el = id >> 4, c = id & 15;
        *(LAS u32x4*)(lds + el * 256 + 16 * c) = *(const u32x4*)(U + (size_t)(el * 32 + (int)(((unsigned)j ^ gmix((unsigned)el)) & 31u)) * D + 256 * sl + 16 * c); }
    __syncthreads();
    const int lane = tid & 63, w = __builtin_amdgcn_readfirstlane(tid >> 6), p4 = lane & 3, eq = lane >> 2;
    const unsigned char* hqb = HQ + 256 * sl;
    unsigned lco[4];
    const int fb = (eq & 7) >> 1;
    int* part = PART + (size_t)sl * NPOOL;
#pragma unroll
    for (int i = 0; i < 4; ++i) lco[i] = (unsigned)(64 * (i ^ fb) + 16 * p4);
    int offv = 0, cntv = 0;
    if (lane < 32) { offv = (int)SEG[((size_t)(w + 8 * lane) * 32 + j) * 2]; cntv = (int)(SEG[((size_t)(w + 8 * lane) * 32 + j) * 2 + 1] >> 1); }
    struct Trip { int si, b0, off, cnt; };
    auto first_trip = [&](Trip& tr) { tr.si = 0; tr.b0 = 0; tr.off = __builtin_amdgcn_readlane(offv, 0); tr.cnt = __builtin_amdgcn_readlane(cntv, 0);
        while (tr.si < 32 && tr.b0 >= tr.cnt) { ++tr.si; if (tr.si < 32) { tr.off = __builtin_amdgcn_readlane(offv, tr.si); tr.cnt = __builtin_amdgcn_readlane(cntv, tr.si); tr.b0 = 0; } } };
    auto next_trip = [&](Trip& tr) { if (tr.si >= 32) return; tr.b0 += 64;
        while (tr.si < 32 && tr.b0 >= tr.cnt) { ++tr.si; if (tr.si < 32) { tr.off = __builtin_amdgcn_readlane(offv, tr.si); tr.cnt = __builtin_amdgcn_readlane(cntv, tr.si); tr.b0 = 0; } } };
#define QBC(v, sb) ((unsigned)__builtin_amdgcn_update_dpp(0, (int)(v), (sb) * 0x55, 0xf, 0xf, false))
#define LOAD_OWN(dst, tr) do { const int idx = (tr).b0 + 16 * p4 + eq; const bool ok = (tr).si < 32 && idx < (tr).cnt; (dst) = *(const u32x2*)(ENT + (ok ? (unsigned)((tr).off + 2 * idx) : 0u)); } while (0)
#define HQ_SB(dst, o, sb) do { const unsigned tof_ = (QBC((o).x, sb) & 32767u) << 11; _Pragma("unroll") for (int i = 0; i < 4; ++i) (dst)[sb][i] = *(const u32x4*)(hqb + (tof_ + lco[i])); } while (0)
#define LOAD_HQ(dst, o) do { HQ_SB(dst, o, 0); HQ_SB(dst, o, 1); HQ_SB(dst, o, 2); HQ_SB(dst, o, 3); } while (0)
#define SB_BODY(sb, o, hb_, hbn_, on_) do { \
        HQ_SB(hbn_, on_, sb);     \
        const unsigned el0 = QBC((o).x, sb) >> 15, el1 = QBC((o).y, sb) >> 15; int acc0 = 0, acc1 = 0; \
        _Pragma("unroll") for (int i = 0; i < 4; ++i) { const u32x4 ua = *(const LAS u32x4*)(lds + (el0 * 256u + lco[i])), ub = *(const LAS u32x4*)(lds + (el1 * 256u + lco[i])); \
            acc0 = __builtin_amdgcn_sdot4((int)ua.x, (int)(hb_)[sb][i].x, acc0, false); acc1 = __builtin_amdgcn_sdot4((int)ub.x, (int)(hb_)[sb][i].x, acc1, false); \
            acc0 = __builtin_amdgcn_sdot4((int)ua.y, (int)(hb_)[sb][i].y, acc0, false); acc1 = __builtin_amdgcn_sdot4((int)ub.y, (int)(hb_)[sb][i].y, acc1, false); \
            acc0 = __builtin_amdgcn_sdot4((int)ua.z, (int)(hb_)[sb][i].z, acc0, false); acc1 = __builtin_amdgcn_sdot4((int)ub.z, (int)(hb_)[sb][i].z, acc1, false); \
            acc0 = __builtin_amdgcn_sdot4((int)ua.w, (int)(hb_)[sb][i].w, acc0, false); acc1 = __builtin_amdgcn_sdot4((int)ub.w, (int)(hb_)[sb][i].w, acc1, false); } \
        acc0 += __builtin_amdgcn_update_dpp(0, acc0, 0xB1, 0xf, 0xf, false); acc1 += __builtin_amdgcn_update_dpp(0, acc1, 0xB1, 0xf, 0xf, false); \
        acc0 += __builtin_amdgcn_update_dpp(0, acc0, 0x4E, 0xf, 0xf, false); acc1 += __builtin_amdgcn_update_dpp(0, acc1, 0x4E, 0xf, 0xf, false); \
        res0_ = (p4 == sb) ? acc0 : res0_; res1_ = (p4 == sb) ? acc1 : res1_; } while (0)
#define COMPUTE(tr, o, hb_, hbn_, on_) do { int res0_ = 0, res1_ = 0; SB_BODY(0, o, hb_, hbn_, on_); SB_BODY(1, o, hb_, hbn_, on_); SB_BODY(2, o, hb_, hbn_, on_); SB_BODY(3, o, hb_, hbn_, on_); \
        const int idx = (tr).b0 + 16 * p4 + eq; if ((tr).si < 32 && idx < (tr).cnt) { u32x2 r_; r_.x = (unsigned)res0_; r_.y = (unsigned)res1_; *(u32x2*)(part + ((tr).off + 2 * idx)) = r_; } } while (0)
    Trip tA, tB, tC;
    first_trip(tA); tB = tA; next_trip(tB); tC = tB; next_trip(tC);
    u32x2 oA, oB, oC; u32x4 h0[4][4], h1[4][4];
    LOAD_OWN(oA, tA); LOAD_OWN(oB, tB);
    LOAD_HQ(h0, oA);
    while (tA.si < 32) {
        LOAD_OWN(oC, tC); COMPUTE(tA, oA, h0, h1, oB);
        tA = tB; tB = tC; next_trip(tC); oA = oB; oB = oC;
        if (tA.si >= 32) break;
        LOAD_OWN(oC, tC); COMPUTE(tA, oA, h1, h0, oB);
        tA = tB; tB = tC; next_trip(tC); oA = oB; oB = oC;
    }
#undef QBC
#undef LOAD_OWN
#undef HQ_SB
#undef LOAD_HQ
#undef SB_BODY
#undef COMPUTE
    asm volatile("s_waitcnt vmcnt(0)" ::: "memory");
    __syncthreads();
}
__device__ __forceinline__ void peer_reduce_unit(LAS unsigned char* lds, const int* IDX, const float* GATE, const unsigned* POS, const int* PART, const float* HSC, const float* SU, const float* SV, unsigned* WE, float* WSC, int unit, int tid) {
    const int lane = tid & 63, w = tid >> 6;
    LAS int* dl = (LAS int*)lds; const unsigned pbase = (unsigned)unit * (unsigned)POOLU;
    __syncthreads();
    for (int i = tid; i < POOLU / 4; i += NTHREADS) { pg8::i32x4 acc = *(const pg8::i32x4*)(PART + (size_t)pbase + 4 * i);
#pragma unroll
        for (int s8 = 1; s8 < 8; ++s8) acc += *(const pg8::i32x4*)(PART + (size_t)s8 * NPOOL + pbase + 4 * i);
        *(LAS pg8::i32x4*)(dl + 4 * i) = acc; }
    __syncthreads();
    constexpr int TU = 4;
    for (int i0 = 0; i0 < 16; i0 += TU) {
        int e0[TU], e1[TU]; float g0[TU], g1[TU]; unsigned p0[TU], p1[TU]; float hs[TU];
#pragma unroll
        for (int u = 0; u < TU; ++u) { const size_t tb = (size_t)(unit * 128 + w * 16 + i0 + u) * 128;
            e0[u] = IDX[tb + lane] & 16383; e1[u] = IDX[tb + 64 + lane] & 16383; g0[u] = GATE[tb + lane]; g1[u] = GATE[tb + 64 + lane]; p0[u] = POS[tb + lane]; p1[u] = POS[tb + 64 + lane];
            hs[u] = HSC[unit * 128 + w * 16 + i0 + u]; }
        int d0[TU], d1[TU]; float su0[TU], su1[TU], sv0[TU], sv1[TU];
#pragma unroll
        for (int u = 0; u < TU; ++u) { d0[u] = dl[p0[u] - pbase]; d1[u] = dl[p1[u] - pbase];
            su0[u] = SU[e0[u]]; su1[u] = SU[e1[u]]; sv0[u] = SV[e0[u]]; sv1[u] = SV[e1[u]]; }
#pragma unroll
        for (int u = 0; u < TU; ++u) { const int t = unit * 128 + w * 16 + i0 + u;
            const float w0 = g0[u] * pg8::gelu_tanh((float)d0[u] * su0[u] * hs[u]) * sv0[u], w1 = g1[u] * pg8::gelu_tanh((float)d1[u] * su1[u] * hs[u]) * sv1[u];
            float wam = fmaxf(fabsf(w0), fabsf(w1));
#pragma unroll
            for (int o = 1; o < 64; o <<= 1) wam = fmaxf(wam, __shfl_xor(wam, o));
            const float wsc = wam > 0.f ? wam * (1.0f / 127.0f) : 1.0f, winv = 1.0f / wsc;
            const int q0 = (int)rintf(w0 * winv) & 255, q1 = (int)rintf(w1 * winv) & 255;
#define QB(v, jj) __builtin_amdgcn_update_dpp(0, (v), (jj) * 0x55, 0xf, 0xf, false)
            u32x4 qa, qb; const int ea = e0[u], eb = e1[u];
            qa.x = (unsigned)(q0 | (QB(q0, 1) << 8) | (QB(q0, 2) << 16) | (QB(q0, 3) << 24)); qa.y = (unsigned)(ea | (QB(ea, 1) << 16)); qa.z = (unsigned)(QB(ea, 2) | (QB(ea, 3) << 16)); qa.w = 0u;
            qb.x = (unsigned)(q1 | (QB(q1, 1) << 8) | (QB(q1, 2) << 16) | (QB(q1, 3) << 24)); qb.y = (unsigned)(eb | (QB(eb, 1) << 16)); qb.z = (unsigned)(QB(eb, 2) | (QB(eb, 3) << 16)); qb.w = 0u;
#undef QB
            if ((lane & 3) == 0) { u32x3* qp = (u32x3*)WE + (size_t)(t >> 6) * 2048 + (t & 63);
                u32x3 a3, b3; a3.x = qa.x; a3.y = qa.y; a3.z = qa.z; b3.x = qb.x; b3.y = qb.y; b3.z = qb.z; qp[(lane >> 2) * 64] = a3; qp[(16 + (lane >> 2)) * 64] = b3; }
            if (lane == 0) WSC[t] = wsc; }
    }
}
__device__ __forceinline__ unsigned lo16x8(unsigned x) { unsigned r; const unsigned three = 3u; asm("v_lshlrev_b32_sdwa %0, %1, %2 dst_sel:DWORD dst_unused:UNUSED_PAD src0_sel:DWORD src1_sel:WORD_0" : "=v"(r) : "v"(three), "v"(x)); return r; }
__device__ __forceinline__ void peer_v_slice(LAS unsigned char* lds, const unsigned char* VSl, const unsigned* WE, const float* WSC, bf16_t* XR, const float* g2mod, int sl, int tid) {
    { const u32x4* src = (const u32x4*)(VSl + (size_t)sl * 131072);
#pragma unroll 4
      for (int i = 0; i < 16; ++i) { const int idx = tid + NTHREADS * i; *(LAS u32x4*)(lds + idx * 16) = src[idx]; } }
    __syncthreads();
    const int lane = tid & 63, w = tid >> 6;
    constexpr int VQ = 16;
    const int rot = 37 * (sl >> 3);
    u32x3 cur[VQ], nxt[VQ];
    { const u32x3* wp0 = (const u32x3*)WE + (size_t)((w + rot) & (T / 64 - 1)) * 2048 + lane;
#pragma unroll
      for (int i = 0; i < VQ; ++i) cur[i] = wp0[64 * i]; }
    for (int tbi = w; tbi < T / 64; tbi += NWAVES) {
        const int tb = (tbi + rot) & (T / 64 - 1);
        const int tbn = (((tbi + NWAVES < T / 64) ? tbi + NWAVES : tbi) + rot) & (T / 64 - 1);
        const int t = tb * 64 + lane, b = t >> 14;
        const float wsc = WSC[t];
        int acc[8];
#pragma unroll
        for (int j = 0; j < 8; ++j) acc[j] = 0;
#define V_HALF(CUR, NXT, WPN) do { { const u32x3* wpn = (WPN); _Pragma("unroll") for (int i = 0; i < VQ; ++i) (NXT)[i] = wpn[64 * i]; } \
            _Pragma("unroll") for (int sb = 0; sb < VQ; sb += 4) { u32x2 row[4][4]; \
                _Pragma("unroll") for (int i = 0; i < 4; ++i) { row[i][0] = *(const LAS u32x2*)(lds + lo16x8((CUR)[sb + i].y)); row[i][1] = *(const LAS u32x2*)(lds + ((CUR)[sb + i].y >> 16) * 8); \
                    row[i][2] = *(const LAS u32x2*)(lds + lo16x8((CUR)[sb + i].z)); row[i][3] = *(const LAS u32x2*)(lds + ((CUR)[sb + i].z >> 16) * 8); } \
                _Pragma("unroll") for (int i = 0; i < 4; ++i) { const int wq = (int)(CUR)[sb + i].x; \
                      \
                    _Pragma("unroll") for (int hh = 0; hh < 2; ++hh) { const unsigned r0 = row[i][0][hh], r1 = row[i][1][hh], r2 = row[i][2][hh], r3 = row[i][3][hh]; \
                        const unsigned t0 = __builtin_amdgcn_perm(r1, r0, 0x05010400u), t1 = __builtin_amdgcn_perm(r1, r0, 0x07030602u); \
                        const unsigned t2 = __builtin_amdgcn_perm(r3, r2, 0x05010400u), t3 = __builtin_amdgcn_perm(r3, r2, 0x07030602u); \
                        const unsigned c0 = __builtin_amdgcn_perm(t2, t0, 0x05040100u), c1 = __builtin_amdgcn_perm(t2, t0, 0x07060302u); \
                        const unsigned c2 = __builtin_amdgcn_perm(t3, t1, 0x05040100u), c3 = __builtin_amdgcn_perm(t3, t1, 0x07060302u); \
                        acc[4 * hh + 0] = __builtin_amdgcn_sdot4((int)c0, wq, acc[4 * hh + 0], false); acc[4 * hh + 1] = __builtin_amdgcn_sdot4((int)c1, wq, acc[4 * hh + 1], false); \
                        acc[4 * hh + 2] = __builtin_amdgcn_sdot4((int)c2, wq, acc[4 * hh + 2], false); acc[4 * hh + 3] = __builtin_amdgcn_sdot4((int)c3, wq, acc[4 * hh + 3], false); } } \
                __builtin_amdgcn_sched_barrier(0); } } while (0)
        V_HALF(cur, nxt, (const u32x3*)WE + (size_t)tb * 2048 + lane + 64 * VQ);
        V_HALF(nxt, cur, (const u32x3*)WE + (size_t)tbn * 2048 + lane);
#undef V_HALF
        u32x4* xr = (u32x4*)(XR + (size_t)t * D + 8 * sl); const float* gp = g2mod + (size_t)b * 12288 + 8 * sl;
        const u32x4 xx = *xr; const f32x4 ga = *(const f32x4*)gp, gb = *(const f32x4*)(gp + 4);
        u32x4 o; o.x = pk2(bflo(xx.x) + ga.x * (wsc * (float)acc[0]), bfhi(xx.x) + ga.y * (wsc * (float)acc[1])); o.y = pk2(bflo(xx.y) + ga.z * (wsc * (float)acc[2]), bfhi(xx.y) + ga.w * (wsc * (float)acc[3]));
        o.z = pk2(bflo(xx.z) + gb.x * (wsc * (float)acc[4]), bfhi(xx.z) + gb.y * (wsc * (float)acc[5])); o.w = pk2(bflo(xx.w) + gb.z * (wsc * (float)acc[6]), bfhi(xx.w) + gb.w * (wsc * (float)acc[7]));
        *xr = o;
    }
    __syncthreads();
}
__device__ __forceinline__ void norm_row_final(float* xrow, const float* g, int lane) {
    f32x4 v[8]; float ss = 0.f;
#pragma unroll
    for (int j = 0; j < 8; ++j) { v[j] = *(const f32x4*)(xrow + 4 * lane + 256 * j); ss += (v[j].x * v[j].x + v[j].y * v[j].y) + (v[j].z * v[j].z + v[j].w * v[j].w); }
    ss = wave_sum(ss);
    const float rstd = rsqrtf(ss * (1.0f / D) + EPS);
#pragma unroll
    for (int j = 0; j < 8; ++j) { const f32x4 gg = *(const f32x4*)(g + 4 * lane + 256 * j); *(f32x4*)(xrow + 4 * lane + 256 * j) = v[j] * rstd * gg; }
}

constexpr int NPHASES = 23;
struct Args { const float* in[26]; float* out; unsigned char* ws; int ph_lo, ph_hi; };

__global__ void __launch_bounds__(NTHREADS, 2) fwd_kernel(Args args) {
    extern __shared__ __attribute__((aligned(16))) unsigned char lds_raw[];
    (void)lds_raw;
    LAS unsigned char* lds = (LAS unsigned char*)(uintptr_t)0u;
    int tid = threadIdx.x; const int lane = tid & 63, wave = __builtin_amdgcn_readfirstlane(tid >> 6);
    const int G = gridDim.x, bx = blockIdx.x;
    const int gw = bx * NWAVES + wave, ngw = G * NWAVES, gtid = bx * NTHREADS + tid, nthr = G * NTHREADS;
    unsigned char* ws = args.ws;
    for (int u = tid; u < (LDS_BYTES - MISC_OFF) / 4; u += NTHREADS) ((LAS unsigned*)(lds + MISC_OFF))[u] = 0u;
    __syncthreads();
    const int lo = args.ph_lo, hi = args.ph_hi;
    unsigned* barw = (unsigned*)(ws + WS_CTL) + CW_BAR;
    XcdBarrier bar; bar.bar = barw; bar.x = 0; bar.st = (volatile LAS unsigned*)(lds + MISC_OFF + 32);
    if (hi - lo > 1) bar = xcd_barrier_post(barw, (volatile LAS unsigned*)(lds + MISC_OFF + 32));
#ifndef PHMASK
#define PHMASK 0xFFFFFFu
#endif
#define IN(k) (lo <= (k) && (k) < hi)
#define ON(j) (((PHMASK) >> (j)) & 1u)
#define SEAM(k) do { if (IN(k) && IN((k) + 1)) xcd_barrier(bar); asm volatile("" : "+v"(tid)); } while (0)

    float* MOD = (float*)(ws + WS_MOD); float* MODC = (float*)(ws + WS_MODC);
    bf16_t* HB = (bf16_t*)(ws + WS_H); bf16_t* GGB = (bf16_t*)(ws + WS_GG); bf16_t* XBB = (bf16_t*)(ws + WS_XB);
    bf16_t* HC = (bf16_t*)(ws + WS_HC); bf16_t* XBC = (bf16_t*)(ws + WS_XBC);
    bf16_t* XR = (bf16_t*)(ws + WS_XR);

    if (ON(0) && IN(0)) {
        if (G == 256) { if (bx < 128) for (int item = bx; item < 192; item += 128) p0_gemv(lds, args.in[1], args.in[3], args.in[4], args.in[5], MOD, MODC, item, tid); }
        else for (int item = bx; item < 192; item += G) p0_gemv(lds, args.in[1], args.in[3], args.in[4], args.in[5], MOD, MODC, item, tid);
        for (int it = (G == 256) ? ((bx >= 128) ? bx - 128 : 128) : (G - 1 - bx); it < 128; it += G) {
            if (it >= 112) p0_quant_strip(lds, args.in[21], D, 128 * (it - 112), ws + WS_WOUT1, (float*)(ws + WS_CS0) + 4096 + 6144 + 2 * D, 128 * (it - 112), tid);
            else if (it >= 80) { const int L = (it - 80) >> 4, st = (it - 80) & 15;
                p0_quant_strip(lds, args.in[22] + (size_t)L * D * D, D, 128 * st, ws + WS_WQ + (size_t)L * D * D, (float*)(ws + WS_CS0) + 4096 + 6144 + L * D, 128 * st, tid); }
            else if (it < 32) p0_quant_strip(lds, args.in[9], 4096, 128 * it, ws + WS_WIN0, (float*)(ws + WS_CS0), 128 * it, tid);
            else { const int col0 = 128 * (it - 32); int nb;
                if (col0 < 2048) nb = col0; else if (col0 < 4096) nb = 2048 + ((col0 - 2048) >> 7) * 256; else nb = 2048 + ((col0 - 4096) >> 7) * 256 + 128;
                p0_quant_strip(lds, args.in[18], 6144, col0, ws + WS_WIN1, (float*)(ws + WS_CS0) + 4096, nb, tid); } }
        LAS float* scr = (LAS float*)(lds + wave * 16384);
        constexpr int I_WOUT = 32 * 64, I_GATE = 64 * 8;
        constexpr int NITEMS = I_WOUT + I_WOUT + I_GATE;
        for (int it = gw; it < NITEMS; it += ngw) {
            int r = it;
            if (r < I_WOUT) { p0_transpose_item(args.in[9] + 2048, D, D, 4096, (bf16_t*)(ws + WS_WIN0C), 0, scr, r, lane); continue; } r -= I_WOUT;
            if (r < I_WOUT) { p0_transpose_item(args.in[17], D, D, D, (bf16_t*)(ws + WS_WOUT0), 0, scr, r, lane); continue; } r -= I_WOUT;
            { const int mtx = r >> 3, dir = mtx >> 5, g = (mtx >> 4) & 1, h = mtx & 15;
              const float* srcw = (g == 0 ? args.in[12] : args.in[14]) + (size_t)(dir * 16 + h) * 16384;
              p0_transpose_item(srcw, 128, 128, 128, (bf16_t*)(ws + WS_GW) + (size_t)mtx * 16384, 0, scr, r & 7, lane, -LOG2E); }
        }
        { f32x4 ra[2][4], rb[2][4];
          p0_row_load(ra, args.in[24] + (size_t)gw * D, lane);
          for (int row = gw; row < 2 * 16384; row += 2 * ngw) {
              const int r1 = row + ngw, r1c = (r1 < 2 * 16384) ? r1 : row, r2 = (row + 2 * ngw < 2 * 16384) ? row + 2 * ngw : row;
              p0_row_load(rb, args.in[24] + (size_t)r1c * D, lane);
              p0_row_quant(ra, ws + WS_U + (size_t)row * D, (float*)(ws + WS_SCL) + row, 0, lane, false, 0, lds);
              p0_row_load(ra, args.in[24] + (size_t)r2 * D, lane);
              if (r1 < 2 * 16384) p0_row_quant(rb, ws + WS_U + (size_t)r1 * D, (float*)(ws + WS_SCL) + r1, 0, lane, false, 0, lds); } }
        for (int grp = bx; grp < 2 * 1024; grp += G) {
            __syncthreads();
            { f32x4 ra[2][4], rb[2][4]; const int r16 = wave * 2, rr = grp * 16 + r16;
              p0_row_load(ra, args.in[25] + (size_t)rr * D, lane); p0_row_load(rb, args.in[25] + (size_t)(rr + 1) * D, lane);
              p0_row_quant(ra, (unsigned char*)nullptr, (float*)(ws + WS_SCL) + 32768 + rr, 0, lane, true, r16, lds);
              p0_row_quant(rb, (unsigned char*)nullptr, (float*)(ws + WS_SCL) + 32768 + rr + 1, 0, lane, true, r16 + 1, lds); }
            __syncthreads();
            unsigned char* vbase = ws + WS_V + (size_t)(grp >> 10) * 16384 * D; const int e0g = (grp & 1023) * 16;
#pragma unroll
            for (int i = 0; i < 8; ++i) { const int idx = tid + NTHREADS * i, sl = idx >> 4, ee = idx & 15;
                const u32x2 v8 = *(const LAS u32x2*)(lds + ee * 2048 + sl * 8);
                *(u32x2*)(vbase + ((size_t)sl * 16384 + e0g + ee) * 8) = v8; }
        }
        __syncthreads();
    }
    SEAM(0);
    if (ON(1) && IN(1)) {
        LAS float* Gs = (LAS float*)lds; LAS float* Ss = (LAS float*)(lds + 16384); LAS float* Gc = (LAS float*)(lds + 32768); LAS float* Sc = (LAS float*)(lds + 40960);
        fill_mod_lds(Gs, Ss, args.in[6], MOD, 0, 1, tid);
        for (int i = tid; i < D; i += NTHREADS) { Gc[i] = args.in[6][i] * (1.0f + MODC[D + i]); Sc[i] = MODC[i]; }
        __syncthreads();
        for (int m = gw; m < T; m += ngw) { const int b = m >> 14; norm_row_q8(args.in[0] + (size_t)m * D, Gs + b * D, Ss + b * D, (unsigned*)(ws + WS_H) + (size_t)m * 512, (float*)(ws + WS_HSA) + m, lane); }
        for (int m = gw; m < TC; m += ngw) norm_row_store(args.in[2] + (size_t)m * D, Gc, Sc, HC + (size_t)m * D, lane);
        for (size_t i = (size_t)gtid * 8; i < (size_t)2 * 8 * 2 * 128 * 128; i += (size_t)nthr * 8) { const int L_ = (int)(i >> 18), hp = (int)(i >> 14) & 15, d0 = (int)i & 127;
            const float* cq = (const float*)(ws + WS_CS0) + 4096 + 6144 + L_ * D + hp * 128 + d0; const f32x4 c0 = *(const f32x4*)cq, c1 = *(const f32x4*)(cq + 4);
            const f32x4 a = *(const f32x4*)(args.in[23] + i) * c0, b = *(const f32x4*)(args.in[23] + i + 4) * c1;
            u32x4 o; o.x = pk2(a.x, a.y); o.y = pk2(a.z, a.w); o.z = pk2(b.x, b.y); o.w = pk2(b.z, b.w); *(u32x4*)((bf16_t*)(ws + WS_KEYS) + i) = o; }
        __syncthreads();
    }
    SEAM(1);
    if (ON(2) && IN(2)) {
        { pg8::Gemm g{HB, (const bf16_t*)(ws + WS_WIN0), T, 4096, D / 2}; pg8::StaticOrder S; S.init(T, 4096, G, bx);
          pg8::EpiGateXbI8 E{GGB, XBB, (const float*)(ws + WS_HSA), (const float*)(ws + WS_CS0)};
          pg8::gemm_phase<pg8::EpiGateXbI8, pg8::StaticOrder, true, true>(lds, g, S, E); }
        for (int tile = bx; tile < 256; tile += G) ctx_gemm_tile(HC, (const bf16_t*)(ws + WS_WIN0C), XBC, tile, tid);
    }
    SEAM(2);
    if (ON(3) && IN(3)) {
        for (int u = bx; u < 256; u += G) scan_unit<1>(lds, args.in[10], args.in[11], args.in[13], args.in[15], args.in[16], ws, false, u >> 7, (u >> 3) & 15, u & 7, tid);
        for (int u = bx; u < 256; u += G) scan_ctx_tile(lds, args.in[10], args.in[11], args.in[13], args.in[15], args.in[16], ws, u >> 7, (u >> 3) & 15, (u >> 2) & 1, u & 3, tid);
    }
    SEAM(3);
    if (ON(4) && IN(4)) {
        for (int u = bx; u < 256; u += G) scan_unit<2>(lds, args.in[10], args.in[11], args.in[13], args.in[15], args.in[16], ws, false, u >> 7, (u >> 3) & 15, u & 7, tid);
    }
    SEAM(4);
    {
    constexpr int pb = 5;
    const float* modL = MOD + (size_t)0 * 2 * 12288;
    if (ON(17) && IN(pb)) {
        pg8::Gemm g{HB, (const bf16_t*)(ws + WS_WOUT0), T, D, D}; pg8::StaticOrder S; S.init(T, D, G, bx);
        pg8::EpiResidBf<true> E{args.in[0], nullptr, XR, modL + 2 * D, 12288};
        pg8::gemm_phase<pg8::EpiResidBf<true>, pg8::StaticOrder, true, true>(lds, g, S, E);
    }
    SEAM(pb);
    if (ON(18) && IN(pb + 1)) {
        LAS float* Gs = (LAS float*)lds; LAS float* Ss = (LAS float*)(lds + 16384);
        fill_mod_lds(Gs, Ss, args.in[7] + (size_t)0 * D, modL, 3, 4, tid);
        __syncthreads();
        for (int m = gw; m < T; m += ngw) { const int b = m >> 14; norm_row_store_h<true, false>(XR + (size_t)m * D, Gs + b * D, Ss + b * D, nullptr, (unsigned*)(ws + WS_HQ) + (size_t)m * 512, (float*)(ws + WS_HSC) + m, lane); }
        __syncthreads();
    }
    SEAM(pb + 1);
    if (ON(19) && IN(pb + 2)) {
        pg8::Gemm g{(const bf16_t*)(ws + WS_HQ), (const bf16_t*)(ws + WS_WQ + (size_t)0 * D * D), T, D, D / 2}; pg8::StaticOrder S; S.init(T, D, G, bx);
        pg8::EpiRawI8 E{GGB, D};
        pg8::gemm_phase<pg8::EpiRawI8, pg8::StaticOrder, true, true>(lds, g, S, E);
    }
    SEAM(pb + 2);
    if (ON(20) && IN(pb + 3)) {
        for (int u = bx; u < T / 128; u += G) peer_select_unit(lds, GGB, (const bf16_t*)(ws + WS_KEYS) + (size_t)0 * 262144, (const float*)(ws + WS_HSC), (int*)(ws + WS_IDX), (float*)(ws + WS_GATE), (unsigned*)(ws + WS_ENT), (unsigned*)(ws + WS_POS), (unsigned*)(ws + WS_SEG), u, tid);
        __syncthreads();
    }
    SEAM(pb + 3);
    if (ON(21) && IN(pb + 4)) {
        for (int un = bx; un < 256; un += G) peer_u_lds(lds, ws + WS_U + (size_t)0 * 16384 * D, ws + WS_HQ, (const unsigned*)(ws + WS_ENT), (const unsigned*)(ws + WS_SEG), (int*)(ws + WS_PART), (G == 256) ? (un >> 3) : (un & 31), (G == 256) ? (un & 7) : (un >> 5), tid);
    }
    SEAM(pb + 4);
    if (ON(21) && IN(pb + 5)) {
        for (int un = bx; un < T / 128; un += G) peer_reduce_unit(lds, (const int*)(ws + WS_IDX), (const float*)(ws + WS_GATE), (const unsigned*)(ws + WS_POS), (const int*)(ws + WS_PART), (const float*)(ws + WS_HSC),
                                                              (const float*)(ws + WS_SCL) + 0 * 16384, (const float*)(ws + WS_SCL) + (2 + 0) * 16384, (unsigned*)(ws + WS_WE), (float*)(ws + WS_WSC), un, tid);
    }
    SEAM(pb + 5);
    if (ON(22) && IN(pb + 6)) {
        for (int sl_ = bx; sl_ < 256; sl_ += G) { const int sl = (G == 256) ? ((sl_ & 7) * 32 + (sl_ >> 3)) : sl_; peer_v_slice(lds, ws + WS_V + (size_t)0 * 16384 * D, (const unsigned*)(ws + WS_WE), (const float*)(ws + WS_WSC), XR, modL + 5 * D, sl, tid); }
    }
    SEAM(pb + 6);
    if (ON(23) && IN(pb + 7)) {
        LAS float* Gs = (LAS float*)lds; LAS float* Ss = (LAS float*)(lds + 16384);
        fill_mod_lds(Gs, Ss, args.in[6] + D, MOD + (size_t)2 * 12288, 0, 1, tid);
        __syncthreads();
        for (int m = gw; m < T; m += ngw) { const int b = m >> 14; norm_row_store_h<true, false>(XR + (size_t)m * D, Gs + b * D, Ss + b * D, nullptr, (unsigned*)(ws + WS_H) + (size_t)m * 512, (float*)(ws + WS_HSA) + m, lane); }
        __syncthreads();
    }
    SEAM(pb + 7);
    }
    if (ON(10) && IN(13)) {
        { pg8::Gemm g{HB, (const bf16_t*)(ws + WS_WIN1), T, D, D / 2}; pg8::StaticOrder S; S.init(T, D, G, bx);
          pg8::EpiRawI8 E{GGB, D};
          pg8::gemm_phase<pg8::EpiRawI8, pg8::StaticOrder, true, true>(lds, g, S, E); }
        { pg8::Gemm g{HB, (const bf16_t*)(ws + WS_WIN1 + (size_t)2048 * 2048), T, 4096, D / 2}; pg8::StaticOrder S; S.init(T, 4096, G, bx);
          pg8::EpiCvI8 E{XBB, (const float*)(ws + WS_HSA), (const float*)(ws + WS_CS0) + 4096 + 2048};
          pg8::gemm_phase<pg8::EpiCvI8, pg8::StaticOrder, true, true>(lds, g, S, E); }
    }
    SEAM(13);
    if (ON(11) && IN(14)) {
        LAS float* cwl = (LAS float*)lds;
        for (int i = tid; i < 4 * D; i += NTHREADS) cwl[i] = ((i < 3 * D) ? args.in[19][i] : args.in[20][i - 3 * D]) * ((const float*)(ws + WS_CS0))[4096 + (i & (D - 1))];
        __syncthreads();
        for (int m = gw; m < T; m += ngw) sc_conv_mul_row(GGB, XBB, cwl, (unsigned*)(ws + WS_H) + (size_t)m * 512, (float*)(ws + WS_HSA) + m, m, lane);
        __syncthreads();
    }
    SEAM(14);
    {
    constexpr int pb = 15;
    const float* modL = MOD + (size_t)1 * 2 * 12288;
    if (ON(17) && IN(pb)) {
        pg8::Gemm g{HB, (const bf16_t*)(ws + WS_WOUT1), T, D, D / 2}; pg8::StaticOrder S; S.init(T, D, G, bx);
        pg8::EpiResidI8 E{XR, XR, modL + 2 * D, 12288, (const float*)(ws + WS_HSA), (const float*)(ws + WS_CS0) + 4096 + 6144 + 2 * D};
        pg8::gemm_phase<pg8::EpiResidI8, pg8::StaticOrder, true, true>(lds, g, S, E);
    }
    SEAM(pb);
    if (ON(18) && IN(pb + 1)) {
        LAS float* Gs = (LAS float*)lds; LAS float* Ss = (LAS float*)(lds + 16384);
        fill_mod_lds(Gs, Ss, args.in[7] + (size_t)1 * D, modL, 3, 4, tid);
        __syncthreads();
        for (int m = gw; m < T; m += ngw) { const int b = m >> 14; norm_row_store_h<true, false>(XR + (size_t)m * D, Gs + b * D, Ss + b * D, nullptr, (unsigned*)(ws + WS_HQ) + (size_t)m * 512, (float*)(ws + WS_HSC) + m, lane); }
        __syncthreads();
    }
    SEAM(pb + 1);
    if (ON(19) && IN(pb + 2)) {
        pg8::Gemm g{(const bf16_t*)(ws + WS_HQ), (const bf16_t*)(ws + WS_WQ + (size_t)1 * D * D), T, D, D / 2}; pg8::StaticOrder S; S.init(T, D, G, bx);
        pg8::EpiRawI8 E{GGB, D};
        pg8::gemm_phase<pg8::EpiRawI8, pg8::StaticOrder, true, true>(lds, g, S, E);
    }
    SEAM(pb + 2);
    if (ON(20) && IN(pb + 3)) {
        for (int u = bx; u < T / 128; u += G) peer_select_unit(lds, GGB, (const bf16_t*)(ws + WS_KEYS) + (size_t)1 * 262144, (const float*)(ws + WS_HSC), (int*)(ws + WS_IDX), (float*)(ws + WS_GATE), (unsigned*)(ws + WS_ENT), (unsigned*)(ws + WS_POS), (unsigned*)(ws + WS_SEG), u, tid);
        __syncthreads();
    }
    SEAM(pb + 3);
    if (ON(21) && IN(pb + 4)) {
        for (int un = bx; un < 256; un += G) peer_u_lds(lds, ws + WS_U + (size_t)1 * 16384 * D, ws + WS_HQ, (const unsigned*)(ws + WS_ENT), (const unsigned*)(ws + WS_SEG), (int*)(ws + WS_PART), (G == 256) ? (un >> 3) : (un & 31), (G == 256) ? (un & 7) : (un >> 5), tid);
    }
    SEAM(pb + 4);
    if (ON(21) && IN(pb + 5)) {
        for (int un = bx; un < T / 128; un += G) peer_reduce_unit(lds, (const int*)(ws + WS_IDX), (const float*)(ws + WS_GATE), (const unsigned*)(ws + WS_POS), (const int*)(ws + WS_PART), (const float*)(ws + WS_HSC),
                                                              (const float*)(ws + WS_SCL) + 1 * 16384, (const float*)(ws + WS_SCL) + (2 + 1) * 16384, (unsigned*)(ws + WS_WE), (float*)(ws + WS_WSC), un, tid);
    }
    SEAM(pb + 5);
    if (ON(22) && IN(pb + 6)) {
        for (int sl_ = bx; sl_ < 256; sl_ += G) { const int sl = (G == 256) ? ((sl_ & 7) * 32 + (sl_ >> 3)) : sl_; peer_v_slice(lds, ws + WS_V + (size_t)1 * 16384 * D, (const unsigned*)(ws + WS_WE), (const float*)(ws + WS_WSC), XR, modL + 5 * D, sl, tid); }
    }
    SEAM(pb + 6);
    if (ON(23) && IN(pb + 7)) { for (int m = gw; m < T; m += ngw) norm_row_final_h(XR + (size_t)m * D, args.in[8], args.out + (size_t)m * D, lane); }
    }
#undef IN
#undef SEAM
}

#ifndef MK_PER_PHASE
#define MK_PER_PHASE 0
#endif
extern "C" void kernel_launch(void* const* d_in, const int* in_sizes, int n_in, void* d_out, int out_size, void* d_ws, size_t ws_size, hipStream_t stream) {
    static int grid = 0;
    if (grid == 0) {
        if (n_in != 26 || out_size != T * D || ws_size < WS_END) { fprintf(stderr, "kernel_launch: unexpected shapes (n_in %d, out %d, ws %zu)\n", n_in, out_size, ws_size); grid = -1; return; }
        int dev = 0, cus = 0;
        if (hipGetDevice(&dev) != hipSuccess || hipDeviceGetAttribute(&cus, hipDeviceAttributeMultiprocessorCount, dev) != hipSuccess) { grid = -1; return; }
        if (hipFuncSetAttribute((const void*)fwd_kernel, hipFuncAttributeMaxDynamicSharedMemorySize, LDS_BYTES) != hipSuccess) { fprintf(stderr, "kernel_launch: hipFuncSetAttribute failed\n"); grid = -1; return; }
        int per_cu = 0;
        if (hipOccupancyMaxActiveBlocksPerMultiprocessor(&per_cu, (const void*)fwd_kernel, NTHREADS, LDS_BYTES) != hipSuccess || per_cu < 1) fprintf(stderr, "kernel_launch: occupancy query reports %d\n", per_cu);
        (void)hipGetLastError();
        grid = cus;
    }
    if (grid < 0) return;
    (void)hipMemsetAsync((char*)d_ws + WS_CTL, 0, CTL_BYTES, stream);
    Args a{};
    for (int i = 0; i < 26; ++i) a.in[i] = (const float*)d_in[i];
    a.out = (float*)d_out; a.ws = (unsigned char*)d_ws;
#if MK_PER_PHASE
    for (int p = 0; p < NPHASES; ++p) { a.ph_lo = p; a.ph_hi = p + 1; hipLaunchKernelGGL(fwd_kernel, dim3(grid), dim3(NTHREADS), LDS_BYTES, stream, a); }
#else
    a.ph_lo = 0; a.ph_hi = NPHASES;
    hipLaunchKernelGGL(fwd_kernel, dim3(grid), dim3(NTHREADS), LDS_BYTES, stream, a);
#endif
}
```

```cpp
#include <hip/hip_runtime.h>
#include <cstdio>
#include <cstdint>
namespace pg8 {
#define PG8_LAS __attribute__((address_space(3)))
typedef unsigned short bf16_t;
typedef short bf16x8 __attribute__((ext_vector_type(8)));
typedef float f32x4 __attribute__((ext_vector_type(4)));
typedef unsigned u32x4 __attribute__((ext_vector_type(4)));
typedef int i32x4 __attribute__((ext_vector_type(4)));
template <bool I8> struct AccSel { typedef f32x4 type; }; template <> struct AccSel<true> { typedef i32x4 type; };
constexpr int BM = 256, BK = 64, HALF = 128, HTB = HALF * BK * 2  , STAGE_BYTES = 8 * HTB, NXCD = 8, WGM = 8;

__host__ __device__ __forceinline__ int lds_byte(int r, int c) { const int st = (r >> 4) * 2 + (c >> 5), rr = r & 15, cc = c & 31, ob = rr * 64 + cc * 2; return st * 1024 + (ob ^ (((ob >> 9) & 1) << 5)); }
__host__ __device__ __forceinline__ void stage_rc(int b, int& R, int& C) { const int st = b / 1024, sb = b % 1024, swz = sb ^ (((sb >> 9) & 1) << 5); R = (st >> 1) * 16 + swz / 64; C = (st & 1) * 32 + (swz % 64) / 2; }
__host__ __device__ __forceinline__ int perm32(int rho) { const int n = rho >> 4, i = rho & 15; return 8 * (i >> 2) + 4 * n + (i & 3); }

struct Unit { int pm, pn; };
struct Gemm { const bf16_t* A; const bf16_t* Bt; int M, N, K; };

struct StaticOrder {
    int nM, nN, nwg, G, c;
    __host__ __device__ void init(int M, int N, int G_, int c_) { nM = M / BM; nN = N / BM; nwg = nM * nN; G = G_; c = c_; }
    __host__ __device__ bool next(int i, Unit& u) const {
        const long L = (long)i * G + c; if (L >= nwg) return false;
        int wgid = (int)L; { const int q = nwg / NXCD, r = nwg % NXCD, xcd = wgid % NXCD, off = wgid / NXCD; wgid = (xcd < r ? xcd * (q + 1) : r * (q + 1) + (xcd - r) * q) + off; }
        const int nig = WGM * nN, gid = wgid / nig, fm = gid * WGM, gsz = (nM - fm) < WGM ? (nM - fm) : WGM;
        u.pm = fm + ((wgid % nig) % gsz); u.pn = (wgid % nig) / gsz; return true;
    }
    __device__ __forceinline__ void a_ready(const Unit&) const {}
    __device__ __forceinline__ void done(const Unit&) const {}
};

typedef float f32x2 __attribute__((ext_vector_type(2)));
__device__ __forceinline__ unsigned cvt_pk_bf16(float lo, float hi) { unsigned r; asm volatile("v_cvt_pk_bf16_f32 %0, %1, %2" : "=v"(r) : "v"(lo), "v"(hi)); return r; }
__device__ __forceinline__ float gelu_tanh(float x) {
    const float e = __builtin_amdgcn_exp2f(-2.302208198f * x * (1.0f + 0.044715f * x * x));
    return x * __builtin_amdgcn_rcpf(1.0f + e);
}
struct EpiGateXb {
    static constexpr bool PERM = true, AFTER_DRAIN = false, I8 = false;
    bf16_t* GG; bf16_t* XB;
    __device__ __forceinline__ void operator()(const f32x4 (&acc)[2][2][4][2], const Unit& u, int wr, int wc, int fr, int fq) const {
        const int row0 = u.pm * BM + wr * 64 + fr; const bool is_gate = u.pn < 8;
        bf16_t* base = is_gate ? GG : XB; const int col0 = (u.pn & 7) * BM + wc * 32 + 8 * fq;
#pragma unroll
        for (int ai = 0; ai < 2; ++ai)
#pragma unroll
            for (int m = 0; m < 4; ++m) { bf16_t* rowp = base + (size_t)(row0 + ai * HALF + m * 16) * 2048 + col0;
#pragma unroll
                for (int bj = 0; bj < 2; ++bj) { f32x4 v0 = acc[ai][bj][m][0], v1 = acc[ai][bj][m][1];
                    if (is_gate) {
#pragma unroll
                        for (int j = 0; j < 4; ++j) { v0[j] = gelu_tanh(v0[j]); v1[j] = gelu_tanh(v1[j]); } }
                    u32x4 w; w.x = cvt_pk_bf16(v0[0], v0[1]); w.y = cvt_pk_bf16(v0[2], v0[3]); w.z = cvt_pk_bf16(v1[0], v1[1]); w.w = cvt_pk_bf16(v1[2], v1[3]);
                    *(u32x4*)(rowp + bj * HALF) = w; } }
    }
};
struct EpiGateXbI8 {
    static constexpr bool PERM = true, AFTER_DRAIN = false, I8 = true;
    bf16_t* GG; bf16_t* XB; const float* rs; const float* cs;
    __device__ __forceinline__ void operator()(const i32x4 (&acc)[2][2][4][2], const Unit& u, int wr, int wc, int fr, int fq) const {
        const int row0 = u.pm * BM + wr * 64 + fr; const bool is_gate = u.pn < 8;
        bf16_t* base = is_gate ? GG : XB; const int col0 = (u.pn & 7) * BM + wc * 32 + 8 * fq, ccol0 = u.pn * BM + wc * 32 + 8 * fq;
        f32x4 cv[2][2];
#pragma unroll
        for (int bj = 0; bj < 2; ++bj)
#pragma unroll
            for (int n = 0; n < 2; ++n) cv[bj][n] = *(const f32x4*)(cs + ccol0 + bj * HALF + 4 * n);
#pragma unroll
        for (int ai = 0; ai < 2; ++ai)
#pragma unroll
            for (int m = 0; m < 4; ++m) { const int row = row0 + ai * HALF + m * 16; const float r = rs[row]; bf16_t* rowp = base + (size_t)row * 2048 + col0;
#pragma unroll
                for (int bj = 0; bj < 2; ++bj) { f32x4 v0, v1;
#pragma unroll
                    for (int j = 0; j < 4; ++j) { v0[j] = (float)acc[ai][bj][m][0][j] * r * cv[bj][0][j]; v1[j] = (float)acc[ai][bj][m][1][j] * r * cv[bj][1][j]; }
                    if (is_gate) {
#pragma unroll
                        for (int j = 0; j < 4; ++j) { v0[j] = gelu_tanh(v0[j]); v1[j] = gelu_tanh(v1[j]); } }
                    u32x4 w; w.x = cvt_pk_bf16(v0[0], v0[1]); w.y = cvt_pk_bf16(v0[2], v0[3]); w.z = cvt_pk_bf16(v1[0], v1[1]); w.w = cvt_pk_bf16(v1[2], v1[3]);
                    *(u32x4*)(rowp + bj * HALF) = w; } }
    }
};
struct EpiPlainI8 {
    static constexpr bool PERM = true, AFTER_DRAIN = false, I8 = true;
    bf16_t* O; int ldc; const float* rs; const float* cs;
    __device__ __forceinline__ void operator()(const i32x4 (&acc)[2][2][4][2], const Unit& u, int wr, int wc, int fr, int fq) const {
        const int row0 = u.pm * BM + wr * 64 + fr; const int col0 = u.pn * BM + wc * 32 + 8 * fq;
        f32x4 cv[2][2];
#pragma unroll
        for (int bj = 0; bj < 2; ++bj)
#pragma unroll
            for (int n = 0; n < 2; ++n) cv[bj][n] = *(const f32x4*)(cs + col0 + bj * HALF + 4 * n);
#pragma unroll
        for (int ai = 0; ai < 2; ++ai)
#pragma unroll
            for (int m = 0; m < 4; ++m) { const int row = row0 + ai * HALF + m * 16; const float r = rs[row]; bf16_t* rowp = O + (size_t)row * ldc + col0;
#pragma unroll
                for (int bj = 0; bj < 2; ++bj) { f32x4 v0, v1;
#pragma unroll
                    for (int j = 0; j < 4; ++j) { v0[j] = (float)acc[ai][bj][m][0][j] * r * cv[bj][0][j]; v1[j] = (float)acc[ai][bj][m][1][j] * r * cv[bj][1][j]; }
                    u32x4 w; w.x = cvt_pk_bf16(v0[0], v0[1]); w.y = cvt_pk_bf16(v0[2], v0[3]); w.z = cvt_pk_bf16(v1[0], v1[1]); w.w = cvt_pk_bf16(v1[2], v1[3]);
                    *(u32x4*)(rowp + bj * HALF) = w; } }
    }
};
struct EpiRawI8 {
    static constexpr bool PERM = true, AFTER_DRAIN = false, I8 = true;
    bf16_t* O; int ldc;
    __device__ __forceinline__ void operator()(const i32x4 (&acc)[2][2][4][2], const Unit& u, int wr, int wc, int fr, int fq) const {
        const int row0 = u.pm * BM + wr * 64 + fr; const int col0 = u.pn * BM + wc * 32 + 8 * fq;
#pragma unroll
        for (int ai = 0; ai < 2; ++ai)
#pragma unroll
            for (int m = 0; m < 4; ++m) { bf16_t* rowp = O + (size_t)(row0 + ai * HALF + m * 16) * ldc + col0;
#pragma unroll
                for (int bj = 0; bj < 2; ++bj) { u32x4 w;
                    w.x = cvt_pk_bf16((float)acc[ai][bj][m][0][0], (float)acc[ai][bj][m][0][1]); w.y = cvt_pk_bf16((float)acc[ai][bj][m][0][2], (float)acc[ai][bj][m][0][3]);
                    w.z = cvt_pk_bf16((float)acc[ai][bj][m][1][0], (float)acc[ai][bj][m][1][1]); w.w = cvt_pk_bf16((float)acc[ai][bj][m][1][2], (float)acc[ai][bj][m][1][3]);
                    *(u32x4*)(rowp + bj * HALF) = w; } }
    }
};
struct EpiCvI8 {
    static constexpr bool PERM = true, AFTER_DRAIN = false, I8 = true;
    bf16_t* CV; const float* rs; const float* cs;
    __device__ __forceinline__ void operator()(const i32x4 (&acc)[2][2][4][2], const Unit& u, int wr, int wc, int fr, int fq) const {
        const int row0 = u.pm * BM + wr * 64 + fr; const int col0 = u.pn * HALF + wc * 32 + 8 * fq, ccol0 = u.pn * BM + wc * 32 + 8 * fq;
        f32x4 cv[2][2];
#pragma unroll
        for (int bj = 0; bj < 2; ++bj)
#pragma unroll
            for (int n = 0; n < 2; ++n) cv[bj][n] = *(const f32x4*)(cs + ccol0 + bj * HALF + 4 * n);
#pragma unroll
        for (int ai = 0; ai < 2; ++ai)
#pragma unroll
            for (int m = 0; m < 4; ++m) { const int row = row0 + ai * HALF + m * 16; const float r = rs[row], r2 = r * r; bf16_t* rowp = CV + (size_t)row * 2048 + col0;
                f32x4 v0, v1;
#pragma unroll
                for (int j = 0; j < 4; ++j) { v0[j] = ((float)acc[ai][0][m][0][j] * cv[0][0][j]) * ((float)acc[ai][1][m][0][j] * cv[1][0][j]) * r2;
                                              v1[j] = ((float)acc[ai][0][m][1][j] * cv[0][1][j]) * ((float)acc[ai][1][m][1][j] * cv[1][1][j]) * r2; }
                u32x4 w; w.x = cvt_pk_bf16(v0[0], v0[1]); w.y = cvt_pk_bf16(v0[2], v0[3]); w.z = cvt_pk_bf16(v1[0], v1[1]); w.w = cvt_pk_bf16(v1[2], v1[3]);
                *(u32x4*)rowp = w; }
    }
};
struct EpiResidI8 {
    static constexpr bool PERM = true, AFTER_DRAIN = false, I8 = true;
    const bf16_t* baseh; bf16_t* out; const float* gvec; int gstride; const float* rs; const float* cs;
    __device__ __forceinline__ void operator()(const i32x4 (&acc)[2][2][4][2], const Unit& u, int wr, int wc, int fr, int fq) const {
        const int row0 = u.pm * BM + wr * 64 + fr, col0 = u.pn * BM + wc * 32 + 8 * fq; const int b = u.pm >> 6;
        f32x4 gv[2][2];
#pragma unroll
        for (int bj = 0; bj < 2; ++bj)
#pragma unroll
            for (int n = 0; n < 2; ++n) gv[bj][n] = *(const f32x4*)(gvec + (size_t)b * gstride + col0 + bj * HALF + n * 4) * *(const f32x4*)(cs + col0 + bj * HALF + n * 4);
#pragma unroll
        for (int ai = 0; ai < 2; ++ai)
#pragma unroll
            for (int m = 0; m < 4; ++m) { const int row = row0 + ai * HALF + m * 16; const float r = rs[row]; const size_t off = (size_t)row * 2048 + col0;
#pragma unroll
                for (int bj = 0; bj < 2; ++bj) { const u32x4 bb = *(const u32x4*)(baseh + off + bj * HALF); f32x4 o0, o1;
                    o0[0] = __uint_as_float(bb.x << 16) + gv[bj][0][0] * (r * (float)acc[ai][bj][m][0][0]); o0[1] = __uint_as_float(bb.x & 0xffff0000u) + gv[bj][0][1] * (r * (float)acc[ai][bj][m][0][1]);
                    o0[2] = __uint_as_float(bb.y << 16) + gv[bj][0][2] * (r * (float)acc[ai][bj][m][0][2]); o0[3] = __uint_as_float(bb.y & 0xffff0000u) + gv[bj][0][3] * (r * (float)acc[ai][bj][m][0][3]);
                    o1[0] = __uint_as_float(bb.z << 16) + gv[bj][1][0] * (r * (float)acc[ai][bj][m][1][0]); o1[1] = __uint_as_float(bb.z & 0xffff0000u) + gv[bj][1][1] * (r * (float)acc[ai][bj][m][1][1]);
                    o1[2] = __uint_as_float(bb.w << 16) + gv[bj][1][2] * (r * (float)acc[ai][bj][m][1][2]); o1[3] = __uint_as_float(bb.w & 0xffff0000u) + gv[bj][1][3] * (r * (float)acc[ai][bj][m][1][3]);
                    u32x4 w; w.x = cvt_pk_bf16(o0[0], o0[1]); w.y = cvt_pk_bf16(o0[2], o0[3]); w.z = cvt_pk_bf16(o1[0], o1[1]); w.w = cvt_pk_bf16(o1[2], o1[3]);
                    *(u32x4*)(out + off + bj * HALF) = w; } }
    }
};
struct EpiPlainBf16 {
    static constexpr bool PERM = true, AFTER_DRAIN = false, I8 = false;
    bf16_t* O; int ldc;
    __device__ __forceinline__ void operator()(const f32x4 (&acc)[2][2][4][2], const Unit& u, int wr, int wc, int fr, int fq) const {
        const int row0 = u.pm * BM + wr * 64 + fr; const int col0 = u.pn * BM + wc * 32 + 8 * fq;
#pragma unroll
        for (int ai = 0; ai < 2; ++ai)
#pragma unroll
            for (int m = 0; m < 4; ++m) { bf16_t* rowp = O + (size_t)(row0 + ai * HALF + m * 16) * ldc + col0;
#pragma unroll
                for (int bj = 0; bj < 2; ++bj) { const f32x4 v0 = acc[ai][bj][m][0], v1 = acc[ai][bj][m][1];
                    u32x4 w; w.x = cvt_pk_bf16(v0[0], v0[1]); w.y = cvt_pk_bf16(v0[2], v0[3]); w.z = cvt_pk_bf16(v1[0], v1[1]); w.w = cvt_pk_bf16(v1[2], v1[3]);
                    *(u32x4*)(rowp + bj * HALF) = w; } }
    }
};
struct EpiCv {
    static constexpr bool PERM = true, AFTER_DRAIN = false, I8 = false;
    bf16_t* CV;
    __device__ __forceinline__ void operator()(const f32x4 (&acc)[2][2][4][2], const Unit& u, int wr, int wc, int fr, int fq) const {
        const int row0 = u.pm * BM + wr * 64 + fr; const int col0 = u.pn * HALF + wc * 32 + 8 * fq;
#pragma unroll
        for (int ai = 0; ai < 2; ++ai)
#pragma unroll
            for (int m = 0; m < 4; ++m) { bf16_t* rowp = CV + (size_t)(row0 + ai * HALF + m * 16) * 2048 + col0;
                const f32x4 v0 = acc[ai][0][m][0] * acc[ai][1][m][0], v1 = acc[ai][0][m][1] * acc[ai][1][m][1];
                u32x4 w; w.x = cvt_pk_bf16(v0[0], v0[1]); w.y = cvt_pk_bf16(v0[2], v0[3]); w.z = cvt_pk_bf16(v1[0], v1[1]); w.w = cvt_pk_bf16(v1[2], v1[3]);
                *(u32x4*)rowp = w; }
    }
};
template <bool BASE_F32> struct EpiResidBf {
    static constexpr bool PERM = true, AFTER_DRAIN = false, I8 = false;
    const float* basef; const bf16_t* baseh; bf16_t* out; const float* gvec; int gstride;
    __device__ __forceinline__ void operator()(const f32x4 (&acc)[2][2][4][2], const Unit& u, int wr, int wc, int fr, int fq) const {
        const int row0 = u.pm * BM + wr * 64 + fr, col0 = u.pn * BM + wc * 32 + 8 * fq; const int b = u.pm >> 6;
        f32x4 gv[2][2];
#pragma unroll
        for (int bj = 0; bj < 2; ++bj)
#pragma unroll
            for (int n = 0; n < 2; ++n) gv[bj][n] = *(const f32x4*)(gvec + (size_t)b * gstride + col0 + bj * HALF + n * 4);
#pragma unroll
        for (int ai = 0; ai < 2; ++ai)
#pragma unroll
            for (int m = 0; m < 4; ++m) { const size_t off = (size_t)(row0 + ai * HALF + m * 16) * 2048 + col0;
#pragma unroll
                for (int bj = 0; bj < 2; ++bj) { f32x4 b0, b1;
                    if (BASE_F32) { b0 = *(const f32x4*)(basef + off + bj * HALF); b1 = *(const f32x4*)(basef + off + bj * HALF + 4); }
                    else { const u32x4 bb = *(const u32x4*)(baseh + off + bj * HALF);
                        b0 = (f32x4){__uint_as_float(bb.x << 16), __uint_as_float(bb.x & 0xffff0000u), __uint_as_float(bb.y << 16), __uint_as_float(bb.y & 0xffff0000u)};
                        b1 = (f32x4){__uint_as_float(bb.z << 16), __uint_as_float(bb.z & 0xffff0000u), __uint_as_float(bb.w << 16), __uint_as_float(bb.w & 0xffff0000u)}; }
                    const f32x4 o0 = b0 + gv[bj][0] * acc[ai][bj][m][0], o1 = b1 + gv[bj][1] * acc[ai][bj][m][1];
                    u32x4 w; w.x = cvt_pk_bf16(o0[0], o0[1]); w.y = cvt_pk_bf16(o0[2], o0[3]); w.z = cvt_pk_bf16(o1[0], o1[1]); w.w = cvt_pk_bf16(o1[2], o1[3]);
                    *(u32x4*)(out + off + bj * HALF) = w; } }
    }
};


template <class Epi, class Sched, bool ALIGN_EPI = false, bool SP2 = false>
__device__ __forceinline__ void gemm_phase(PG8_LAS unsigned char* lds, const Gemm g, const Sched& S, const Epi& E) {
    const int tid = threadIdx.x, wid = __builtin_amdgcn_readfirstlane(tid >> 6), lane = tid & 63, wr = wid >> 2, wc = wid & 3, fr = lane & 15, fq = lane >> 4;
    const int K = g.K, nt = K / BK;
    unsigned voffA[2], voffB[2];
#pragma unroll
    for (int i = 0; i < 2; ++i) { int R, C; stage_rc(tid * 16 + i * 8192, R, C); const int Rb = Epi::PERM ? ((R & ~31) + perm32(R & 31)) : R;
        voffA[i] = (unsigned)(R * K + C) * 2u; voffB[i] = (unsigned)(Rb * K + C) * 2u; }
    const size_t kstep = (size_t)(BK * 2);
    const size_t hstep = (size_t)HALF * K * 2;
    const size_t tstep = 2 * hstep;
    const unsigned ldsw = (unsigned)wid * 1024u;
    const int aoff = lds_byte(wr * 64 + fr, fq * 8), boff = lds_byte(wc * 32 + fr, fq * 8);
#define PG8_SA(b, h) (((b) * 2 + (h)) * HTB)
#define PG8_SB(b, h) ((4 + (b) * 2 + (h)) * HTB)
#define PG8_STAGE(bufoff, gbase, voff) do { _Pragma("unroll") for (int _i = 0; _i < 2; ++_i) \
        __builtin_amdgcn_global_load_lds((const unsigned*)((const char*)(gbase) + (voff)[_i]), (PG8_LAS unsigned*)(lds + (bufoff) + ldsw + _i * 8192), 16, 0, 0); } while (0)
#define PG8_LDA(dst, b, h) do { _Pragma("unroll") for (int m = 0; m < 4; ++m) _Pragma("unroll") for (int k = 0; k < 2; ++k) dst[m][k] = *(const PG8_LAS bf16x8*)(lds + PG8_SA(b, h) + aoff + m * 2048 + k * 1024); } while (0)
#define PG8_LDB(dst, b, h) do { _Pragma("unroll") for (int n = 0; n < 2; ++n) _Pragma("unroll") for (int k = 0; k < 2; ++k) dst[n][k] = *(const PG8_LAS bf16x8*)(lds + PG8_SB(b, h) + boff + n * 2048 + k * 1024); } while (0)
#define PG8_MMA(ai, bj, At, Bt) do { __builtin_amdgcn_s_setprio(1); _Pragma("unroll") for (int m = 0; m < 4; ++m) _Pragma("unroll") for (int n = 0; n < 2; ++n) _Pragma("unroll") for (int k = 0; k < 2; ++k) \
        { if constexpr (Epi::I8) acc[ai][bj][m][n] = __builtin_amdgcn_mfma_i32_16x16x64_i8(__builtin_bit_cast(i32x4, Bt[n][k]), __builtin_bit_cast(i32x4, At[m][k]), acc[ai][bj][m][n], 0, 0, 0); \
          else acc[ai][bj][m][n] = __builtin_amdgcn_mfma_f32_16x16x32_bf16(Bt[n][k], At[m][k], acc[ai][bj][m][n], 0, 0, 0); } __builtin_amdgcn_s_setprio(0); } while (0)
#define PG8_WAIT_V(n) asm volatile("s_waitcnt vmcnt(" #n ")" ::: "memory")
#define PG8_WAIT_L(n) asm volatile("s_waitcnt lgkmcnt(" #n ")" ::: "memory")
#define PG8_BAR __builtin_amdgcn_s_barrier()
#define PG8_SCHED __builtin_amdgcn_sched_barrier(0)
    Unit cur, nxt; int ui = 0;
    if (!S.next(0, cur)) return;
    typedef typename AccSel<Epi::I8>::type acc_t;
    acc_t acc[2][2][4][2];
#pragma unroll
    for (int a = 0; a < 2; ++a)
#pragma unroll
        for (int b = 0; b < 2; ++b)
#pragma unroll
            for (int m = 0; m < 4; ++m)
#pragma unroll
                for (int n = 0; n < 2; ++n) acc[a][b][m][n] = (acc_t){0, 0, 0, 0};
    bf16x8 At[4][2], B0[2][2], B1[2][2];
    const char* cA = (const char*)g.A + (size_t)cur.pm * tstep; const char* cB = (const char*)g.Bt + (size_t)cur.pn * tstep;
    S.a_ready(cur);
    if constexpr (SP2) {
        PG8_STAGE(PG8_SB(0, 0), cB, voffB); PG8_STAGE(PG8_SB(0, 1), cB + hstep, voffB); PG8_STAGE(PG8_SA(0, 0), cA, voffA); PG8_STAGE(PG8_SA(0, 1), cA + hstep, voffA);
        if (wr == 1) PG8_BAR;
        PG8_WAIT_V(2); PG8_BAR;
        PG8_STAGE(PG8_SB(1, 0), cB + kstep, voffB); PG8_STAGE(PG8_SA(1, 0), cA + kstep, voffA); PG8_STAGE(PG8_SB(1, 1), cB + hstep + kstep, voffB);
        PG8_WAIT_V(6); PG8_BAR;
    } else {
        PG8_STAGE(PG8_SB(0, 0), cB, voffB); PG8_STAGE(PG8_SA(0, 0), cA, voffA); PG8_STAGE(PG8_SB(0, 1), cB + hstep, voffB); PG8_STAGE(PG8_SA(0, 1), cA + hstep, voffA);
        if (wr == 1) PG8_BAR;
        PG8_WAIT_V(4); PG8_BAR;
        PG8_STAGE(PG8_SB(1, 0), cB + kstep, voffB); PG8_STAGE(PG8_SA(1, 0), cA + kstep, voffA); PG8_STAGE(PG8_SB(1, 1), cB + hstep + kstep, voffB);
        PG8_WAIT_V(6); PG8_BAR;
    }
    for (;;) {
        const bool has_next = S.next(ui + 1, nxt);
        const char* nA = has_next ? (const char*)g.A + (size_t)nxt.pm * tstep : cA; const char* nB = has_next ? (const char*)g.Bt + (size_t)nxt.pn * tstep : cB;
        for (int t = 0; t < nt; t += 2) {
            const bool last = (t == nt - 2);
            const char* a1 = cA + (size_t)(t + 1) * kstep;
            const char* a2 = last ? nA : cA + (size_t)(t + 2) * kstep; const char* b2 = last ? nB : cB + (size_t)(t + 2) * kstep;
            const char* a3 = a2 + kstep; const char* b3 = b2 + kstep;
            if (last && has_next) S.a_ready(nxt);
            if constexpr (SP2) {
            PG8_LDB(B0, 0, 0); PG8_LDB(B1, 0, 1); PG8_SCHED; PG8_LDA(At, 0, 0); PG8_STAGE(PG8_SA(1, 1), a1 + hstep, voffA);
            PG8_WAIT_V(8); PG8_WAIT_L(0); PG8_BAR; PG8_MMA(0, 0, At, B0); PG8_MMA(0, 1, At, B1); PG8_BAR; PG8_SCHED;
            PG8_LDA(At, 0, 1); PG8_STAGE(PG8_SB(0, 0), b2, voffB); PG8_STAGE(PG8_SB(0, 1), b2 + hstep, voffB); PG8_STAGE(PG8_SA(0, 0), a2, voffA);
            PG8_WAIT_V(8); PG8_WAIT_L(0); PG8_BAR; PG8_MMA(1, 0, At, B0); PG8_MMA(1, 1, At, B1); PG8_BAR; PG8_SCHED;
            PG8_LDB(B0, 1, 0); PG8_LDB(B1, 1, 1); PG8_SCHED; PG8_LDA(At, 1, 0); PG8_STAGE(PG8_SA(0, 1), a2 + hstep, voffA);
            PG8_WAIT_V(8); PG8_WAIT_L(0); PG8_BAR; PG8_MMA(0, 0, At, B0); PG8_MMA(0, 1, At, B1); PG8_BAR; PG8_SCHED;
            PG8_LDA(At, 1, 1); PG8_STAGE(PG8_SB(1, 0), b3, voffB); PG8_STAGE(PG8_SB(1, 1), b3 + hstep, voffB); PG8_STAGE(PG8_SA(1, 0), a3, voffA);
            PG8_WAIT_V(8); PG8_WAIT_L(0); PG8_BAR; PG8_MMA(1, 0, At, B0); PG8_MMA(1, 1, At, B1); PG8_BAR; PG8_SCHED;
            } else {
            PG8_LDB(B0, 0, 0); PG8_SCHED; PG8_LDA(At, 0, 0); PG8_STAGE(PG8_SA(1, 1), a1 + hstep, voffA);
            PG8_WAIT_L(8); PG8_BAR; PG8_WAIT_L(0); PG8_MMA(0, 0, At, B0); PG8_BAR; PG8_SCHED;
            PG8_LDB(B1, 0, 1); PG8_STAGE(PG8_SB(0, 0), b2, voffB);
            PG8_BAR; PG8_WAIT_L(0); PG8_MMA(0, 1, At, B1); PG8_BAR;
            PG8_LDA(At, 0, 1); PG8_STAGE(PG8_SA(0, 0), a2, voffA);
            PG8_BAR; PG8_WAIT_L(0); PG8_MMA(1, 0, At, B0); PG8_BAR; PG8_SCHED;
            PG8_STAGE(PG8_SB(0, 1), b2 + hstep, voffB);
            PG8_WAIT_V(6); PG8_BAR; PG8_MMA(1, 1, At, B1); PG8_BAR;
            PG8_LDB(B0, 1, 0); PG8_SCHED; PG8_LDA(At, 1, 0); PG8_STAGE(PG8_SA(0, 1), a2 + hstep, voffA);
            PG8_WAIT_L(8); PG8_BAR; PG8_WAIT_L(0); PG8_MMA(0, 0, At, B0); PG8_BAR; PG8_SCHED;
            PG8_LDB(B1, 1, 1); PG8_STAGE(PG8_SB(1, 0), b3, voffB);
            PG8_BAR; PG8_WAIT_L(0); PG8_MMA(0, 1, At, B1); PG8_BAR;
            PG8_LDA(At, 1, 1); PG8_STAGE(PG8_SA(1, 0), a3, voffA);
            PG8_BAR; PG8_WAIT_L(0); PG8_MMA(1, 0, At, B0); PG8_BAR; PG8_SCHED;
            PG8_STAGE(PG8_SB(1, 1), b3 + hstep, voffB);
            PG8_WAIT_V(6); PG8_BAR; PG8_MMA(1, 1, At, B1); PG8_BAR;
            }
        }
        if constexpr (ALIGN_EPI) { if (wr == 0) PG8_BAR; }
        if constexpr (!Epi::AFTER_DRAIN) { E(acc, cur, wr, wc, fr, fq); S.done(cur); }
        if (!has_next) break;
#pragma unroll
        for (int a = 0; a < 2; ++a)
#pragma unroll
            for (int b = 0; b < 2; ++b)
#pragma unroll
                for (int m = 0; m < 4; ++m)
#pragma unroll
                    for (int n = 0; n < 2; ++n) acc[a][b][m][n] = (acc_t){0, 0, 0, 0};
        cur = nxt; cA = nA; cB = nB; ++ui;
        if constexpr (ALIGN_EPI) { if (wr == 1) PG8_BAR; }
    }
    PG8_WAIT_V(0);
    if constexpr (!ALIGN_EPI) { if (wr == 0) PG8_BAR; }
    PG8_BAR;
    if constexpr (Epi::AFTER_DRAIN) { E.fused(acc, cur, wr, wc, fr, fq, lds, wid, lane); S.done(cur); }
#undef PG8_SA
#undef PG8_SB
#undef PG8_STAGE
#undef PG8_LDA
#undef PG8_LDB
#undef PG8_MMA
#undef PG8_WAIT_V
#undef PG8_WAIT_L
#undef PG8_BAR
#undef PG8_SCHED
}
}
#define XB_TMO      128
#define XB_XCNT(j)  (256  + 64 * (j))
#define XB_XSUB(j)  (1280 + 64 * (j))
#define XB_XGEN(j)  (2304 + 64 * (j))
#define XB_TOP      3328
#define XB_TOPGEN   3392
#define XCD_BAR_WORDS 3456
#define XB_SPIN_CAP (1u << 18)
#define LAS __attribute__((address_space(3)))

__device__ __forceinline__ unsigned xb_ld(unsigned* p)              { return __hip_atomic_load(p, __ATOMIC_RELAXED, __HIP_MEMORY_SCOPE_AGENT); }
__device__ __forceinline__ unsigned xb_add(unsigned* p, unsigned v) { return __hip_atomic_fetch_add(p, v, __ATOMIC_RELAXED, __HIP_MEMORY_SCOPE_AGENT); }
__device__ __forceinline__ unsigned xb_xcc_id() { return (unsigned)__builtin_amdgcn_s_getreg((3 << 11) | 20) & 0xFu; }
#define XB_SPIN(cond, bar) do { unsigned _sp = 0; while (cond) { __builtin_amdgcn_s_sleep(1); \
    if ((++_sp & 255u) == 0u) { if (xb_ld(&(bar)[XB_TMO])) break; if (_sp > XB_SPIN_CAP) { atomicAdd(&(bar)[XB_TMO], 1u); break; } } } } while (0)

struct XcdBarrier {
    unsigned* bar; unsigned x;
    volatile LAS unsigned* st;
};

__device__ __forceinline__ XcdBarrier xcd_barrier_post(unsigned* bar, volatile LAS unsigned* st) {
    XcdBarrier b; b.bar = bar; b.x = xb_xcc_id(); b.st = st;
    if (threadIdx.x == 0) (void)xb_add(&bar[XB_XCNT(b.x)], 1u);
    return b;
}
__device__ __forceinline__ void xcd_barrier_complete(unsigned* bar, unsigned x, unsigned& nloc, unsigned& nx) {
    const unsigned G = gridDim.x * gridDim.y * gridDim.z;
    unsigned sum, cnt, mine, sp = 0u;
    for (;;) {
        sum = 0u; cnt = 0u; mine = 0u;
#pragma unroll
        for (unsigned j = 0; j < 16; ++j) { const unsigned c = xb_ld(&bar[XB_XCNT(j)]); sum += c; cnt += (c > 0u) ? 1u : 0u; mine = (j == x) ? c : mine; }
        if (sum == G) break;
        __builtin_amdgcn_s_sleep(1);
        if ((++sp & 255u) == 0u) { if (xb_ld(&bar[XB_TMO])) break; if (sp > XB_SPIN_CAP) { atomicAdd(&bar[XB_TMO], 1u); break; } }
    }
    nloc = mine > 0u ? mine : 1u; nx = cnt > 0u ? cnt : 1u;
}

__device__ __forceinline__ void xcd_barrier(const XcdBarrier& b) {
    asm volatile("s_waitcnt vmcnt(0)" ::: "memory");
    __syncthreads();
    if (threadIdx.x == 0) {
        unsigned* bar = b.bar;
        __builtin_amdgcn_s_waitcnt(0);
        unsigned nloc = b.st[0], nx = b.st[1];
        if (nloc == 0u) { xcd_barrier_complete(bar, b.x, nloc, nx); b.st[0] = nloc; b.st[1] = nx; }
        const unsigned old = xb_add(&bar[XB_XSUB(b.x)], 1u);
        const unsigned gen = old / nloc;
        if (old + 1u == (gen + 1u) * nloc) {
            __builtin_amdgcn_fence(__ATOMIC_RELEASE, "agent");
            asm volatile("s_waitcnt vmcnt(0)" ::: "memory");
            const unsigned og = xb_add(&bar[XB_TOP], 1u);
            const unsigned tg = og / nx;
            if (og + 1u == (tg + 1u) * nx) xb_add(&bar[XB_TOPGEN], 1u);
            else XB_SPIN(xb_ld(&bar[XB_TOPGEN]) == tg, bar);
            __builtin_amdgcn_fence(__ATOMIC_ACQUIRE, "agent");
            xb_add(&bar[XB_XGEN(b.x)], 1u);
            asm volatile("s_waitcnt vmcnt(0)" ::: "memory");
        } else {
            XB_SPIN(xb_ld(&bar[XB_XGEN(b.x)]) == gen, bar);
            __builtin_amdgcn_fence(__ATOMIC_ACQUIRE, "agent");
            asm volatile("s_waitcnt vmcnt(0)" ::: "memory");
        }
    }
    __syncthreads();
}
constexpr int D = 2048, NBATCH = 2, SEQ = 16384, T = NBATCH * SEQ, CTXL = 256, TC = NBATCH * CTXL;
constexpr float EPS = 1e-6f;
constexpr int NTHREADS = 512, NWAVES = 8;
constexpr float LOG2E = 1.4426950408889634f;

constexpr size_t MiB = 1u << 20;
constexpr size_t WS_CTL = 0, CTL_BYTES = 1 * MiB;
constexpr size_t WS_MOD = 1 * MiB;
constexpr size_t WS_MODC = WS_MOD + 256 * 1024;
constexpr size_t WS_SUMA = 2 * MiB;
constexpr size_t WS_SUMB = WS_SUMA + 256 * 1024;
constexpr size_t WS_CSA = WS_SUMA + 576 * 1024, WS_CSB = WS_SUMA + 704 * 1024;
constexpr size_t WS_H0 = WS_SUMA + 512 * 1024;
constexpr size_t WS_GW = 3 * MiB;
constexpr size_t WS_KEYS = 5 * MiB;
constexpr size_t WS_WIN0 = 6 * MiB, WS_WOUT0 = 22 * MiB, WS_WIN1 = 30 * MiB, WS_WOUT1 = 54 * MiB, WS_WQ = 62 * MiB;
constexpr size_t WS_HC = 78 * MiB, WS_XBC = 80 * MiB, WS_IDX = 82 * MiB, WS_GATE = 98 * MiB;
constexpr size_t WS_SCL = 114 * MiB;
constexpr size_t WS_U = 128 * MiB, WS_V = 192 * MiB;
constexpr size_t WS_H = 384 * MiB, WS_GG = 512 * MiB, WS_XB = 640 * MiB, WS_XR = 768 * MiB  , WS_END = 896 * MiB;
constexpr size_t WS_WE = WS_XB + 96 * MiB;
constexpr size_t WS_WSC = WS_XB + 112 * MiB;
constexpr size_t WS_HQ = WS_XB;
constexpr size_t WS_ENT = 480 * MiB;
constexpr size_t WS_POS = WS_XB + 80 * MiB;
constexpr size_t WS_HSC = WS_XB + 113 * MiB;
constexpr size_t WS_SEG = WS_XB + 114 * MiB;
constexpr size_t WS_PART = 256 * MiB;
constexpr int POOLU = 20480;
constexpr int NPOOL = (T / 128) * POOLU;
constexpr size_t WS_HSA = 115 * MiB;
constexpr size_t WS_CS0 = 116 * MiB;
constexpr size_t WS_WIN0C = WS_WIN0 + 8 * MiB;
constexpr int CW_BAR = 4096;

constexpr int SCRATCH_BYTES = 131072, MISC_OFF = SCRATCH_BYTES, LDS_BYTES = 147456;

#define LAS __attribute__((address_space(3)))
using pg8::bf16_t; using pg8::bf16x8; using pg8::f32x4; using pg8::u32x4;
typedef unsigned u32x2 __attribute__((ext_vector_type(2)));
struct __attribute__((packed, aligned(4))) u32x3 { unsigned x, y, z; };
typedef __bf16 bf16v2 __attribute__((ext_vector_type(2)));

__device__ __forceinline__ float bflo(unsigned u) { return __uint_as_float(u << 16); }
__device__ __forceinline__ float bfhi(unsigned u) { return __uint_as_float(u & 0xffff0000u); }
__device__ __forceinline__ unsigned pk2(float lo, float hi) { return pg8::cvt_pk_bf16(lo, hi); }
__device__ __forceinline__ float wave_sum(float v) {
#pragma unroll
    for (int o = 1; o < 64; o <<= 1) v += __shfl_xor(v, o);
    return v;
}
__device__ __forceinline__ float dot2bf(unsigned a, unsigned b, float c) { return __builtin_amdgcn_fdot2_f32_bf16(__builtin_bit_cast(bf16v2, a), __builtin_bit_cast(bf16v2, b), c, false); }
__device__ __forceinline__ float silu_f(float v) { return v / (1.0f + __expf(-v)); }
__device__ __forceinline__ float sigmoid_f(float z) { return __builtin_amdgcn_rcpf(1.0f + __builtin_amdgcn_exp2f(-z * LOG2E)); }
#define DPP_ROR(x, n) __builtin_amdgcn_update_dpp(0, (x), 0x120 + (n), 0xf, 0xf, false)
__device__ __forceinline__ unsigned row_max_u32(unsigned m) {
    m = max(m, (unsigned)DPP_ROR((int)m, 8)); m = max(m, (unsigned)DPP_ROR((int)m, 4)); m = max(m, (unsigned)DPP_ROR((int)m, 2)); m = max(m, (unsigned)DPP_ROR((int)m, 1)); return m; }
__device__ __forceinline__ float row_sum_f32(float v) {
    v += __int_as_float(DPP_ROR(__float_as_int(v), 8)); v += __int_as_float(DPP_ROR(__float_as_int(v), 4)); v += __int_as_float(DPP_ROR(__float_as_int(v), 2)); v += __int_as_float(DPP_ROR(__float_as_int(v), 1)); return v; }
__device__ __forceinline__ float wave_sum_rows(float v) {
    v = row_sum_f32(v);
    const float a = __int_as_float(__builtin_amdgcn_readlane(__float_as_int(v), 0)), b = __int_as_float(__builtin_amdgcn_readlane(__float_as_int(v), 16));
    const float c = __int_as_float(__builtin_amdgcn_readlane(__float_as_int(v), 32)), d = __int_as_float(__builtin_amdgcn_readlane(__float_as_int(v), 48));
    return (a + b) + (c + d);
}

__device__ __forceinline__ void p0_transpose_item(const float* W, int K, int N, int ldw, bf16_t* WT, int row_off, LAS float* scr, int item, int lane, float scale = 1.0f) {
    const int nblk = N / 32, kb = item / nblk, nb = item % nblk, k0 = 64 * kb, n0 = 32 * nb;
#pragma unroll 8
    for (int i = 0; i < 32; ++i) { const int kk = 2 * i + (lane >> 5); scr[kk * 33 + (lane & 31)] = W[(size_t)(k0 + kk) * ldw + n0 + (lane & 31)] * scale; }
    asm volatile("s_waitcnt lgkmcnt(0)" ::: "memory");
    const int c = lane & 7;
#pragma unroll
    for (int j = 0; j < 4; ++j) { const int n = (lane >> 3) + 8 * j; const LAS float* s = scr + (8 * c) * 33 + n;
        u32x4 o; o.x = pk2(s[0 * 33], s[1 * 33]); o.y = pk2(s[2 * 33], s[3 * 33]); o.z = pk2(s[4 * 33], s[5 * 33]); o.w = pk2(s[6 * 33], s[7 * 33]);
        *(u32x4*)(WT + (size_t)(row_off + n0 + n) * K + k0 + 8 * c) = o; }
    asm volatile("s_waitcnt lgkmcnt(0)" ::: "memory");
}
__device__ __forceinline__ void p0_convert(const float* src, bf16_t* dst, size_t n, size_t gtid, size_t nthr) {
#pragma unroll 4
    for (size_t i = gtid * 8; i < n; i += nthr * 8) { const f32x4 a = *(const f32x4*)(src + i), b = *(const f32x4*)(src + i + 4);
        u32x4 o; o.x = pk2(a.x, a.y); o.y = pk2(a.z, a.w); o.z = pk2(b.x, b.y); o.w = pk2(b.z, b.w); *(u32x4*)(dst + i) = o; }
}
__device__ __forceinline__ void p0_row_load(f32x4 (&v)[2][4], const float* src, int lane) {
#pragma unroll
    for (int c = 0; c < 2; ++c)
#pragma unroll
        for (int j = 0; j < 4; ++j) v[c][j] = *(const f32x4*)(src + 1024 * c + 16 * lane + 4 * j);
}
__device__ __forceinline__ void p0_row_quant(const f32x4 (&v)[2][4], unsigned char* dst, float* scale_out, int bias, int lane, bool to_lds, int erow, LAS unsigned char* lds) {
    float am = 0.f;
#pragma unroll
    for (int c = 0; c < 2; ++c)
#pragma unroll
        for (int j = 0; j < 4; ++j) am = fmaxf(am, fmaxf(fmaxf(fabsf(v[c][j].x), fabsf(v[c][j].y)), fmaxf(fabsf(v[c][j].z), fabsf(v[c][j].w))));
#pragma unroll
    for (int o = 1; o < 64; o <<= 1) am = fmaxf(am, __shfl_xor(am, o));
    const float sc = am > 0.f ? am * (1.0f / 127.0f) : 1.0f, inv = 1.0f / sc;
    if (lane == 0) *scale_out = sc;
#pragma unroll
    for (int c = 0; c < 2; ++c) { u32x4 o;
#pragma unroll
        for (int j = 0; j < 4; ++j) { const f32x4 x = v[c][j];
            const unsigned q0 = (unsigned)((int)rintf(x.x * inv) + bias) & 255u, q1 = (unsigned)((int)rintf(x.y * inv) + bias) & 255u, q2 = (unsigned)((int)rintf(x.z * inv) + bias) & 255u, q3 = (unsigned)((int)rintf(x.w * inv) + bias) & 255u;
            o[j] = q0 | (q1 << 8) | (q2 << 16) | (q3 << 24); }
        if (!to_lds) *(u32x4*)(dst + 1024 * c + 16 * lane) = o;
        else *(LAS u32x4*)(lds + erow * 2048 + 1024 * c + 16 * lane) = o; }
}
__device__ __forceinline__ void p0_quant_row(const float* src, unsigned char* dst, float* scale_out, int bias, int lane, bool to_lds, int erow, LAS unsigned char* lds) {
    f32x4 v[2][4]; p0_row_load(v, src, lane); p0_row_quant(v, dst, scale_out, bias, lane, to_lds, erow, lds);
}
__device__ __forceinline__ void p0_quant_strip(LAS unsigned char* lds, const float* W, int N, int col0, unsigned char* WT8, float* cs, int row_off, int tid) {
    LAS float* red = (LAS float*)lds; LAS float* inv = (LAS float*)(lds + 4096);
    const int lane = tid & 63, w = tid >> 6;
    { float m0 = 0.f, m1 = 0.f; const float* Wp = W + col0 + 2 * lane;
#pragma unroll 8
      for (int k = 256 * w; k < 256 * w + 256; ++k) { const float2 x = *(const float2*)(Wp + (size_t)k * N); m0 = fmaxf(m0, fabsf(x.x)); m1 = fmaxf(m1, fabsf(x.y)); }
      red[w * 128 + 2 * lane] = m0; red[w * 128 + 2 * lane + 1] = m1; }
    __syncthreads();
    if (tid < 128) { float am = 0.f;
#pragma unroll
        for (int ww = 0; ww < 8; ++ww) am = fmaxf(am, red[ww * 128 + tid]);
        const float sc = am > 0.f ? am * (1.0f / 127.0f) : 1.0f; cs[row_off + tid] = sc; inv[tid] = 1.0f / sc; }
    __syncthreads();
    LAS float* scr = (LAS float*)(lds + 8192 + w * 8448);
    for (int it = w; it < 128; it += NWAVES) { const int k0 = 64 * (it >> 2), n0 = 32 * (it & 3);
#pragma unroll 8
        for (int i = 0; i < 32; ++i) { const int kk = 2 * i + (lane >> 5); scr[kk * 33 + (lane & 31)] = W[(size_t)(k0 + kk) * N + col0 + n0 + (lane & 31)]; }
        asm volatile("s_waitcnt lgkmcnt(0)" ::: "memory");
        const int c = lane & 3;
#pragma unroll
        for (int j = 0; j < 2; ++j) { const int n = (lane >> 2) + 16 * j; const float iv = inv[n0 + n]; const LAS float* sp = scr + (16 * c) * 33 + n; u32x4 o;
#pragma unroll
            for (int d = 0; d < 4; ++d) o[d] = ((unsigned)(int)rintf(sp[(4 * d + 0) * 33] * iv) & 255u) | (((unsigned)(int)rintf(sp[(4 * d + 1) * 33] * iv) & 255u) << 8)
                                             | (((unsigned)(int)rintf(sp[(4 * d + 2) * 33] * iv) & 255u) << 16) | (((unsigned)(int)rintf(sp[(4 * d + 3) * 33] * iv) & 255u) << 24);
            *(u32x4*)(WT8 + (size_t)(row_off + n0 + n) * 2048 + k0 + 16 * c) = o; }
        asm volatile("s_waitcnt lgkmcnt(0)" ::: "memory"); }
    __syncthreads();
}
__device__ __forceinline__ void p0_gemv(LAS unsigned char* lds, const float* c, const float* cctx, const float* w_mod, const float* b_mod, float* MOD, float* MODC, int item, int tid) {
    LAS float* sv = (LAS float*)lds; LAS float* red = (LAS float*)(lds + 24576);
    for (int i = tid; i < 2048; i += NTHREADS) { sv[i] = silu_f(c[i]); sv[2048 + i] = silu_f(c[2048 + i]); sv[4096 + i] = silu_f(cctx[i]); }
    __syncthreads();
    const int layer = item / 96, col0 = (item % 96) * 128, w = tid >> 6, l = tid & 63;
    const float* W = w_mod + (size_t)layer * 2048 * 12288 + col0 + 2 * l;
    float a00 = 0.f, a01 = 0.f, a10 = 0.f, a11 = 0.f, a20 = 0.f, a21 = 0.f;
#pragma unroll 8
    for (int k = 256 * w; k < 256 * w + 256; ++k) { const float2 wv = *(const float2*)(W + (size_t)k * 12288); const float s0 = sv[k], s1 = sv[2048 + k], s2 = sv[4096 + k];
        a00 += s0 * wv.x; a01 += s0 * wv.y; a10 += s1 * wv.x; a11 += s1 * wv.y; a20 += s2 * wv.x; a21 += s2 * wv.y; }
    red[(w * 3 + 0) * 128 + 2 * l] = a00; red[(w * 3 + 0) * 128 + 2 * l + 1] = a01;
    red[(w * 3 + 1) * 128 + 2 * l] = a10; red[(w * 3 + 1) * 128 + 2 * l + 1] = a11;
    red[(w * 3 + 2) * 128 + 2 * l] = a20; red[(w * 3 + 2) * 128 + 2 * l + 1] = a21;
    __syncthreads();
    if (tid < 384) { const int r = tid >> 7, cc = tid & 127; float s = 0.f;
#pragma unroll
        for (int ww = 0; ww < 8; ++ww) s += red[(ww * 3 + r) * 128 + cc];
        const int col = col0 + cc; const float val = s + b_mod[layer * 12288 + col];
        if (r < 2) MOD[(layer * 2 + r) * 12288 + col] = val; else if (layer == 0 && col < 4096) MODC[col] = val; }
    __syncthreads();
}

__device__ __forceinline__ void norm_row_store(const float* xrow, const LAS float* Gv, const LAS float* Sv, bf16_t* orow, int lane) {
    f32x4 v[8]; float ss = 0.f;
#pragma unroll
    for (int j = 0; j < 8; ++j) { v[j] = *(const f32x4*)(xrow + 4 * lane + 256 * j); ss += (v[j].x * v[j].x + v[j].y * v[j].y) + (v[j].z * v[j].z + v[j].w * v[j].w); }
    ss = wave_sum(ss);
    const float rstd = rsqrtf(ss * (1.0f / D) + EPS);
#pragma unroll
    for (int j = 0; j < 8; ++j) { const f32x4 g = *(const LAS f32x4*)(Gv + 4 * lane + 256 * j), s = *(const LAS f32x4*)(Sv + 4 * lane + 256 * j);
        const f32x4 o = v[j] * rstd * g + s; u32x2 p; p.x = pk2(o.x, o.y); p.y = pk2(o.z, o.w); *(u32x2*)(orow + 4 * lane + 256 * j) = p; }
}
__device__ __forceinline__ void norm_row_store_q(const float* xrow, const LAS float* Gv, const LAS float* Sv, bf16_t* orow, unsigned* hqrow, float* hsc, int lane) {
    f32x4 v[8]; float ss = 0.f;
#pragma unroll
    for (int j = 0; j < 8; ++j) { v[j] = *(const f32x4*)(xrow + 4 * lane + 256 * j); ss += (v[j].x * v[j].x + v[j].y * v[j].y) + (v[j].z * v[j].z + v[j].w * v[j].w); }
    ss = wave_sum(ss);
    const float rstd = rsqrtf(ss * (1.0f / D) + EPS); float am = 0.f;
#pragma unroll
    for (int j = 0; j < 8; ++j) { const f32x4 g = *(const LAS f32x4*)(Gv + 4 * lane + 256 * j), s = *(const LAS f32x4*)(Sv + 4 * lane + 256 * j);
        const f32x4 o = v[j] * rstd * g + s; v[j] = o; u32x2 p; p.x = pk2(o.x, o.y); p.y = pk2(o.z, o.w); *(u32x2*)(orow + 4 * lane + 256 * j) = p;
        am = fmaxf(am, fmaxf(fmaxf(fabsf(o.x), fabsf(o.y)), fmaxf(fabsf(o.z), fabsf(o.w)))); }
#pragma unroll
    for (int o = 1; o < 64; o <<= 1) am = fmaxf(am, __shfl_xor(am, o));
    const float hs = am > 0.f ? am * (1.0f / 127.0f) : 1.0f, inv = 1.0f / hs;
    if (lane == 0) *hsc = hs;
#pragma unroll
    for (int j = 0; j < 8; ++j) { const f32x4 o = v[j];
        hqrow[64 * j + lane] = ((unsigned)(int)rintf(o.x * inv) & 255u) | (((unsigned)(int)rintf(o.y * inv) & 255u) << 8) | (((unsigned)(int)rintf(o.z * inv) & 255u) << 16) | (((unsigned)(int)rintf(o.w * inv) & 255u) << 24); }
}
__device__ __forceinline__ void norm_row_q8(const float* xrow, const LAS float* Gv, const LAS float* Sv, unsigned* hqrow, float* hsc, int lane) {
    f32x4 v[8]; float ss = 0.f;
#pragma unroll
    for (int j = 0; j < 8; ++j) { v[j] = *(const f32x4*)(xrow + 4 * lane + 256 * j); ss += (v[j].x * v[j].x + v[j].y * v[j].y) + (v[j].z * v[j].z + v[j].w * v[j].w); }
    ss = wave_sum(ss);
    const float rstd = rsqrtf(ss * (1.0f / D) + EPS); float am = 0.f;
#pragma unroll
    for (int j = 0; j < 8; ++j) { const f32x4 g = *(const LAS f32x4*)(Gv + 4 * lane + 256 * j), sft = *(const LAS f32x4*)(Sv + 4 * lane + 256 * j);
        const f32x4 o = v[j] * rstd * g + sft; v[j] = o; am = fmaxf(am, fmaxf(fmaxf(fabsf(o.x), fabsf(o.y)), fmaxf(fabsf(o.z), fabsf(o.w)))); }
#pragma unroll
    for (int o = 1; o < 64; o <<= 1) am = fmaxf(am, __shfl_xor(am, o));
    const float hs = am > 0.f ? am * (1.0f / 127.0f) : 1.0f, inv = 1.0f / hs;
    if (lane == 0) *hsc = hs;
#pragma unroll
    for (int j = 0; j < 8; ++j) { const f32x4 o = v[j];
        hqrow[64 * j + lane] = ((unsigned)(int)rintf(o.x * inv) & 255u) | (((unsigned)(int)rintf(o.y * inv) & 255u) << 8) | (((unsigned)(int)rintf(o.z * inv) & 255u) << 16) | (((unsigned)(int)rintf(o.w * inv) & 255u) << 24); }
}
__device__ __forceinline__ float load_row_h(const bf16_t* xrow, float (&v)[4][8], int lane) {
    float ss = 0.f;
#pragma unroll
    for (int j = 0; j < 4; ++j) { const u32x4 x = *(const u32x4*)(xrow + 8 * lane + 512 * j);
        v[j][0] = bflo(x.x); v[j][1] = bfhi(x.x); v[j][2] = bflo(x.y); v[j][3] = bfhi(x.y); v[j][4] = bflo(x.z); v[j][5] = bfhi(x.z); v[j][6] = bflo(x.w); v[j][7] = bfhi(x.w);
#pragma unroll
        for (int i = 0; i < 8; ++i) ss += v[j][i] * v[j][i]; }
    return wave_sum(ss);
}
template <bool QUANT, bool BF16OUT = true>
__device__ __forceinline__ void norm_row_store_h(const bf16_t* xrow, const LAS float* Gv, const LAS float* Sv, bf16_t* orow, unsigned* hqrow, float* hsc, int lane) {
    float v[4][8]; const float ss = load_row_h(xrow, v, lane);
    const float rstd = rsqrtf(ss * (1.0f / D) + EPS); float am = 0.f;
#pragma unroll
    for (int j = 0; j < 4; ++j) { const int e = 8 * lane + 512 * j; const f32x4 g0 = *(const LAS f32x4*)(Gv + e), g1 = *(const LAS f32x4*)(Gv + e + 4), s0 = *(const LAS f32x4*)(Sv + e), s1 = *(const LAS f32x4*)(Sv + e + 4);
        v[j][0] = v[j][0] * rstd * g0.x + s0.x; v[j][1] = v[j][1] * rstd * g0.y + s0.y; v[j][2] = v[j][2] * rstd * g0.z + s0.z; v[j][3] = v[j][3] * rstd * g0.w + s0.w;
        v[j][4] = v[j][4] * rstd * g1.x + s1.x; v[j][5] = v[j][5] * rstd * g1.y + s1.y; v[j][6] = v[j][6] * rstd * g1.z + s1.z; v[j][7] = v[j][7] * rstd * g1.w + s1.w;
        u32x4 p; p.x = pk2(v[j][0], v[j][1]); p.y = pk2(v[j][2], v[j][3]); p.z = pk2(v[j][4], v[j][5]); p.w = pk2(v[j][6], v[j][7]); if (BF16OUT) *(u32x4*)(orow + e) = p;
        if (QUANT) {
#pragma unroll
            for (int i = 0; i < 8; ++i) am = fmaxf(am, fabsf(v[j][i])); } }
    if (QUANT) {
#pragma unroll
        for (int o = 1; o < 64; o <<= 1) am = fmaxf(am, __shfl_xor(am, o));
        const float hs = am > 0.f ? am * (1.0f / 127.0f) : 1.0f, inv = 1.0f / hs;
        if (lane == 0) *hsc = hs;
#pragma unroll
        for (int j = 0; j < 4; ++j) { u32x2 q;
            q.x = ((unsigned)(int)rintf(v[j][0] * inv) & 255u) | (((unsigned)(int)rintf(v[j][1] * inv) & 255u) << 8) | (((unsigned)(int)rintf(v[j][2] * inv) & 255u) << 16) | (((unsigned)(int)rintf(v[j][3] * inv) & 255u) << 24);
            q.y = ((unsigned)(int)rintf(v[j][4] * inv) & 255u) | (((unsigned)(int)rintf(v[j][5] * inv) & 255u) << 8) | (((unsigned)(int)rintf(v[j][6] * inv) & 255u) << 16) | (((unsigned)(int)rintf(v[j][7] * inv) & 255u) << 24);
            *(u32x2*)(hqrow + 2 * lane + 128 * j) = q; } }
}
__device__ __forceinline__ void norm_row_final_h(const bf16_t* xrow, const float* g, float* orow, int lane) {
    float v[4][8]; const float ss = load_row_h(xrow, v, lane);
    const float rstd = rsqrtf(ss * (1.0f / D) + EPS);
#pragma unroll
    for (int j = 0; j < 4; ++j) { const int e = 8 * lane + 512 * j; const f32x4 g0 = *(const f32x4*)(g + e), g1 = *(const f32x4*)(g + e + 4);
        f32x4 o0, o1; o0.x = v[j][0] * rstd * g0.x; o0.y = v[j][1] * rstd * g0.y; o0.z = v[j][2] * rstd * g0.z; o0.w = v[j][3] * rstd * g0.w;
        o1.x = v[j][4] * rstd * g1.x; o1.y = v[j][5] * rstd * g1.y; o1.z = v[j][6] * rstd * g1.z; o1.w = v[j][7] * rstd * g1.w;
        *(f32x4*)(orow + e) = o0; *(f32x4*)(orow + e + 4) = o1; }
}
__device__ __forceinline__ void fill_mod_lds(LAS float* Gs, LAS float* Ss, const float* g, const float* mod, int shift_idx, int scale_idx, int tid) {
    for (int i = tid; i < 2 * D; i += NTHREADS) { const int b = i >> 11, d = i & 2047; const float* mb = mod + (size_t)b * 12288;
        Gs[i] = g[d] * (1.0f + mb[scale_idx * D + d]); Ss[i] = mb[shift_idx * D + d]; }
}
__device__ __forceinline__ void ctx_gemm_tile(const bf16_t* HC, const bf16_t* Bt, bf16_t* XBC, int tile, int tid) {
    const int lane = tid & 63, w = tid >> 6, n = lane & 15, q = lane >> 4, rt = tile >> 4, ct = tile & 15;
    const bf16_t* a0 = HC + (size_t)(rt * 32 + n) * D + 8 * q; const bf16_t* a1 = a0 + (size_t)16 * D;
    const bf16_t* bp = Bt + (size_t)(ct * 128 + 16 * w + n) * D + 8 * q;
    f32x4 acc0 = {0.f, 0.f, 0.f, 0.f}, acc1 = {0.f, 0.f, 0.f, 0.f};
#pragma unroll 1
    for (int k0 = 0; k0 < D; k0 += 256) { bf16x8 A0[8], A1[8], B[8];
#pragma unroll
        for (int s8 = 0; s8 < 8; ++s8) { A0[s8] = *(const bf16x8*)(a0 + k0 + 32 * s8); A1[s8] = *(const bf16x8*)(a1 + k0 + 32 * s8); B[s8] = *(const bf16x8*)(bp + k0 + 32 * s8); }
#pragma unroll
        for (int s8 = 0; s8 < 8; ++s8) { acc0 = __builtin_amdgcn_mfma_f32_16x16x32_bf16(A0[s8], B[s8], acc0, 0, 0, 0); acc1 = __builtin_amdgcn_mfma_f32_16x16x32_bf16(A1[s8], B[s8], acc1, 0, 0, 0); } }
    bf16_t* o = XBC + (size_t)(rt * 32 + 4 * q) * D + ct * 128 + 16 * w + n;
#pragma unroll
    for (int i = 0; i < 4; ++i) { o[(size_t)i * D] = (bf16_t)(pk2(acc0[i], 0.f) & 0xffffu); o[(size_t)(16 + i) * D] = (bf16_t)(pk2(acc1[i], 0.f) & 0xffffu); }
}
constexpr int SC_RAW = 0, SC_XC = 18432, SC_Y = 35840, SC_CARRY = 69632, SC_CW = 70656  , SC_PITCH = 272, SC_YPITCH = 528;

__device__ __forceinline__ void scan_load_raw(u32x4 (&pre)[3], const bf16_t* src, int t0, bool is_ctx, int tid) {
#pragma unroll
    for (int j = 0; j < 3; ++j) { const int cidx = tid + NTHREADS * j, rr = (cidx >> 4) - 2, c16 = cidx & 15, tok = t0 + rr;
        const bool valid = (cidx < 1072) && (is_ctx ? (tok >= 0 && tok < CTXL) : (rr >= 0 && rr < 64));
        const u32x4 z = *(const u32x4*)(src + (ptrdiff_t)(valid ? tok : t0) * D + 8 * c16);
        pre[j] = valid ? z : (u32x4){0u, 0u, 0u, 0u}; }
}
__device__ __forceinline__ void gate_ab(float za, float zx, float sp8l, float xcv, float& a, float& b) {
    const float r = __builtin_amdgcn_rcpf(1.0f + __builtin_amdgcn_exp2f(za)), ig = __builtin_amdgcn_rcpf(1.0f + __builtin_amdgcn_exp2f(zx));
    a = __builtin_amdgcn_exp2f(sp8l * r);
    const float om = __builtin_fmaf(-a, a, 1.0f);
    b = __builtin_amdgcn_sqrtf(om) * ig * xcv;
}

template <int PASS, int DIR, bool CONV>
__device__ __forceinline__ void scan_sweep(LAS unsigned char* lds, const bf16_t* src, int t_begin, int ntiles, bool is_ctx, const bf16_t* gwd,
                                           float ba, float bx, float sp8, float S_in, float& S_out, float& P_out,
                                           bf16_t* Mrow, const bf16_t* GGrow, int tid) {
    const int lane = tid & 63, w = tid >> 6, n = lane & 15, q = lane >> 4, cg = tid & 15, tq = tid >> 4;
    bf16x8 Bf[2][4];
#pragma unroll
    for (int g = 0; g < 2; ++g)
#pragma unroll
        for (int ks = 0; ks < 4; ++ks) Bf[g][ks] = *(const bf16x8*)(gwd + (size_t)g * 16 * 16384 + (16 * w + n) * 128 + 32 * ks + 8 * q);
    float S = S_in, P = 1.0f;
    u32x4 pre[3];
    if (CONV) scan_load_raw(pre, src, t_begin + 64 * (DIR ? ntiles - 1 : 0), is_ctx, tid);
    else {
#pragma unroll
        for (int jj = 0; jj < 2; ++jj) pre[jj] = *(const u32x4*)(src + (size_t)(t_begin + 64 * (DIR ? ntiles - 1 : 0) + tq + 32 * jj) * D + 8 * cg); }
    for (int it = 0; it < ntiles; ++it) {
        const int ti = DIR ? ntiles - 1 - it : it, t0 = t_begin + 64 * ti;
        const int tin = (it + 1 < ntiles) ? (DIR ? ti - 1 : ti + 1) : ti;
        const int xcoff = CONV ? SC_XC : ((it & 1) ? SC_RAW : SC_XC);
        if (CONV) {
#pragma unroll
            for (int j = 0; j < 3; ++j) { const int cidx = tid + NTHREADS * j; if (cidx < 1072) *(LAS u32x4*)(lds + SC_RAW + (cidx >> 4) * SC_PITCH + (cidx & 15) * 16) = pre[j]; }
            __syncthreads();
            scan_load_raw(pre, src, t_begin + 64 * tin, is_ctx, tid);
#pragma unroll
            for (int jj = 0; jj < 2; ++jj) { const int tt = tq + 32 * jj; float xc[8];
                { const f32x4 c0 = *(const LAS f32x4*)(lds + SC_CW + (4 * 128 + 8 * cg) * 4), c1 = *(const LAS f32x4*)(lds + SC_CW + (4 * 128 + 8 * cg + 4) * 4);
                  xc[0] = c0.x; xc[1] = c0.y; xc[2] = c0.z; xc[3] = c0.w; xc[4] = c1.x; xc[5] = c1.y; xc[6] = c1.z; xc[7] = c1.w; }
#pragma unroll
                for (int k = 0; k < 4; ++k) { const u32x4 rv = *(const LAS u32x4*)(lds + SC_RAW + (tt + k) * SC_PITCH + cg * 16);
                    const f32x4 w0 = *(const LAS f32x4*)(lds + SC_CW + (k * 128 + 8 * cg) * 4), w1 = *(const LAS f32x4*)(lds + SC_CW + (k * 128 + 8 * cg + 4) * 4);
                    xc[0] += w0.x * bflo(rv.x); xc[1] += w0.y * bfhi(rv.x); xc[2] += w0.z * bflo(rv.y); xc[3] += w0.w * bfhi(rv.y);
                    xc[4] += w1.x * bflo(rv.z); xc[5] += w1.y * bfhi(rv.z); xc[6] += w1.z * bflo(rv.w); xc[7] += w1.w * bfhi(rv.w); }
                u32x4 o; o.x = pk2(xc[0], xc[1]); o.y = pk2(xc[2], xc[3]); o.z = pk2(xc[4], xc[5]); o.w = pk2(xc[6], xc[7]);
                *(LAS u32x4*)(lds + SC_XC + tt * SC_PITCH + cg * 16) = o;
                if (!is_ctx) *(u32x4*)(const_cast<bf16_t*>(src) + (size_t)(t0 + tt) * D + 8 * cg) = o; }
            __syncthreads();
        } else {
#pragma unroll
            for (int jj = 0; jj < 2; ++jj) *(LAS u32x4*)(lds + xcoff + (tq + 32 * jj) * SC_PITCH + cg * 16) = pre[jj];
            __syncthreads();
#pragma unroll
            for (int jj = 0; jj < 2; ++jj) pre[jj] = *(const u32x4*)(src + (size_t)(t_begin + 64 * tin + tq + 32 * jj) * D + 8 * cg);
        }
        u32x4 yfp[2], ggp[2];
        if (PASS == 2 && DIR == 1) {
#pragma unroll
            for (int jj = 0; jj < 2; ++jj) { const size_t gi = (size_t)(t0 + tq + 32 * jj) * D + 8 * cg; yfp[jj] = *(const u32x4*)(Mrow + gi); ggp[jj] = *(const u32x4*)(GGrow + gi); } }
        f32x4 acc_a[4], acc_x[4];
#pragma unroll
        for (int mt = 0; mt < 4; ++mt) { acc_a[mt] = (f32x4){ba, ba, ba, ba}; acc_x[mt] = (f32x4){bx, bx, bx, bx};
#pragma unroll
            for (int ks = 0; ks < 4; ++ks) { const bf16x8 Af = *(const LAS bf16x8*)(lds + xcoff + (16 * mt + n) * SC_PITCH + (32 * ks + 8 * q) * 2);
                acc_a[mt] = __builtin_amdgcn_mfma_f32_16x16x32_bf16(Af, Bf[0][ks], acc_a[mt], 0, 0, 0);
                acc_x[mt] = __builtin_amdgcn_mfma_f32_16x16x32_bf16(Af, Bf[1][ks], acc_x[mt], 0, 0, 0); } }
#pragma unroll
        for (int mi = 0; mi < 4; ++mi) { const int mt = DIR ? 3 - mi : mi;
            float a[4], b[4];
#pragma unroll
            for (int i = 0; i < 4; ++i) { const unsigned short xh = *(const LAS unsigned short*)(lds + xcoff + (16 * mt + 4 * q + i) * SC_PITCH + (16 * w + n) * 2);
                gate_ab(acc_a[mt][i], acc_x[mt][i], sp8, __uint_as_float((unsigned)xh << 16), a[i], b[i]); }
            const float A4 = (a[0] * a[1]) * (a[2] * a[3]); float l;
            if (DIR == 0) { l = b[0]; l = a[1] * l + b[1]; l = a[2] * l + b[2]; l = a[3] * l + b[3]; }
            else          { l = b[3]; l = a[2] * l + b[2]; l = a[1] * l + b[1]; l = a[0] * l + b[0]; }
            float Aq[4], Bq[4];
#pragma unroll
            for (int qq = 0; qq < 4; ++qq) { Aq[qq] = __shfl(A4, n + 16 * qq); Bq[qq] = __shfl(l, n + 16 * qq); }
            float c = S, mine = S;
#pragma unroll
            for (int s = 0; s < 4; ++s) { const int qq = DIR ? 3 - s : s; if (qq == q) mine = c; c = Aq[qq] * c + Bq[qq]; }
            S = c; P *= (Aq[0] * Aq[1]) * (Aq[2] * Aq[3]);
            if (PASS == 2) { float y[4], h = mine;
                if (DIR == 0) { h = a[0] * h + b[0]; y[0] = h; h = a[1] * h + b[1]; y[1] = h; h = a[2] * h + b[2]; y[2] = h; h = a[3] * h + b[3]; y[3] = h; }
                else          { h = a[3] * h + b[3]; y[3] = h; h = a[2] * h + b[2]; y[2] = h; h = a[1] * h + b[1]; y[1] = h; h = a[0] * h + b[0]; y[0] = h; }
#pragma unroll
                for (int i = 0; i < 4; ++i) *(LAS float*)(lds + SC_Y + (16 * mt + 4 * q + i) * SC_YPITCH + (16 * w + n) * 4) = y[i]; }
        }
        if (PASS == 2) {
            __syncthreads();
#pragma unroll
            for (int jj = 0; jj < 2; ++jj) { const int row = tq + 32 * jj; const LAS f32x4* yp = (const LAS f32x4*)(lds + SC_Y + row * SC_YPITCH + cg * 32);
                f32x4 y0 = yp[0], y1 = yp[1]; const size_t gi = (size_t)(t0 + row) * D + 8 * cg;
                if (DIR == 1) { const u32x4 f = yfp[jj], g = ggp[jj];
                    y0.x = (y0.x + bflo(f.x)) * bflo(g.x); y0.y = (y0.y + bfhi(f.x)) * bfhi(g.x); y0.z = (y0.z + bflo(f.y)) * bflo(g.y); y0.w = (y0.w + bfhi(f.y)) * bfhi(g.y);
                    y1.x = (y1.x + bflo(f.z)) * bflo(g.z); y1.y = (y1.y + bfhi(f.z)) * bfhi(g.z); y1.z = (y1.z + bflo(f.w)) * bflo(g.w); y1.w = (y1.w + bfhi(f.w)) * bfhi(g.w); }
                u32x4 o; o.x = pk2(y0.x, y0.y); o.y = pk2(y0.z, y0.w); o.z = pk2(y1.x, y1.y); o.w = pk2(y1.z, y1.w);
                *(u32x4*)(Mrow + gi) = o; }
        }
    }
    S_out = S; P_out = P;
}

template <int PASS>
__device__ __forceinline__ void scan_unit(LAS unsigned char* lds, const float* conv_w, const float* conv_b, const float* b_a, const float* b_x, const float* lam,
                                          unsigned char* ws, bool is_ctx, int b, int hd, int r, int tid) {
    const int lane = tid & 63, w = tid >> 6, n = lane & 15, q = lane >> 4;
    const bf16_t* GW = (const bf16_t*)(ws + WS_GW);
    float* SUMA = (float*)(ws + WS_SUMA); float* SUMB = (float*)(ws + WS_SUMB); float* H0 = (float*)(ws + WS_H0);
    for (int i = tid; i < 640; i += NTHREADS) { const int k = i >> 7, ch = hd * 128 + (i & 127); *(LAS float*)(lds + SC_CW + i * 4) = (k < 4) ? conv_w[k * D + ch] : conv_b[ch]; }
    __syncthreads();
    const int gch = hd * 128 + 16 * w + n;
    const bf16_t* src = is_ctx ? (const bf16_t*)(ws + WS_XBC) + (size_t)b * CTXL * D + hd * 128 : (const bf16_t*)(ws + WS_XB) + (size_t)b * SEQ * D + hd * 128;
    const int t_begin = is_ctx ? 0 : r * 2048, ntiles = is_ctx ? 4 : 32;
    bf16_t* Mrow = (bf16_t*)(ws + WS_H) + (size_t)b * SEQ * D + hd * 128; const bf16_t* GGrow = (const bf16_t*)(ws + WS_GG) + (size_t)b * SEQ * D + hd * 128;
    if (PASS == 2) {
        if (tid < 256) { const int dir = tid >> 7, ch = hd * 128 + (tid & 127); float S = 0.f;
            { const float* CSA = (const float*)(ws + WS_CSA); const float* CSB = (const float*)(ws + WS_CSB);
              if (dir == 0) { for (int k = 0; k < 4; ++k) S = CSA[(size_t)((0 * 2 + b) * 4 + k) * D + ch] * S + CSB[(size_t)((0 * 2 + b) * 4 + k) * D + ch]; }
              else          { for (int k = 3; k >= 0; --k) S = CSA[(size_t)((1 * 2 + b) * 4 + k) * D + ch] * S + CSB[(size_t)((1 * 2 + b) * 4 + k) * D + ch]; } }
            if (dir == 0) { for (int rr = 0; rr < r; ++rr) S = SUMA[((0 * 2 + b) * 8 + rr) * D + ch] * S + SUMB[((0 * 2 + b) * 8 + rr) * D + ch]; }
            else          { for (int rr = 7; rr > r; --rr) S = SUMA[((1 * 2 + b) * 8 + rr) * D + ch] * S + SUMB[((1 * 2 + b) * 8 + rr) * D + ch]; }
            *(LAS float*)(lds + SC_CARRY + tid * 4) = S; }
        __syncthreads();
    }
#pragma unroll
    for (int dir = 0; dir < 2; ++dir) {
        const float ba = -LOG2E * b_a[dir * D + gch], bx = -LOG2E * b_x[dir * D + gch];
        const float sp8 = -LOG2E * 8.0f * log1pf(expf(-lam[dir * D + gch]));
        const bf16_t* gwd = GW + (size_t)((dir * 2) * 16 + hd) * 16384;
        float S_in = 0.f, S_out, P_out;
        if (PASS == 2) S_in = *(const LAS float*)(lds + SC_CARRY + (dir * 128 + 16 * w + n) * 4);
        if (PASS == 1 && is_ctx) { if (dir == 0) scan_sweep<PASS, 0, true>(lds, src, t_begin, ntiles, true, gwd, ba, bx, sp8, S_in, S_out, P_out, Mrow, GGrow, tid);
                                   else          scan_sweep<PASS, 1, true>(lds, src, t_begin, ntiles, true, gwd, ba, bx, sp8, S_in, S_out, P_out, Mrow, GGrow, tid); }
        else if (PASS == 1 && dir == 0) scan_sweep<PASS, 0, true>(lds, src, t_begin, ntiles, false, gwd, ba, bx, sp8, S_in, S_out, P_out, Mrow, GGrow, tid);
        else if (dir == 0) scan_sweep<PASS, 0, false>(lds, src, t_begin, ntiles, false, gwd, ba, bx, sp8, S_in, S_out, P_out, Mrow, GGrow, tid);
        else               scan_sweep<PASS, 1, false>(lds, src, t_begin, ntiles, false, gwd, ba, bx, sp8, S_in, S_out, P_out, Mrow, GGrow, tid);
        if (PASS == 1 && q == 0) {
            if (is_ctx) H0[(dir * 2 + b) * D + gch] = S_out;
            else { SUMA[((dir * 2 + b) * 8 + r) * D + gch] = P_out; SUMB[((dir * 2 + b) * 8 + r) * D + gch] = S_out; } }
        asm volatile("s_waitcnt vmcnt(0)" ::: "memory");
        __syncthreads();
        if (PASS == 1 && dir == 0) {
            __builtin_amdgcn_fence(__ATOMIC_ACQUIRE, "agent");
            asm volatile("s_waitcnt vmcnt(0)" ::: "memory");
            __syncthreads(); }
    }
}
__device__ __forceinline__ void scan_ctx_tile(LAS unsigned char* lds, const float* conv_w, const float* conv_b, const float* b_a, const float* b_x, const float* lam,
                                              unsigned char* ws, int b, int hd, int dir, int tile, int tid) {
    const int lane = tid & 63, w = tid >> 6, n = lane & 15, q = lane >> 4;
    const bf16_t* GW = (const bf16_t*)(ws + WS_GW);
    __syncthreads();
    for (int i = tid; i < 640; i += NTHREADS) { const int k = i >> 7, ch = hd * 128 + (i & 127); *(LAS float*)(lds + SC_CW + i * 4) = (k < 4) ? conv_w[k * D + ch] : conv_b[ch]; }
    __syncthreads();
    const int gch = hd * 128 + 16 * w + n;
    const bf16_t* src = (const bf16_t*)(ws + WS_XBC) + (size_t)b * CTXL * D + hd * 128;
    bf16_t* Mrow = (bf16_t*)(ws + WS_H) + (size_t)b * SEQ * D + hd * 128; const bf16_t* GGrow = (const bf16_t*)(ws + WS_GG) + (size_t)b * SEQ * D + hd * 128;
    const float ba = -LOG2E * b_a[dir * D + gch], bx = -LOG2E * b_x[dir * D + gch];
    const float sp8 = -LOG2E * 8.0f * log1pf(expf(-lam[dir * D + gch]));
    const bf16_t* gwd = GW + (size_t)((dir * 2) * 16 + hd) * 16384;
    float S_out, P_out;
    if (dir == 0) scan_sweep<1, 0, true>(lds, src, 64 * tile, 1, true, gwd, ba, bx, sp8, 0.f, S_out, P_out, Mrow, GGrow, tid);
    else          scan_sweep<1, 1, true>(lds, src, 64 * tile, 1, true, gwd, ba, bx, sp8, 0.f, S_out, P_out, Mrow, GGrow, tid);
    if (q == 0) { ((float*)(ws + WS_CSA))[(size_t)((dir * 2 + b) * 4 + tile) * D + gch] = P_out; ((float*)(ws + WS_CSB))[(size_t)((dir * 2 + b) * 4 + tile) * D + gch] = S_out; }
    asm volatile("s_waitcnt vmcnt(0)" ::: "memory");
    __syncthreads();
}
__device__ __forceinline__ void sc_conv_mul(const bf16_t* BG, const bf16_t* CV, const float* conv_w, const float* conv_b, bf16_t* M, int gtid, int nthr) {
    const int cgp = gtid & 255, ch0 = 8 * cgp; float cw[3][8], cb[8];
#pragma unroll
    for (int j = 0; j < 8; ++j) { cb[j] = conv_b[ch0 + j];
#pragma unroll
        for (int k = 0; k < 3; ++k) cw[k][j] = conv_w[k * D + ch0 + j]; }
    for (int t = gtid >> 8; t < T; t += (nthr >> 8)) { const int tl = t & 63; const size_t gi = (size_t)t * D + ch0;
        u32x4 c[3]; c[0] = (u32x4){0u, 0u, 0u, 0u}; c[2] = c[0];
        if (tl > 0) c[0] = *(const u32x4*)(CV + gi - D);
        c[1] = *(const u32x4*)(CV + gi);
        if (tl < 63) c[2] = *(const u32x4*)(CV + gi + D);
        const u32x4 g = *(const u32x4*)(BG + gi);
        float y[8];
#pragma unroll
        for (int j = 0; j < 8; ++j) y[j] = cb[j];
#pragma unroll
        for (int k = 0; k < 3; ++k) { y[0] += cw[k][0] * bflo(c[k].x); y[1] += cw[k][1] * bfhi(c[k].x); y[2] += cw[k][2] * bflo(c[k].y); y[3] += cw[k][3] * bfhi(c[k].y);
            y[4] += cw[k][4] * bflo(c[k].z); y[5] += cw[k][5] * bfhi(c[k].z); y[6] += cw[k][6] * bflo(c[k].w); y[7] += cw[k][7] * bfhi(c[k].w); }
        u32x4 o; o.x = pk2(y[0] * bflo(g.x), y[1] * bfhi(g.x)); o.y = pk2(y[2] * bflo(g.y), y[3] * bfhi(g.y)); o.z = pk2(y[4] * bflo(g.z), y[5] * bfhi(g.z)); o.w = pk2(y[6] * bflo(g.w), y[7] * bfhi(g.w));
        *(u32x4*)(M + gi) = o; }
}

__device__ __forceinline__ void sc_conv_mul_row(const bf16_t* BG, const bf16_t* CV, const LAS float* cwl, unsigned* mq, float* msc, int t, int lane) {
    const int tl = t & 63; const int tm = (tl > 0) ? t - 1 : t, tp = (tl < 63) ? t + 1 : t;
    const float zm = (tl > 0) ? 1.f : 0.f, zp = (tl < 63) ? 1.f : 0.f;
    const float rbg = *msc;
    float v[4][8]; float am = 0.f;
#pragma unroll
    for (int j = 0; j < 4; ++j) { const int e = 8 * lane + 512 * j;
        const u32x4 c0 = *(const u32x4*)(CV + (size_t)tm * D + e), c1 = *(const u32x4*)(CV + (size_t)t * D + e), c2 = *(const u32x4*)(CV + (size_t)tp * D + e), g = *(const u32x4*)(BG + (size_t)t * D + e);
        float y[8];
#pragma unroll
        for (int h = 0; h < 2; ++h) { const f32x4 w0 = *(const LAS f32x4*)(cwl + e + 4 * h), w1 = *(const LAS f32x4*)(cwl + D + e + 4 * h), w2 = *(const LAS f32x4*)(cwl + 2 * D + e + 4 * h), bb = *(const LAS f32x4*)(cwl + 3 * D + e + 4 * h);
            const unsigned a0 = h ? c0.z : c0.x, a1 = h ? c0.w : c0.y, b0 = h ? c1.z : c1.x, b1 = h ? c1.w : c1.y, d0 = h ? c2.z : c2.x, d1 = h ? c2.w : c2.y;
            y[4 * h + 0] = bb.x + zm * w0.x * bflo(a0) + w1.x * bflo(b0) + zp * w2.x * bflo(d0); y[4 * h + 1] = bb.y + zm * w0.y * bfhi(a0) + w1.y * bfhi(b0) + zp * w2.y * bfhi(d0);
            y[4 * h + 2] = bb.z + zm * w0.z * bflo(a1) + w1.z * bflo(b1) + zp * w2.z * bflo(d1); y[4 * h + 3] = bb.w + zm * w0.w * bfhi(a1) + w1.w * bfhi(b1) + zp * w2.w * bfhi(d1); }
        v[j][0] = y[0] * bflo(g.x); v[j][1] = y[1] * bfhi(g.x); v[j][2] = y[2] * bflo(g.y); v[j][3] = y[3] * bfhi(g.y); v[j][4] = y[4] * bflo(g.z); v[j][5] = y[5] * bfhi(g.z); v[j][6] = y[6] * bflo(g.w); v[j][7] = y[7] * bfhi(g.w);
#pragma unroll
        for (int i = 0; i < 8; ++i) am = fmaxf(am, fabsf(v[j][i])); }
#pragma unroll
    for (int o = 1; o < 64; o <<= 1) am = fmaxf(am, __shfl_xor(am, o));
    const float sc = am > 0.f ? am * (1.0f / 127.0f) : 1.0f, inv = 1.0f / sc;
    if (lane == 0) *msc = sc * rbg;
#pragma unroll
    for (int j = 0; j < 4; ++j) { u32x2 q;
        q.x = ((unsigned)(int)rintf(v[j][0] * inv) & 255u) | (((unsigned)(int)rintf(v[j][1] * inv) & 255u) << 8) | (((unsigned)(int)rintf(v[j][2] * inv) & 255u) << 16) | (((unsigned)(int)rintf(v[j][3] * inv) & 255u) << 24);
        q.y = ((unsigned)(int)rintf(v[j][4] * inv) & 255u) | (((unsigned)(int)rintf(v[j][5] * inv) & 255u) << 8) | (((unsigned)(int)rintf(v[j][6] * inv) & 255u) << 16) | (((unsigned)(int)rintf(v[j][7] * inv) & 255u) << 24);
        *(u32x2*)(mq + 2 * lane + 128 * j) = q; }
}

__device__ __forceinline__ unsigned gmix(unsigned el) { return ((el >> 2) ^ (el >> 7) ^ ((el & 3u) * 11u)) & 31u; }
__device__ __forceinline__ unsigned ord_f32(float f) { const unsigned u = __float_as_uint(f); return u ^ ((unsigned)((int)u >> 31) | 0x80000000u); }
__device__ __forceinline__ float unord_f32(unsigned o) { return __uint_as_float((o & 0x80000000u) ? (o ^ 0x80000000u) : ~o); }
__device__ __forceinline__ bool stair_ij(int reg, int n, int& i, int& j) {
    bool ok = true; i = 0; j = 0;
    if (reg == 0) { i = 0; j = n; }
    else if (reg == 1) { if (n < 8) { i = 1; j = n; } else if (n < 13) { i = 2; j = n - 8; } else ok = false; }
    else if (reg == 2) { if (n < 4) { i = 3; j = n; } else if (n < 7) { i = 4; j = n - 4; } else if (n < 9) { i = 5; j = n - 7; } else if (n < 11) { i = 6; j = n - 9; } else if (n < 13) { i = 7; j = n - 11; } else { i = 8 + (n - 13); j = 0; } }
    else { if (n < 5) { i = 11 + n; j = 0; } else ok = false; }
    return ok;
}
constexpr int SEL_KT = 0, SEL_PITCH = 272, SEL_KTBYTES = 34816, SEL_LIST = 73728  ;
__device__ __forceinline__ void peer_select_unit(LAS unsigned char* lds, const bf16_t* Q, const bf16_t* KEYS, const float* HSC, int* IDX, float* GATE, unsigned* ENT, unsigned* POS, unsigned* SEG, int unit, int tid) {
    const int lane = tid & 63, w = tid >> 6, n = lane & 15, q = lane >> 4, rowbase = lane & 48;
    const int tok0 = unit * 128 + 16 * w;
    int stA0[4], stA1[4]; unsigned stTag[4], stOk[4];
#pragma unroll
    for (int reg = 0; reg < 4; ++reg) { int ci, cj; const bool ok = stair_ij(reg, n, ci, cj); stA0[reg] = (rowbase + ci) * 4; stA1[reg] = (rowbase + cj) * 4; stTag[reg] = (unsigned)(255 - (16 * ci + cj)); stOk[reg] = ok ? 0xffffffffu : 0u; }
    u32x4 kn[4]; bf16x8 An[4];
#pragma unroll
    for (int j = 0; j < 4; ++j) kn[j] = *(const u32x4*)(KEYS + (size_t)(tid + NTHREADS * j) * 8);
#pragma unroll
    for (int ks = 0; ks < 4; ++ks) An[ks] = *(const bf16x8*)(Q + (size_t)(tok0 + n) * D + 32 * ks + 8 * q);
    for (int h = 0; h < 8; ++h) {
        unsigned topk[2][4];
#pragma unroll
        for (int p = 0; p < 2; ++p) {
            const int ktoff = SEL_KT + p * SEL_KTBYTES;
            bf16x8 Aq[4];
#pragma unroll
            for (int ks = 0; ks < 4; ++ks) Aq[ks] = An[ks];
#pragma unroll
            for (int j = 0; j < 4; ++j) { const int cidx = tid + NTHREADS * j; *(LAS u32x4*)(lds + ktoff + (cidx >> 4) * SEL_PITCH + (cidx & 15) * 16) = kn[j]; }
            __syncthreads();
            { const int hpn = (2 * h + p + 1 < 16) ? 2 * h + p + 1 : 15;
              const bf16_t* kp = KEYS + (size_t)hpn * 16384;
#pragma unroll
              for (int j = 0; j < 4; ++j) kn[j] = *(const u32x4*)(kp + (size_t)(tid + NTHREADS * j) * 8);
#pragma unroll
              for (int ks = 0; ks < 4; ++ks) An[ks] = *(const bf16x8*)(Q + (size_t)(tok0 + n) * D + hpn * 128 + 32 * ks + 8 * q); }
            f32x4 acc[8];
#pragma unroll
            for (int nt = 0; nt < 8; ++nt) { acc[nt] = (f32x4){0.f, 0.f, 0.f, 0.f};
#pragma unroll
                for (int ks = 0; ks < 4; ++ks) { const bf16x8 Bk = *(const LAS bf16x8*)(lds + ktoff + (16 * nt + n) * SEL_PITCH + (32 * ks + 8 * q) * 2);
                    acc[nt] = __builtin_amdgcn_mfma_f32_16x16x32_bf16(Aq[ks], Bk, acc[nt], 0, 0, 0); } }
#pragma unroll
            for (int i2 = 0; i2 < 4; i2 += 2) { unsigned hd[2]; unsigned pt[2];
#pragma unroll
                for (int s2 = 0; s2 < 2; ++s2) { unsigned kv[8];
#pragma unroll
                    for (int nt = 0; nt < 8; ++nt) kv[nt] = (ord_f32(acc[nt][i2 + s2]) & ~127u) | (unsigned)(127 - (16 * nt + n));
#define CE(a, b) { const unsigned hi_ = max(kv[a], kv[b]), lo_ = min(kv[a], kv[b]); kv[a] = hi_; kv[b] = lo_; }
                    CE(0, 1) CE(2, 3) CE(4, 5) CE(6, 7)  CE(0, 2) CE(1, 3) CE(4, 6) CE(5, 7)  CE(1, 2) CE(5, 6) CE(0, 4) CE(3, 7)  CE(1, 5) CE(2, 6)  CE(1, 4) CE(3, 6)  CE(2, 4) CE(3, 5)  CE(3, 4)
#undef CE
                    pt[s2] = (unsigned)(SEL_LIST + w * 4608 + s2 * 2304 + lane * 4);
#pragma unroll
                    for (int r = 0; r < 8; ++r) *(LAS unsigned*)(lds + pt[s2] + 256 * r) = kv[r];
                    *(LAS unsigned*)(lds + pt[s2] + 256 * 8) = 0u;
                    hd[s2] = kv[0]; }
                unsigned res0 = 0u, res1 = 0u;
#pragma unroll 1
                for (int rnd = 0; rnd < 16; ++rnd) {
                    const unsigned m0 = row_max_u32(hd[0]), m1 = row_max_u32(hd[1]);
                    pt[0] += (hd[0] == m0) ? 256u : 0u; pt[1] += (hd[1] == m1) ? 256u : 0u;
                    hd[0] = *(const LAS unsigned*)(lds + pt[0]); hd[1] = *(const LAS unsigned*)(lds + pt[1]);
                    res0 = (n == rnd) ? m0 : res0; res1 = (n == rnd) ? m1 : res1; }
                topk[p][i2] = res0; topk[p][i2 + 1] = res1; }
        }
#pragma unroll
        for (int i2 = 0; i2 < 4; i2 += 2) { unsigned hd[2], pt[2], res[2] = {0u, 0u};
#pragma unroll
            for (int s2 = 0; s2 < 2; ++s2) { const unsigned v0 = topk[0][i2 + s2], v1 = topk[1][i2 + s2]; unsigned cv[4];
#pragma unroll
                for (int reg = 0; reg < 4; ++reg) {
                    const unsigned a0 = (unsigned)__builtin_amdgcn_ds_bpermute(stA0[reg], (int)v0), a1 = (unsigned)__builtin_amdgcn_ds_bpermute(stA1[reg], (int)v1);
                    const float sm = unord_f32(a0 & ~127u) + unord_f32(a1 & ~127u);
                    cv[reg] = ((ord_f32(sm) & ~255u) | stTag[reg]) & stOk[reg]; }
#define CE(a, b) { const unsigned hi_ = max(cv[a], cv[b]), lo_ = min(cv[a], cv[b]); cv[a] = hi_; cv[b] = lo_; }
                CE(0, 1) CE(2, 3) CE(0, 2) CE(1, 3) CE(1, 2)
#undef CE
                pt[s2] = (unsigned)(SEL_LIST + w * 4608 + s2 * 2304 + lane * 4);
#pragma unroll
                for (int r = 0; r < 4; ++r) *(LAS unsigned*)(lds + pt[s2] + 256 * r) = cv[r];
                *(LAS unsigned*)(lds + pt[s2] + 256 * 4) = 0u;
                hd[s2] = cv[0]; }
#pragma unroll 1
            for (int rnd = 0; rnd < 16; ++rnd) {
                const unsigned m0 = row_max_u32(hd[0]), m1 = row_max_u32(hd[1]);
                pt[0] += (hd[0] == m0) ? 256u : 0u; pt[1] += (hd[1] == m1) ? 256u : 0u;
                hd[0] = *(const LAS unsigned*)(lds + pt[0]); hd[1] = *(const LAS unsigned*)(lds + pt[1]);
                res[0] = (n == rnd) ? m0 : res[0]; res[1] = (n == rnd) ? m1 : res[1]; }
#pragma unroll
            for (int s2 = 0; s2 < 2; ++s2) { const int i = i2 + s2; const unsigned v0 = topk[0][i], v1 = topk[1][i], rs = res[s2];
                const int flat = 255 - (int)(rs & 255u), fi = flat >> 4, fj = flat & 15;
                const unsigned k0 = (unsigned)__builtin_amdgcn_ds_bpermute((rowbase + fi) * 4, (int)v0), k1 = (unsigned)__builtin_amdgcn_ds_bpermute((rowbase + fj) * 4, (int)v1);
                const int expert = (127 - (int)(k0 & 127u)) * 128 + (127 - (int)(k1 & 127u));
                const float sc = unord_f32(rs & ~255u);
                const float mx = __int_as_float(__builtin_amdgcn_ds_bpermute(rowbase * 4, __float_as_int(sc)));
                const float e = __builtin_amdgcn_exp2f((sc - mx) * (LOG2E * HSC[tok0 + 4 * q + i]));
                const float g = e * __builtin_amdgcn_rcpf(row_sum_f32(e));
                const size_t oi = (size_t)(tok0 + 4 * q + i) * 128 + h * 16 + n;
                IDX[oi] = expert; GATE[oi] = g; } }
    }
    asm volatile("s_waitcnt vmcnt(0)" ::: "memory");
    __syncthreads();
    volatile LAS unsigned* hist = (volatile LAS unsigned*)(lds + 69632); LAS unsigned* pref = (LAS unsigned*)(lds + 69632) + 256; LAS unsigned* tot = (LAS unsigned*)(lds + 69632) + 512;
    if (tid < 256) hist[tid] = 0u;
    __syncthreads();
    unsigned myj[32], pads[16];
#pragma unroll
    for (int tt = 0; tt < 16; ++tt) {
#pragma unroll
        for (int hf = 0; hf < 2; ++hf) { const int i = 2 * tt + hf, p = (16 * w + tt) * 128 + hf * 64 + lane; const unsigned e = (unsigned)IDX[(size_t)unit * 16384 + p] & 16383u;
            myj[i] = e | (__hip_atomic_fetch_add((LAS unsigned*)(lds + 69632) + w * 32 + (int)((e & 31u) ^ gmix(e >> 5)), 1u, __ATOMIC_RELAXED, __HIP_MEMORY_SCOPE_WORKGROUP) << 14); }
        const unsigned c = hist[w * 32 + (lane & 31)]; const bool pad = (lane < 32) && (c & 1u);
        pads[tt] = pad ? c : 0xffffffffu;
        if (pad) hist[w * 32 + lane] = c + 1u; }
    __syncthreads();
    if (tid < 32) { unsigned t = 0u;
#pragma unroll
        for (int ww = 0; ww < 8; ++ww) t += hist[ww * 32 + tid];
        tot[tid] = t; }
    __syncthreads();
    if (tid < 32) { unsigned off = 0u; for (int j = 0; j < tid; ++j) off += tot[j];
        SEG[((size_t)unit * 32 + tid) * 2] = (unsigned)unit * (unsigned)POOLU + off; SEG[((size_t)unit * 32 + tid) * 2 + 1] = tot[tid];
#pragma unroll
        for (int ww = 0; ww < 8; ++ww) { pref[ww * 32 + tid] = off; off += hist[ww * 32 + tid]; } }
    __syncthreads();
#pragma unroll
    for (int i = 0; i < 32; ++i) { const int p = (16 * w + (i >> 1)) * 128 + (i & 1) * 64 + lane; const unsigned e = myj[i] & 16383u, j = (e & 31u) ^ gmix(e >> 5);
        const unsigned pos = (unsigned)unit * (unsigned)POOLU + pref[w * 32 + (int)j] + (myj[i] >> 14);
        ENT[pos] = ((unsigned)unit * 128u + ((unsigned)p >> 7)) | ((e >> 5) << 15); POS[(size_t)unit * 16384 + p] = pos; }
    if (lane < 32) { const unsigned pb_ = (unsigned)unit * (unsigned)POOLU + pref[w * 32 + lane];
#pragma unroll
        for (int tt = 0; tt < 16; ++tt) if (pads[tt] != 0xffffffffu) ENT[pb_ + pads[tt]] = (unsigned)unit * 128u + (unsigned)(16 * w + tt); }
    __syncthreads();
}
constexpr int EX_G1 = 0, EX_S1 = 16384, EX_G2 = 32768;
constexpr int EXG = 4;
#define DPP_ROR_I(x, n) __builtin_amdgcn_update_dpp(0, (x), 0x120 + (n), 0xf, 0xf, false)
__device__ __forceinline__ int wave_isum(int v) {
    v += DPP_ROR_I(v, 8); v += DPP_ROR_I(v, 4); v += DPP_ROR_I(v, 2); v += DPP_ROR_I(v, 1);
    return (__builtin_amdgcn_readlane(v, 0) + __builtin_amdgcn_readlane(v, 16)) + (__builtin_amdgcn_readlane(v, 32) + __builtin_amdgcn_readlane(v, 48));
}
__device__ __forceinline__ void ex_load_rows(u32x4 (&buf)[EXG][2], const unsigned char* tab, int e0reg, int e1reg, int grp, int lane) {
    const int ereg = (grp < 16) ? e0reg : e1reg; const int k0 = (grp & 15) * EXG;
#pragma unroll
    for (int j = 0; j < EXG; ++j) { const int e = __builtin_amdgcn_readlane(ereg, k0 + j) & 16383; const u32x4* rp = (const u32x4*)(tab + (size_t)e * D) + lane;
        buf[j][0] = rp[0]; buf[j][1] = rp[64]; }
}
__device__ __forceinline__ void ex_dots(const u32x4 (&buf)[EXG][2], const u32x4 (&hq)[2], int& d0, int& d1, int grp, int lane) {
#pragma unroll
    for (int j = 0; j < EXG; ++j) { int a = 0;
#pragma unroll
        for (int c = 0; c < 2; ++c) { a = __builtin_amdgcn_sdot4((int)buf[j][c].x, (int)hq[c].x, a, false); a = __builtin_amdgcn_sdot4((int)buf[j][c].y, (int)hq[c].y, a, false);
            a = __builtin_amdgcn_sdot4((int)buf[j][c].z, (int)hq[c].z, a, false); a = __builtin_amdgcn_sdot4((int)buf[j][c].w, (int)hq[c].w, a, false); }
        a = wave_isum(a);
        const int kk = grp * EXG + j;
        d0 = (lane == kk) ? a : d0; d1 = (lane + 64 == kk) ? a : d1; }
}
__device__ __forceinline__ void peer_u_phase(const bf16_t* H, const int* IDX, const float* GATE, const unsigned char* U, const float* SU, const float* SV, unsigned* WE, float* WSC, int bx, int G, int wave, int lane) {
    for (int tt = bx * 64 + wave * 8; tt < T; tt += ((tt & 7) == 7) ? (G * 64 - 7) : 1) { const int t = tt;
        u32x4 hq[2]; float hs;
        { u32x4 hv[2][2]; float am = 0.f;
#pragma unroll
          for (int c = 0; c < 2; ++c) { const u32x4* hp = (const u32x4*)(H + (size_t)t * D + 1024 * c + 16 * lane); hv[c][0] = hp[0]; hv[c][1] = hp[1];
#pragma unroll
              for (int i = 0; i < 2; ++i)
#pragma unroll
                  for (int d = 0; d < 4; ++d) am = fmaxf(am, fmaxf(fabsf(bflo(hv[c][i][d])), fabsf(bfhi(hv[c][i][d])))); }
#pragma unroll
          for (int o = 1; o < 64; o <<= 1) am = fmaxf(am, __shfl_xor(am, o));
          hs = am > 0.f ? am * (1.0f / 127.0f) : 1.0f; const float inv = 1.0f / hs;
#pragma unroll
          for (int c = 0; c < 2; ++c)
#pragma unroll
              for (int i = 0; i < 2; ++i)
#pragma unroll
                  for (int dd = 0; dd < 2; ++dd) { const unsigned p0 = hv[c][i][2 * dd], p1 = hv[c][i][2 * dd + 1];
                      const unsigned q0 = (unsigned)(int)rintf(bflo(p0) * inv) & 255u, q1 = (unsigned)(int)rintf(bfhi(p0) * inv) & 255u, q2 = (unsigned)(int)rintf(bflo(p1) * inv) & 255u, q3 = (unsigned)(int)rintf(bfhi(p1) * inv) & 255u;
                      hq[c][2 * i + dd] = q0 | (q1 << 8) | (q2 << 16) | (q3 << 24); } }
        const int e0 = IDX[(size_t)t * 128 + lane] & 16383, e1 = IDX[(size_t)t * 128 + 64 + lane] & 16383;
        const float g0 = GATE[(size_t)t * 128 + lane], g1 = GATE[(size_t)t * 128 + 64 + lane];
        const float su0 = SU[e0], su1 = SU[e1], sv0 = SV[e0], sv1 = SV[e1];
        int d0 = 0, d1 = 0;
        u32x4 bA[EXG][2], bB[EXG][2];
        ex_load_rows(bA, U, e0, e1, 0, lane);
#pragma unroll 1
        for (int g = 0; g < 32; g += 2) {
            ex_load_rows(bB, U, e0, e1, g + 1, lane); ex_dots(bA, hq, d0, d1, g, lane);
            ex_load_rows(bA, U, e0, e1, (g + 2 < 32) ? g + 2 : 31, lane); ex_dots(bB, hq, d0, d1, g + 1, lane); }
        asm volatile("s_waitcnt vmcnt(0)" ::: "memory");
        const float w0 = g0 * pg8::gelu_tanh((float)d0 * su0 * hs) * sv0, w1 = g1 * pg8::gelu_tanh((float)d1 * su1 * hs) * sv1;
        float wam = fmaxf(fabsf(w0), fabsf(w1));
#pragma unroll
        for (int o = 1; o < 64; o <<= 1) wam = fmaxf(wam, __shfl_xor(wam, o));
        const float wsc = wam > 0.f ? wam * (1.0f / 127.0f) : 1.0f, winv = 1.0f / wsc;
        const int q0 = (int)rintf(w0 * winv) & 255, q1 = (int)rintf(w1 * winv) & 255;
#define QB(v, j) __builtin_amdgcn_update_dpp(0, (v), (j) * 0x55, 0xf, 0xf, false)
        u32x4 qa, qb;
        qa.x = (unsigned)(q0 | (QB(q0, 1) << 8) | (QB(q0, 2) << 16) | (QB(q0, 3) << 24)); qa.y = (unsigned)(e0 | (QB(e0, 1) << 16)); qa.z = (unsigned)(QB(e0, 2) | (QB(e0, 3) << 16)); qa.w = 0u;
        qb.x = (unsigned)(q1 | (QB(q1, 1) << 8) | (QB(q1, 2) << 16) | (QB(q1, 3) << 24)); qb.y = (unsigned)(e1 | (QB(e1, 1) << 16)); qb.z = (unsigned)(QB(e1, 2) | (QB(e1, 3) << 16)); qb.w = 0u;
#undef QB
        if ((lane & 3) == 0) { u32x4* qp = (u32x4*)WE + (size_t)(t >> 6) * 2048 + (t & 63);
            qp[(lane >> 2) * 64] = qa; qp[(16 + (lane >> 2)) * 64] = qb; }
        if (lane == 0) WSC[t] = wsc;
    }
}
__device__ __forceinline__ void peer_u_lds(LAS unsigned char* lds, const unsigned char* U, const unsigned char* HQ, const unsigned* ENT, const unsigned* SEG, int* PART, int j, int sl, int tid) {
#pragma unroll 4
    for (int i = 0; i < 16; ++i) { const int id = tid + NTHREADS * i, el = id >> 4, c = id & 15;
        *(LAS u32x4*)(lds + el * 256 + 16 * c) = *(const u32x4*)(U + (size_t)(el * 32 + (int)(((unsigned)j ^ gmix((unsigned)el)) & 31u)) * D + 256 * sl + 16 * c); }
    __syncthreads();
    const int lane = tid & 63, w = __builtin_amdgcn_readfirstlane(tid >> 6), p4 = lane & 3, eq = lane >> 2;
    const unsigned char* hqb = HQ + 256 * sl;
    unsigned lco[4];
    const int fb = (eq & 7) >> 1;
    int* part = PART + (size_t)sl * NPOOL;
#pragma unroll
    for (int i = 0; i < 4; ++i) lco[i] = (unsigned)(64 * (i ^ fb) + 16 * p4);
    int offv = 0, cntv = 0;
    if (lane < 32) { offv = (int)SEG[((size_t)(w + 8 * lane) * 32 + j) * 2]; cntv = (int)(SEG[((size_t)(w + 8 * lane) * 32 + j) * 2 + 1] >> 1); }
    struct Trip { int si, b0, off, cnt; };
    auto first_trip = [&](Trip& tr) { tr.si = 0; tr.b0 = 0; tr.off = __builtin_amdgcn_readlane(offv, 0); tr.cnt = __builtin_amdgcn_readlane(cntv, 0);
        while (tr.si < 32 && tr.b0 >= tr.cnt) { ++tr.si; if (tr.si < 32) { tr.off = __builtin_amdgcn_readlane(offv, tr.si); tr.cnt = __builtin_amdgcn_readlane(cntv, tr.si); tr.b0 = 0; } } };
    auto next_trip = [&](Trip& tr) { if (tr.si >= 32) return; tr.b0 += 64;
        while (tr.si < 32 && tr.b0 >= tr.cnt) { ++tr.si; if (tr.si < 32) { tr.off = __builtin_amdgcn_readlane(offv, tr.si); tr.cnt = __builtin_amdgcn_readlane(cntv, tr.si); tr.b0 = 0; } } };
#define QBC(v, sb) ((unsigned)__builtin_amdgcn_update_dpp(0, (int)(v), (sb) * 0x55, 0xf, 0xf, false))
#define LOAD_OWN(dst, tr) do { const int idx = (tr).b0 + 16 * p4 + eq; const bool ok = (tr).si < 32 && idx < (tr).cnt; (dst) = *(const u32x2*)(ENT + (ok ? (unsigned)((tr).off + 2 * idx) : 0u)); } while (0)
#define HQ_SB(dst, o, sb) do { const unsigned tof_ = (QBC((o).x, sb) & 32767u) << 11; _Pragma("unroll") for (int i = 0; i < 4; ++i) (dst)[sb][i] = *(const u32x4*)(hqb + (tof_ + lco[i])); } while (0)
#define LOAD_HQ(dst, o) do { HQ_SB(dst, o, 0); HQ_SB(dst, o, 1); HQ_SB(dst, o, 2); HQ_SB(dst, o, 3); } while (0)
#define SB_BODY(sb, o, hb_, hbn_, on_) do { \
        HQ_SB(hbn_, on_, sb);     \
        const unsigned el0 = QBC((o).x, sb) >> 15, el1 = QBC((o).y, sb) >> 15; int acc0 = 0, acc1 = 0; \
        _Pragma("unroll") for (int i = 0; i < 4; ++i) { const u32x4 ua = *(const LAS u32x4*)(lds + (el0 * 256u + lco[i])), ub = *(const LAS u32x4*)(lds + (el1 * 256u + lco[i])); \
            acc0 = __builtin_amdgcn_sdot4((int)ua.x, (int)(hb_)[sb][i].x, acc0, false); acc1 = __builtin_amdgcn_sdot4((int)ub.x, (int)(hb_)[sb][i].x, acc1, false); \
            acc0 = __builtin_amdgcn_sdot4((int)ua.y, (int)(hb_)[sb][i].y, acc0, false); acc1 = __builtin_amdgcn_sdot4((int)ub.y, (int)(hb_)[sb][i].y, acc1, false); \
            acc0 = __builtin_amdgcn_sdot4((int)ua.z, (int)(hb_)[sb][i].z, acc0, false); acc1 = __builtin_amdgcn_sdot4((int)ub.z, (int)(hb_)[sb][i].z, acc1, false); \
            acc0 = __builtin_amdgcn_sdot4((int)ua.w, (int)(hb_)[sb][i].w, acc0, false); acc1 = __builtin_amdgcn_sdot4((int)ub.w, (int)(hb_)[sb][i].w, acc1, false); } \
        acc0 += __builtin_amdgcn_update_dpp(0, acc0, 0xB1, 0xf, 0xf, false); acc1 += __builtin_amdgcn_update_dpp(0, acc1, 0xB1, 0xf, 0xf, false); \
        acc0 += __builtin_amdgcn_update_dpp(0, acc0, 0x4E, 0xf, 0xf, false); acc1 += __builtin_amdgcn_update_dpp(0, acc1, 0x4E, 0xf, 0xf, false); \
        res0_ = (p4 == sb) ? acc0 : res0_; res1_ = (p4 == sb) ? acc1 : res1_; } while (0)
#define COMPUTE(tr, o, hb_, hbn_, on_) do { int res0_ = 0, res1_ = 0; SB_BODY(0, o, hb_, hbn_, on_); SB_BODY(1, o, hb_, hbn_, on_); SB_BODY(2, o, hb_, hbn_, on_); SB_BODY(3, o, hb_, hbn_, on_); \
        const int idx = (tr).b0 + 16 * p4 + eq; if ((tr).si < 32 && idx < (tr).cnt) { u32x2 r_; r_.x = (unsigned)res0_; r_.y = (unsigned)res1_; *(u32x2*)(part + ((tr).off + 2 * idx)) = r_; } } while (0)
    Trip tA, tB, tC;
    first_trip(tA); tB = tA; next_trip(tB); tC = tB; next_trip(tC);
    u32x2 oA, oB, oC; u32x4 h0[4][4], h1[4][4];
    LOAD_OWN(oA, tA); LOAD_OWN(oB, tB);
    LOAD_HQ(h0, oA);
    while (tA.si < 32) {
        LOAD_OWN(oC, tC); COMPUTE(tA, oA, h0, h1, oB);
        tA = tB; tB = tC; next_trip(tC); oA = oB; oB = oC;
        if (tA.si >= 32) break;
        LOAD_OWN(oC, tC); COMPUTE(tA, oA, h1, h0, oB);
        tA = tB; tB = tC; next_trip(tC); oA = oB; oB = oC;
    }
#undef QBC
#undef LOAD_OWN
#undef HQ_SB
#undef LOAD_HQ
#undef SB_BODY
#undef COMPUTE
    asm volatile("s_waitcnt vmcnt(0)" ::: "memory");
    __syncthreads();
}
__device__ __forceinline__ void peer_reduce_unit(LAS unsigned char* lds, const int* IDX, const float* GATE, const unsigned* POS, const int* PART, const float* HSC, const float* SU, const float* SV, unsigned* WE, float* WSC, int unit, int tid) {
    const int lane = tid & 63, w = tid >> 6;
    LAS int* dl = (LAS int*)lds; const unsigned pbase = (unsigned)unit * (unsigned)POOLU;
    __syncthreads();
    for (int i = tid; i < POOLU / 4; i += NTHREADS) { pg8::i32x4 acc = *(const pg8::i32x4*)(PART + (size_t)pbase + 4 * i);
#pragma unroll
        for (int s8 = 1; s8 < 8; ++s8) acc += *(const pg8::i32x4*)(PART + (size_t)s8 * NPOOL + pbase + 4 * i);
        *(LAS pg8::i32x4*)(dl + 4 * i) = acc; }
    __syncthreads();
    constexpr int TU = 4;
    for (int i0 = 0; i0 < 16; i0 += TU) {
        int e0[TU], e1[TU]; float g0[TU], g1[TU]; unsigned p0[TU], p1[TU]; float hs[TU];
#pragma unroll
        for (int u = 0; u < TU; ++u) { const size_t tb = (size_t)(unit * 128 + w * 16 + i0 + u) * 128;
            e0[u] = IDX[tb + lane] & 16383; e1[u] = IDX[tb + 64 + lane] & 16383; g0[u] = GATE[tb + lane]; g1[u] = GATE[tb + 64 + lane]; p0[u] = POS[tb + lane]; p1[u] = POS[tb + 64 + lane];
            hs[u] = HSC[unit * 128 + w * 16 + i0 + u]; }
        int d0[TU], d1[TU]; float su0[TU], su1[TU], sv0[TU], sv1[TU];
#pragma unroll
        for (int u = 0; u < TU; ++u) { d0[u] = dl[p0[u] - pbase]; d1[u] = dl[p1[u] - pbase];
            su0[u] = SU[e0[u]]; su1[u] = SU[e1[u]]; sv0[u] = SV[e0[u]]; sv1[u] = SV[e1[u]]; }
#pragma unroll
        for (int u = 0; u < TU; ++u) { const int t = unit * 128 + w * 16 + i0 + u;
            const float w0 = g0[u] * pg8::gelu_tanh((float)d0[u] * su0[u] * hs[u]) * sv0[u], w1 = g1[u] * pg8::gelu_tanh((float)d1[u] * su1[u] * hs[u]) * sv1[u];
            float wam = fmaxf(fabsf(w0), fabsf(w1));
#pragma unroll
            for (int o = 1; o < 64; o <<= 1) wam = fmaxf(wam, __shfl_xor(wam, o));
            const float wsc = wam > 0.f ? wam * (1.0f / 127.0f) : 1.0f, winv = 1.0f / wsc;
            const int q0 = (int)rintf(w0 * winv) & 255, q1 = (int)rintf(w1 * winv) & 255;
#define QB(v, jj) __builtin_amdgcn_update_dpp(0, (v), (jj) * 0x55, 0xf, 0xf, false)
            u32x4 qa, qb; const int ea = e0[u], eb = e1[u];
            qa.x = (unsigned)(q0 | (QB(q0, 1) << 8) | (QB(q0, 2) << 16) | (QB(q0, 3) << 24)); qa.y = (unsigned)(ea | (QB(ea, 1) << 16)); qa.z = (unsigned)(QB(ea, 2) | (QB(ea, 3) << 16)); qa.w = 0u;
            qb.x = (unsigned)(q1 | (QB(q1, 1) << 8) | (QB(q1, 2) << 16) | (QB(q1, 3) << 24)); qb.y = (unsigned)(eb | (QB(eb, 1) << 16)); qb.z = (unsigned)(QB(eb, 2) | (QB(eb, 3) << 16)); qb.w = 0u;
#undef QB
            if ((lane & 3) == 0) { u32x3* qp = (u32x3*)WE + (size_t)(t >> 6) * 2048 + (t & 63);
                u32x3 a3, b3; a3.x = qa.x; a3.y = qa.y; a3.z = qa.z; b3.x = qb.x; b3.y = qb.y; b3.z = qb.z; qp[(lane >> 2) * 64] = a3; qp[(16 + (lane >> 2)) * 64] = b3; }
            if (lane == 0) WSC[t] = wsc; }
    }
}
__device__ __forceinline__ unsigned lo16x8(unsigned x) { unsigned r; const unsigned three = 3u; asm("v_lshlrev_b32_sdwa %0, %1, %2 dst_sel:DWORD dst_unused:UNUSED_PAD src0_sel:DWORD src1_sel:WORD_0" : "=v"(r) : "v"(three), "v"(x)); return r; }
__device__ __forceinline__ void peer_v_slice(LAS unsigned char* lds, const unsigned char* VSl, const unsigned* WE, const float* WSC, bf16_t* XR, const float* g2mod, int sl, int tid) {
    { const u32x4* src = (const u32x4*)(VSl + (size_t)sl * 131072);
#pragma unroll 4
      for (int i = 0; i < 16; ++i) { const int idx = tid + NTHREADS * i; *(LAS u32x4*)(lds + idx * 16) = src[idx]; } }
    __syncthreads();
    const int lane = tid & 63, w = tid >> 6;
    constexpr int VQ = 16;
    const int rot = 37 * (sl >> 3);
    u32x3 cur[VQ], nxt[VQ];
    { const u32x3* wp0 = (const u32x3*)WE + (size_t)((w + rot) & (T / 64 - 1)) * 2048 + lane;
#pragma unroll
      for (int i = 0; i < VQ; ++i) cur[i] = wp0[64 * i]; }
    for (int tbi = w; tbi < T / 64; tbi += NWAVES) {
        const int tb = (tbi + rot) & (T / 64 - 1);
        const int tbn = (((tbi + NWAVES < T / 64) ? tbi + NWAVES : tbi) + rot) & (T / 64 - 1);
        const int t = tb * 64 + lane, b = t >> 14;
        const float wsc = WSC[t];
        u32x4* xr = (u32x4*)(XR + (size_t)t * D + 8 * sl); const float* gp = g2mod + (size_t)b * 12288 + 8 * sl;
        const u32x4 xx = *xr; const f32x4 ga = *(const f32x4*)gp, gb = *(const f32x4*)(gp + 4);
        int acc[8];
#pragma unroll
        for (int j = 0; j < 8; ++j) acc[j] = 0;
#define V_HALF(CUR, NXT, WPN) do { { const u32x3* wpn = (WPN); _Pragma("unroll") for (int i = 0; i < VQ; ++i) (NXT)[i] = wpn[64 * i]; } \
            _Pragma("unroll") for (int sb = 0; sb < VQ; sb += 4) { u32x2 row[4][4]; \
                _Pragma("unroll") for (int i = 0; i < 4; ++i) { row[i][0] = *(const LAS u32x2*)(lds + lo16x8((CUR)[sb + i].y)); row[i][1] = *(const LAS u32x2*)(lds + ((CUR)[sb + i].y >> 16) * 8); \
                    row[i][2] = *(const LAS u32x2*)(lds + lo16x8((CUR)[sb + i].z)); row[i][3] = *(const LAS u32x2*)(lds + ((CUR)[sb + i].z >> 16) * 8); } \
                _Pragma("unroll") for (int i = 0; i < 4; ++i) { const int wq = (int)(CUR)[sb + i].x; \
                      \
                    _Pragma("unroll") for (int hh = 0; hh < 2; ++hh) { const unsigned r0 = row[i][0][hh], r1 = row[i][1][hh], r2 = row[i][2][hh], r3 = row[i][3][hh]; \
                        const unsigned t0 = __builtin_amdgcn_perm(r1, r0, 0x05010400u), t1 = __builtin_amdgcn_perm(r1, r0, 0x07030602u); \
                        const unsigned t2 = __builtin_amdgcn_perm(r3, r2, 0x05010400u), t3 = __builtin_amdgcn_perm(r3, r2, 0x07030602u); \
                        const unsigned c0 = __builtin_amdgcn_perm(t2, t0, 0x05040100u), c1 = __builtin_amdgcn_perm(t2, t0, 0x07060302u); \
                        const unsigned c2 = __builtin_amdgcn_perm(t3, t1, 0x05040100u), c3 = __builtin_amdgcn_perm(t3, t1, 0x07060302u); \
                        acc[4 * hh + 0] = __builtin_amdgcn_sdot4((int)c0, wq, acc[4 * hh + 0], false); acc[4 * hh + 1] = __builtin_amdgcn_sdot4((int)c1, wq, acc[4 * hh + 1], false); \
                        acc[4 * hh + 2] = __builtin_amdgcn_sdot4((int)c2, wq, acc[4 * hh + 2], false); acc[4 * hh + 3] = __builtin_amdgcn_sdot4((int)c3, wq, acc[4 * hh + 3], false); } } \
                __builtin_amdgcn_sched_barrier(0); } } while (0)
        V_HALF(cur, nxt, (const u32x3*)WE + (size_t)tb * 2048 + lane + 64 * VQ);
        V_HALF(nxt, cur, (const u32x3*)WE + (size_t)tbn * 2048 + lane);
#undef V_HALF
        u32x4 o; o.x = pk2(bflo(xx.x) + ga.x * (wsc * (float)acc[0]), bfhi(xx.x) + ga.y * (wsc * (float)acc[1])); o.y = pk2(bflo(xx.y) + ga.z * (wsc * (float)acc[2]), bfhi(xx.y) + ga.w * (wsc * (float)acc[3]));
        o.z = pk2(bflo(xx.z) + gb.x * (wsc * (float)acc[4]), bfhi(xx.z) + gb.y * (wsc * (float)acc[5])); o.w = pk2(bflo(xx.w) + gb.z * (wsc * (float)acc[6]), bfhi(xx.w) + gb.w * (wsc * (float)acc[7]));
        *xr = o;
    }
    __syncthreads();
}
__device__ __forceinline__ void norm_row_final(float* xrow, const float* g, int lane) {
    f32x4 v[8]; float ss = 0.f;
#pragma unroll
    for (int j = 0; j < 8; ++j) { v[j] = *(const f32x4*)(xrow + 4 * lane + 256 * j); ss += (v[j].x * v[j].x + v[j].y * v[j].y) + (v[j].z * v[j].z + v[j].w * v[j].w); }
    ss = wave_sum(ss);
    const float rstd = rsqrtf(ss * (1.0f / D) + EPS);
#pragma unroll
    for (int j = 0; j < 8; ++j) { const f32x4 gg = *(const f32x4*)(g + 4 * lane + 256 * j); *(f32x4*)(xrow + 4 * lane + 256 * j) = v[j] * rstd * gg; }
}

constexpr int NPHASES = 23;
struct Args { const float* in[26]; float* out; unsigned char* ws; int ph_lo, ph_hi; };

__global__ void __launch_bounds__(NTHREADS, 2) fwd_kernel(Args args) {
    extern __shared__ __attribute__((aligned(16))) unsigned char lds_raw[];
    (void)lds_raw;
    LAS unsigned char* lds = (LAS unsigned char*)(uintptr_t)0u;
    int tid = threadIdx.x; const int lane = tid & 63, wave = __builtin_amdgcn_readfirstlane(tid >> 6);
    const int G = gridDim.x, bx = blockIdx.x;
    const int gw = bx * NWAVES + wave, ngw = G * NWAVES, gtid = bx * NTHREADS + tid, nthr = G * NTHREADS;
    unsigned char* ws = args.ws;
    for (int u = tid; u < (LDS_BYTES - MISC_OFF) / 4; u += NTHREADS) ((LAS unsigned*)(lds + MISC_OFF))[u] = 0u;
    __syncthreads();
    const int lo = args.ph_lo, hi = args.ph_hi;
    unsigned* barw = (unsigned*)(ws + WS_CTL) + CW_BAR;
    XcdBarrier bar; bar.bar = barw; bar.x = 0; bar.st = (volatile LAS unsigned*)(lds + MISC_OFF + 32);
    if (hi - lo > 1) bar = xcd_barrier_post(barw, (volatile LAS unsigned*)(lds + MISC_OFF + 32));
#ifndef PHMASK
#define PHMASK 0xFFFFFFu
#endif
#define IN(k) (lo <= (k) && (k) < hi)
#define ON(j) (((PHMASK) >> (j)) & 1u)
#define SEAM(k) do { if (IN(k) && IN((k) + 1)) xcd_barrier(bar); asm volatile("" : "+v"(tid)); } while (0)

    float* MOD = (float*)(ws + WS_MOD); float* MODC = (float*)(ws + WS_MODC);
    bf16_t* HB = (bf16_t*)(ws + WS_H); bf16_t* GGB = (bf16_t*)(ws + WS_GG); bf16_t* XBB = (bf16_t*)(ws + WS_XB);
    bf16_t* HC = (bf16_t*)(ws + WS_HC); bf16_t* XBC = (bf16_t*)(ws + WS_XBC);
    bf16_t* XR = (bf16_t*)(ws + WS_XR);

    if (ON(0) && IN(0)) {
        if (G == 256) { if (bx < 128) for (int item = bx; item < 192; item += 128) p0_gemv(lds, args.in[1], args.in[3], args.in[4], args.in[5], MOD, MODC, item, tid); }
        else for (int item = bx; item < 192; item += G) p0_gemv(lds, args.in[1], args.in[3], args.in[4], args.in[5], MOD, MODC, item, tid);
        for (int it = (G == 256) ? ((bx >= 128) ? bx - 128 : 128) : (G - 1 - bx); it < 128; it += G) {
            if (it >= 112) p0_quant_strip(lds, args.in[21], D, 128 * (it - 112), ws + WS_WOUT1, (float*)(ws + WS_CS0) + 4096 + 6144 + 2 * D, 128 * (it - 112), tid);
            else if (it >= 80) { const int L = (it - 80) >> 4, st = (it - 80) & 15;
                p0_quant_strip(lds, args.in[22] + (size_t)L * D * D, D, 128 * st, ws + WS_WQ + (size_t)L * D * D, (float*)(ws + WS_CS0) + 4096 + 6144 + L * D, 128 * st, tid); }
            else if (it < 32) p0_quant_strip(lds, args.in[9], 4096, 128 * it, ws + WS_WIN0, (float*)(ws + WS_CS0), 128 * it, tid);
            else { const int col0 = 128 * (it - 32); int nb;
                if (col0 < 2048) nb = col0; else if (col0 < 4096) nb = 2048 + ((col0 - 2048) >> 7) * 256; else nb = 2048 + ((col0 - 4096) >> 7) * 256 + 128;
                p0_quant_strip(lds, args.in[18], 6144, col0, ws + WS_WIN1, (float*)(ws + WS_CS0) + 4096, nb, tid); } }
        LAS float* scr = (LAS float*)(lds + wave * 16384);
        constexpr int I_WOUT = 32 * 64, I_GATE = 64 * 8;
        constexpr int NITEMS = I_WOUT + I_WOUT + I_GATE;
        for (int it = gw; it < NITEMS; it += ngw) {
            int r = it;
            if (r < I_WOUT) { p0_transpose_item(args.in[9] + 2048, D, D, 4096, (bf16_t*)(ws + WS_WIN0C), 0, scr, r, lane); continue; } r -= I_WOUT;
            if (r < I_WOUT) { p0_transpose_item(args.in[17], D, D, D, (bf16_t*)(ws + WS_WOUT0), 0, scr, r, lane); continue; } r -= I_WOUT;
            { const int mtx = r >> 3, dir = mtx >> 5, g = (mtx >> 4) & 1, h = mtx & 15;
              const float* srcw = (g == 0 ? args.in[12] : args.in[14]) + (size_t)(dir * 16 + h) * 16384;
              p0_transpose_item(srcw, 128, 128, 128, (bf16_t*)(ws + WS_GW) + (size_t)mtx * 16384, 0, scr, r & 7, lane, -LOG2E); }
        }
        { f32x4 ra[2][4], rb[2][4];
          p0_row_load(ra, args.in[24] + (size_t)gw * D, lane);
          for (int row = gw; row < 2 * 16384; row += 2 * ngw) {
              const int r1 = row + ngw, r1c = (r1 < 2 * 16384) ? r1 : row, r2 = (row + 2 * ngw < 2 * 16384) ? row + 2 * ngw : row;
              p0_row_load(rb, args.in[24] + (size_t)r1c * D, lane);
              p0_row_quant(ra, ws + WS_U + (size_t)row * D, (float*)(ws + WS_SCL) + row, 0, lane, false, 0, lds);
              p0_row_load(ra, args.in[24] + (size_t)r2 * D, lane);
              if (r1 < 2 * 16384) p0_row_quant(rb, ws + WS_U + (size_t)r1 * D, (float*)(ws + WS_SCL) + r1, 0, lane, false, 0, lds); } }
        for (int grp = bx; grp < 2 * 1024; grp += G) {
            __syncthreads();
            { f32x4 ra[2][4], rb[2][4]; const int r16 = wave * 2, rr = grp * 16 + r16;
              p0_row_load(ra, args.in[25] + (size_t)rr * D, lane); p0_row_load(rb, args.in[25] + (size_t)(rr + 1) * D, lane);
              p0_row_quant(ra, (unsigned char*)nullptr, (float*)(ws + WS_SCL) + 32768 + rr, 0, lane, true, r16, lds);
              p0_row_quant(rb, (unsigned char*)nullptr, (float*)(ws + WS_SCL) + 32768 + rr + 1, 0, lane, true, r16 + 1, lds); }
            __syncthreads();
            unsigned char* vbase = ws + WS_V + (size_t)(grp >> 10) * 16384 * D; const int e0g = (grp & 1023) * 16;
#pragma unroll
            for (int i = 0; i < 8; ++i) { const int idx = tid + NTHREADS * i, sl = idx >> 4, ee = idx & 15;
                const u32x2 v8 = *(const LAS u32x2*)(lds + ee * 2048 + sl * 8);
                *(u32x2*)(vbase + ((size_t)sl * 16384 + e0g + ee) * 8) = v8; }
        }
        __syncthreads();
    }
    SEAM(0);
    if (ON(1) && IN(1)) {
        LAS float* Gs = (LAS float*)lds; LAS float* Ss = (LAS float*)(lds + 16384); LAS float* Gc = (LAS float*)(lds + 32768); LAS float* Sc = (LAS float*)(lds + 40960);
        fill_mod_lds(Gs, Ss, args.in[6], MOD, 0, 1, tid);
        for (int i = tid; i < D; i += NTHREADS) { Gc[i] = args.in[6][i] * (1.0f + MODC[D + i]); Sc[i] = MODC[i]; }
        __syncthreads();
        for (int m = gw; m < T; m += ngw) { const int b = m >> 14; norm_row_q8(args.in[0] + (size_t)m * D, Gs + b * D, Ss + b * D, (unsigned*)(ws + WS_H) + (size_t)m * 512, (float*)(ws + WS_HSA) + m, lane); }
        for (int m = gw; m < TC; m += ngw) norm_row_store(args.in[2] + (size_t)m * D, Gc, Sc, HC + (size_t)m * D, lane);
        for (size_t i = (size_t)gtid * 8; i < (size_t)2 * 8 * 2 * 128 * 128; i += (size_t)nthr * 8) { const int L_ = (int)(i >> 18), hp = (int)(i >> 14) & 15, d0 = (int)i & 127;
            const float* cq = (const float*)(ws + WS_CS0) + 4096 + 6144 + L_ * D + hp * 128 + d0; const f32x4 c0 = *(const f32x4*)cq, c1 = *(const f32x4*)(cq + 4);
            const f32x4 a = *(const f32x4*)(args.in[23] + i) * c0, b = *(const f32x4*)(args.in[23] + i + 4) * c1;
            u32x4 o; o.x = pk2(a.x, a.y); o.y = pk2(a.z, a.w); o.z = pk2(b.x, b.y); o.w = pk2(b.z, b.w); *(u32x4*)((bf16_t*)(ws + WS_KEYS) + i) = o; }
        __syncthreads();
    }
    SEAM(1);
    if (ON(2) && IN(2)) {
        { pg8::Gemm g{HB, (const bf16_t*)(ws + WS_WIN0), T, 4096, D / 2}; pg8::StaticOrder S; S.init(T, 4096, G, bx);
          pg8::EpiGateXbI8 E{GGB, XBB, (const float*)(ws + WS_HSA), (const float*)(ws + WS_CS0)};
          pg8::gemm_phase<pg8::EpiGateXbI8, pg8::StaticOrder, true, true>(lds, g, S, E); }
        for (int tile = bx; tile < 256; tile += G) ctx_gemm_tile(HC, (const bf16_t*)(ws + WS_WIN0C), XBC, tile, tid);
    }
    SEAM(2);
    if (ON(3) && IN(3)) {
        for (int u = bx; u < 256; u += G) scan_unit<1>(lds, args.in[10], args.in[11], args.in[13], args.in[15], args.in[16], ws, false, u >> 7, (u >> 3) & 15, u & 7, tid);
        for (int u = bx; u < 256; u += G) scan_ctx_tile(lds, args.in[10], args.in[11], args.in[13], args.in[15], args.in[16], ws, u >> 7, (u >> 3) & 15, (u >> 2) & 1, u & 3, tid);
    }
    SEAM(3);
    if (ON(4) && IN(4)) {
        for (int u = bx; u < 256; u += G) scan_unit<2>(lds, args.in[10], args.in[11], args.in[13], args.in[15], args.in[16], ws, false, u >> 7, (u >> 3) & 15, u & 7, tid);
    }
    SEAM(4);
    {
    constexpr int pb = 5;
    const float* modL = MOD + (size_t)0 * 2 * 12288;
    if (ON(17) && IN(pb)) {
        pg8::Gemm g{HB, (const bf16_t*)(ws + WS_WOUT0), T, D, D}; pg8::StaticOrder S; S.init(T, D, G, bx);
        pg8::EpiResidBf<true> E{args.in[0], nullptr, XR, modL + 2 * D, 12288};
        pg8::gemm_phase<pg8::EpiResidBf<true>, pg8::StaticOrder, true, true>(lds, g, S, E);
    }
    SEAM(pb);
    if (ON(18) && IN(pb + 1)) {
        LAS float* Gs = (LAS float*)lds; LAS float* Ss = (LAS float*)(lds + 16384);
        fill_mod_lds(Gs, Ss, args.in[7] + (size_t)0 * D, modL, 3, 4, tid);
        __syncthreads();
        for (int m = gw; m < T; m += ngw) { const int b = m >> 14; norm_row_store_h<true, false>(XR + (size_t)m * D, Gs + b * D, Ss + b * D, nullptr, (unsigned*)(ws + WS_HQ) + (size_t)m * 512, (float*)(ws + WS_HSC) + m, lane); }
        __syncthreads();
    }
    SEAM(pb + 1);
    if (ON(19) && IN(pb + 2)) {
        pg8::Gemm g{(const bf16_t*)(ws + WS_HQ), (const bf16_t*)(ws + WS_WQ + (size_t)0 * D * D), T, D, D / 2}; pg8::StaticOrder S; S.init(T, D, G, bx);
        pg8::EpiRawI8 E{GGB, D};
        pg8::gemm_phase<pg8::EpiRawI8, pg8::StaticOrder, true, true>(lds, g, S, E);
    }
    SEAM(pb + 2);
    if (ON(20) && IN(pb + 3)) {
        for (int u = bx; u < T / 128; u += G) peer_select_unit(lds, GGB, (const bf16_t*)(ws + WS_KEYS) + (size_t)0 * 262144, (const float*)(ws + WS_HSC), (int*)(ws + WS_IDX), (float*)(ws + WS_GATE), (unsigned*)(ws + WS_ENT), (unsigned*)(ws + WS_POS), (unsigned*)(ws + WS_SEG), u, tid);
        __syncthreads();
    }
    SEAM(pb + 3);
    if (ON(21) && IN(pb + 4)) {
        for (int un = bx; un < 256; un += G) peer_u_lds(lds, ws + WS_U + (size_t)0 * 16384 * D, ws + WS_HQ, (const unsigned*)(ws + WS_ENT), (const unsigned*)(ws + WS_SEG), (int*)(ws + WS_PART), (G == 256) ? (un >> 3) : (un & 31), (G == 256) ? (un & 7) : (un >> 5), tid);
    }
    SEAM(pb + 4);
    if (ON(21) && IN(pb + 5)) {
        for (int un = bx; un < T / 128; un += G) peer_reduce_unit(lds, (const int*)(ws + WS_IDX), (const float*)(ws + WS_GATE), (const unsigned*)(ws + WS_POS), (const int*)(ws + WS_PART), (const float*)(ws + WS_HSC),
                                                              (const float*)(ws + WS_SCL) + 0 * 16384, (const float*)(ws + WS_SCL) + (2 + 0) * 16384, (unsigned*)(ws + WS_WE), (float*)(ws + WS_WSC), un, tid);
    }
    SEAM(pb + 5);
    if (ON(22) && IN(pb + 6)) {
        for (int sl_ = bx; sl_ < 256; sl_ += G) { const int sl = (G == 256) ? ((sl_ & 7) * 32 + (sl_ >> 3)) : sl_; peer_v_slice(lds, ws + WS_V + (size_t)0 * 16384 * D, (const unsigned*)(ws + WS_WE), (const float*)(ws + WS_WSC), XR, modL + 5 * D, sl, tid); }
    }
    SEAM(pb + 6);
    if (ON(23) && IN(pb + 7)) {
        LAS float* Gs = (LAS float*)lds; LAS float* Ss = (LAS float*)(lds + 16384);
        fill_mod_lds(Gs, Ss, args.in[6] + D, MOD + (size_t)2 * 12288, 0, 1, tid);
        __syncthreads();
        for (int m = gw; m < T; m += ngw) { const int b = m >> 14; norm_row_store_h<true, false>(XR + (size_t)m * D, Gs + b * D, Ss + b * D, nullptr, (unsigned*)(ws + WS_H) + (size_t)m * 512, (float*)(ws + WS_HSA) + m, lane); }
        __syncthreads();
    }
    SEAM(pb + 7);
    }
    if (ON(10) && IN(13)) {
        { pg8::Gemm g{HB, (const bf16_t*)(ws + WS_WIN1), T, D, D / 2}; pg8::StaticOrder S; S.init(T, D, G, bx);
          pg8::EpiRawI8 E{GGB, D};
          pg8::gemm_phase<pg8::EpiRawI8, pg8::StaticOrder, true, true>(lds, g, S, E); }
        { pg8::Gemm g{HB, (const bf16_t*)(ws + WS_WIN1 + (size_t)2048 * 2048), T, 4096, D / 2}; pg8::StaticOrder S; S.init(T, 4096, G, bx);
          pg8::EpiCvI8 E{XBB, (const float*)(ws + WS_HSA), (const float*)(ws + WS_CS0) + 4096 + 2048};
          pg8::gemm_phase<pg8::EpiCvI8, pg8::StaticOrder, true, true>(lds, g, S, E); }
    }
    SEAM(13);
    if (ON(11) && IN(14)) {
        LAS float* cwl = (LAS float*)lds;
        for (int i = tid; i < 4 * D; i += NTHREADS) cwl[i] = ((i < 3 * D) ? args.in[19][i] : args.in[20][i - 3 * D]) * ((const float*)(ws + WS_CS0))[4096 + (i & (D - 1))];
        __syncthreads();
        for (int m = gw; m < T; m += ngw) sc_conv_mul_row(GGB, XBB, cwl, (unsigned*)(ws + WS_H) + (size_t)m * 512, (float*)(ws + WS_HSA) + m, m, lane);
        __syncthreads();
    }
    SEAM(14);
    {
    constexpr int pb = 15;
    const float* modL = MOD + (size_t)1 * 2 * 12288;
    if (ON(17) && IN(pb)) {
        pg8::Gemm g{HB, (const bf16_t*)(ws + WS_WOUT1), T, D, D / 2}; pg8::StaticOrder S; S.init(T, D, G, bx);
        pg8::EpiResidI8 E{XR, XR, modL + 2 * D, 12288, (const float*)(ws + WS_HSA), (const float*)(ws + WS_CS0) + 4096 + 6144 + 2 * D};
        pg8::gemm_phase<pg8::EpiResidI8, pg8::StaticOrder, true, true>(lds, g, S, E);
    }
    SEAM(pb);
    if (ON(18) && IN(pb + 1)) {
        LAS float* Gs = (LAS float*)lds; LAS float* Ss = (LAS float*)(lds + 16384);
        fill_mod_lds(Gs, Ss, args.in[7] + (size_t)1 * D, modL, 3, 4, tid);
        __syncthreads();
        for (int m = gw; m < T; m += ngw) { const int b = m >> 14; norm_row_store_h<true, false>(XR + (size_t)m * D, Gs + b * D, Ss + b * D, nullptr, (unsigned*)(ws + WS_HQ) + (size_t)m * 512, (float*)(ws + WS_HSC) + m, lane); }
        __syncthreads();
    }
    SEAM(pb + 1);
    if (ON(19) && IN(pb + 2)) {
        pg8::Gemm g{(const bf16_t*)(ws + WS_HQ), (const bf16_t*)(ws + WS_WQ + (size_t)1 * D * D), T, D, D / 2}; pg8::StaticOrder S; S.init(T, D, G, bx);
        pg8::EpiRawI8 E{GGB, D};
        pg8::gemm_phase<pg8::EpiRawI8, pg8::StaticOrder, true, true>(lds, g, S, E);
    }
    SEAM(pb + 2);
    if (ON(20) && IN(pb + 3)) {
        for (int u = bx; u < T / 128; u += G) peer_select_unit(lds, GGB, (const bf16_t*)(ws + WS_KEYS) + (size_t)1 * 262144, (const float*)(ws + WS_HSC), (int*)(ws + WS_IDX), (float*)(ws + WS_GATE), (unsigned*)(ws + WS_ENT), (unsigned*)(ws + WS_POS), (unsigned*)(ws + WS_SEG), u, tid);
        __syncthreads();
    }
    SEAM(pb + 3);
    if (ON(21) && IN(pb + 4)) {
        for (int un = bx; un < 256; un += G) peer_u_lds(lds, ws + WS_U + (size_t)1 * 16384 * D, ws + WS_HQ, (const unsigned*)(ws + WS_ENT), (const unsigned*)(ws + WS_SEG), (int*)(ws + WS_PART), (G == 256) ? (un >> 3) : (un & 31), (G == 256) ? (un & 7) : (un >> 5), tid);
    }
    SEAM(pb + 4);
    if (ON(21) && IN(pb + 5)) {
        for (int un = bx; un < T / 128; un += G) peer_reduce_unit(lds, (const int*)(ws + WS_IDX), (const float*)(ws + WS_GATE), (const unsigned*)(ws + WS_POS), (const int*)(ws + WS_PART), (const float*)(ws + WS_HSC),
                                                              (const float*)(ws + WS_SCL) + 1 * 16384, (const float*)(ws + WS_SCL) + (2 + 1) * 16384, (unsigned*)(ws + WS_WE), (float*)(ws + WS_WSC), un, tid);
    }
    SEAM(pb + 5);
    if (ON(22) && IN(pb + 6)) {
        for (int sl_ = bx; sl_ < 256; sl_ += G) { const int sl = (G == 256) ? ((sl_ & 7) * 32 + (sl_ >> 3)) : sl_; peer_v_slice(lds, ws + WS_V + (size_t)1 * 16384 * D, (const unsigned*)(ws + WS_WE), (const float*)(ws + WS_WSC), XR, modL + 5 * D, sl, tid); }
    }
    SEAM(pb + 6);
    if (ON(23) && IN(pb + 7)) { for (int m = gw; m < T; m += ngw) norm_row_final_h(XR + (size_t)m * D, args.in[8], args.out + (size_t)m * D, lane); }
    }
#undef IN
#undef SEAM
}

#ifndef MK_PER_PHASE
#define MK_PER_PHASE 0
#endif
extern "C" void kernel_launch(void* const* d_in, const int* in_sizes, int n_in, void* d_out, int out_size, void* d_ws, size_t ws_size, hipStream_t stream) {
    static int grid = 0;
    if (grid == 0) {
        if (n_in != 26 || out_size != T * D || ws_size < WS_END) { fprintf(stderr, "kernel_launch: unexpected shapes (n_in %d, out %d, ws %zu)\n", n_in, out_size, ws_size); grid = -1; return; }
        int dev = 0, cus = 0;
        if (hipGetDevice(&dev) != hipSuccess || hipDeviceGetAttribute(&cus, hipDeviceAttributeMultiprocessorCount, dev) != hipSuccess) { grid = -1; return; }
        if (hipFuncSetAttribute((const void*)fwd_kernel, hipFuncAttributeMaxDynamicSharedMemorySize, LDS_BYTES) != hipSuccess) { fprintf(stderr, "kernel_launch: hipFuncSetAttribute failed\n"); grid = -1; return; }
        int per_cu = 0;
        if (hipOccupancyMaxActiveBlocksPerMultiprocessor(&per_cu, (const void*)fwd_kernel, NTHREADS, LDS_BYTES) != hipSuccess || per_cu < 1) fprintf(stderr, "kernel_launch: occupancy query reports %d\n", per_cu);
        (void)hipGetLastError();
        grid = cus;
    }
    if (grid < 0) return;
    (void)hipMemsetAsync((char*)d_ws + WS_CTL, 0, CTL_BYTES, stream);
    Args a{};
    for (int i = 0; i < 26; ++i) a.in[i] = (const float*)d_in[i];
    a.out = (float*)d_out; a.ws = (unsigned char*)d_ws;
#if MK_PER_PHASE
    for (int p = 0; p < NPHASES; ++p) { a.ph_lo = p; a.ph_hi = p + 1; hipLaunchKernelGGL(fwd_kernel, dim3(grid), dim3(NTHREADS), LDS_BYTES, stream, a); }
#else
    a.ph_lo = 0; a.ph_hi = NPHASES;
    hipLaunchKernelGGL(fwd_kernel, dim3(grid), dim3(NTHREADS), LDS_BYTES, stream, a);
#endif
}
```

```cpp
#include <hip/hip_runtime.h>
#include <cstdio>
#include <cstdint>
namespace pg8 {
#define PG8_LAS __attribute__((address_space(3)))
typedef unsigned short bf16_t;
typedef short bf16x8 __attribute__((ext_vector_type(8)));
typedef float f32x4 __attribute__((ext_vector_type(4)));
typedef unsigned u32x4 __attribute__((ext_vector_type(4)));
typedef int i32x4 __attribute__((ext_vector_type(4)));
template <bool I8> struct AccSel { typedef f32x4 type; }; template <> struct AccSel<true> { typedef i32x4 type; };
constexpr int BM = 256, BK = 64, HALF = 128, HTB = HALF * BK * 2  , STAGE_BYTES = 8 * HTB, NXCD = 8, WGM = 8;

__host__ __device__ __forceinline__ int lds_byte(int r, int c) { const int st = (r >> 4) * 2 + (c >> 5), rr = r & 15, cc = c & 31, ob = rr * 64 + cc * 2; return st * 1024 + (ob ^ (((ob >> 9) & 1) << 5)); }
__host__ __device__ __forceinline__ void stage_rc(int b, int& R, int& C) { const int st = b / 1024, sb = b % 1024, swz = sb ^ (((sb >> 9) & 1) << 5); R = (st >> 1) * 16 + swz / 64; C = (st & 1) * 32 + (swz % 64) / 2; }
__host__ __device__ __forceinline__ int perm32(int rho) { const int n = rho >> 4, i = rho & 15; return 8 * (i >> 2) + 4 * n + (i & 3); }

struct Unit { int pm, pn; };
struct Gemm { const bf16_t* A; const bf16_t* Bt; int M, N, K; };

struct StaticOrder {
    int nM, nN, nwg, G, c;
    __host__ __device__ void init(int M, int N, int G_, int c_) { nM = M / BM; nN = N / BM; nwg = nM * nN; G = G_; c = c_; }
    __host__ __device__ bool next(int i, Unit& u) const {
        const long L = (long)i * G + c; if (L >= nwg) return false;
        int wgid = (int)L; { const int q = nwg / NXCD, r = nwg % NXCD, xcd = wgid % NXCD, off = wgid / NXCD; wgid = (xcd < r ? xcd * (q + 1) : r * (q + 1) + (xcd - r) * q) + off; }
        const int nig = WGM * nN, gid = wgid / nig, fm = gid * WGM, gsz = (nM - fm) < WGM ? (nM - fm) : WGM;
        u.pm = fm + ((wgid % nig) % gsz); u.pn = (wgid % nig) / gsz; return true;
    }
    __device__ __forceinline__ void a_ready(const Unit&) const {}
    __device__ __forceinline__ void done(const Unit&) const {}
};

typedef float f32x2 __attribute__((ext_vector_type(2)));
__device__ __forceinline__ unsigned cvt_pk_bf16(float lo, float hi) { unsigned r; asm volatile("v_cvt_pk_bf16_f32 %0, %1, %2" : "=v"(r) : "v"(lo), "v"(hi)); return r; }
__device__ __forceinline__ float gelu_tanh(float x) {
    const float e = __builtin_amdgcn_exp2f(-2.302208198f * x * (1.0f + 0.044715f * x * x));
    return x * __builtin_amdgcn_rcpf(1.0f + e);
}
struct EpiGateXb {
    static constexpr bool PERM = true, AFTER_DRAIN = false, I8 = false;
    bf16_t* GG; bf16_t* XB;
    __device__ __forceinline__ void operator()(const f32x4 (&acc)[2][2][4][2], const Unit& u, int wr, int wc, int fr, int fq) const {
        const int row0 = u.pm * BM + wr * 64 + fr; const bool is_gate = u.pn < 8;
        bf16_t* base = is_gate ? GG : XB; const int col0 = (u.pn & 7) * BM + wc * 32 + 8 * fq;
#pragma unroll
        for (int ai = 0; ai < 2; ++ai)
#pragma unroll
            for (int m = 0; m < 4; ++m) { bf16_t* rowp = base + (size_t)(row0 + ai * HALF + m * 16) * 2048 + col0;
#pragma unroll
                for (int bj = 0; bj < 2; ++bj) { f32x4 v0 = acc[ai][bj][m][0], v1 = acc[ai][bj][m][1];
                    if (is_gate) {
#pragma unroll
                        for (int j = 0; j < 4; ++j) { v0[j] = gelu_tanh(v0[j]); v1[j] = gelu_tanh(v1[j]); } }
                    u32x4 w; w.x = cvt_pk_bf16(v0[0], v0[1]); w.y = cvt_pk_bf16(v0[2], v0[3]); w.z = cvt_pk_bf16(v1[0], v1[1]); w.w = cvt_pk_bf16(v1[2], v1[3]);
                    *(u32x4*)(rowp + bj * HALF) = w; } }
    }
};
struct EpiGateXbI8 {
    static constexpr bool PERM = true, AFTER_DRAIN = false, I8 = true;
    bf16_t* GG; bf16_t* XB; const float* rs; const float* cs;
    __device__ __forceinline__ void operator()(const i32x4 (&acc)[2][2][4][2], const Unit& u, int wr, int wc, int fr, int fq) const {
        const int row0 = u.pm * BM + wr * 64 + fr; const bool is_gate = u.pn < 8;
        bf16_t* base = is_gate ? GG : XB; const int col0 = (u.pn & 7) * BM + wc * 32 + 8 * fq, ccol0 = u.pn * BM + wc * 32 + 8 * fq;
        float r8[2][4];
#pragma unroll
        for (int ai = 0; ai < 2; ++ai)
#pragma unroll
            for (int m = 0; m < 4; ++m) r8[ai][m] = rs[row0 + ai * HALF + m * 16];
        f32x4 cv[2][2];
#pragma unroll
        for (int bj = 0; bj < 2; ++bj)
#pragma unroll
            for (int n = 0; n < 2; ++n) cv[bj][n] = *(const f32x4*)(cs + ccol0 + bj * HALF + 4 * n);
#pragma unroll
        for (int ai = 0; ai < 2; ++ai)
#pragma unroll
            for (int m = 0; m < 4; ++m) { const int row = row0 + ai * HALF + m * 16; const float r = r8[ai][m]; bf16_t* rowp = base + (size_t)row * 2048 + col0;
#pragma unroll
                for (int bj = 0; bj < 2; ++bj) { f32x4 v0, v1;
#pragma unroll
                    for (int j = 0; j < 4; ++j) { v0[j] = (float)acc[ai][bj][m][0][j] * r * cv[bj][0][j]; v1[j] = (float)acc[ai][bj][m][1][j] * r * cv[bj][1][j]; }
                    if (is_gate) {
#pragma unroll
                        for (int j = 0; j < 4; ++j) { v0[j] = gelu_tanh(v0[j]); v1[j] = gelu_tanh(v1[j]); } }
                    u32x4 w; w.x = cvt_pk_bf16(v0[0], v0[1]); w.y = cvt_pk_bf16(v0[2], v0[3]); w.z = cvt_pk_bf16(v1[0], v1[1]); w.w = cvt_pk_bf16(v1[2], v1[3]);
                    *(u32x4*)(rowp + bj * HALF) = w; } }
    }
};
struct EpiPlainI8 {
    static constexpr bool PERM = true, AFTER_DRAIN = false, I8 = true;
    bf16_t* O; int ldc; const float* rs; const float* cs;
    __device__ __forceinline__ void operator()(const i32x4 (&acc)[2][2][4][2], const Unit& u, int wr, int wc, int fr, int fq) const {
        const int row0 = u.pm * BM + wr * 64 + fr; const int col0 = u.pn * BM + wc * 32 + 8 * fq;
        float r8[2][4];
#pragma unroll
        for (int ai = 0; ai < 2; ++ai)
#pragma unroll
            for (int m = 0; m < 4; ++m) r8[ai][m] = rs[row0 + ai * HALF + m * 16];
        f32x4 cv[2][2];
#pragma unroll
        for (int bj = 0; bj < 2; ++bj)
#pragma unroll
            for (int n = 0; n < 2; ++n) cv[bj][n] = *(const f32x4*)(cs + col0 + bj * HALF + 4 * n);
#pragma unroll
        for (int ai = 0; ai < 2; ++ai)
#pragma unroll
            for (int m = 0; m < 4; ++m) { const int row = row0 + ai * HALF + m * 16; const float r = r8[ai][m]; bf16_t* rowp = O + (size_t)row * ldc + col0;
#pragma unroll
                for (int bj = 0; bj < 2; ++bj) { f32x4 v0, v1;
#pragma unroll
                    for (int j = 0; j < 4; ++j) { v0[j] = (float)acc[ai][bj][m][0][j] * r * cv[bj][0][j]; v1[j] = (float)acc[ai][bj][m][1][j] * r * cv[bj][1][j]; }
                    u32x4 w; w.x = cvt_pk_bf16(v0[0], v0[1]); w.y = cvt_pk_bf16(v0[2], v0[3]); w.z = cvt_pk_bf16(v1[0], v1[1]); w.w = cvt_pk_bf16(v1[2], v1[3]);
                    *(u32x4*)(rowp + bj * HALF) = w; } }
    }
};
struct EpiRawI8 {
    static constexpr bool PERM = true, AFTER_DRAIN = false, I8 = true;
    bf16_t* O; int ldc;
    __device__ __forceinline__ void operator()(const i32x4 (&acc)[2][2][4][2], const Unit& u, int wr, int wc, int fr, int fq) const {
        const int row0 = u.pm * BM + wr * 64 + fr; const int col0 = u.pn * BM + wc * 32 + 8 * fq;
#pragma unroll
        for (int ai = 0; ai < 2; ++ai)
#pragma unroll
            for (int m = 0; m < 4; ++m) { bf16_t* rowp = O + (size_t)(row0 + ai * HALF + m * 16) * ldc + col0;
#pragma unroll
                for (int bj = 0; bj < 2; ++bj) { u32x4 w;
                    w.x = cvt_pk_bf16((float)acc[ai][bj][m][0][0], (float)acc[ai][bj][m][0][1]); w.y = cvt_pk_bf16((float)acc[ai][bj][m][0][2], (float)acc[ai][bj][m][0][3]);
                    w.z = cvt_pk_bf16((float)acc[ai][bj][m][1][0], (float)acc[ai][bj][m][1][1]); w.w = cvt_pk_bf16((float)acc[ai][bj][m][1][2], (float)acc[ai][bj][m][1][3]);
                    *(u32x4*)(rowp + bj * HALF) = w; } }
    }
};
struct EpiCvI8 {
    static constexpr bool PERM = true, AFTER_DRAIN = false, I8 = true;
    bf16_t* CV; const float* rs; const float* cs;
    __device__ __forceinline__ void operator()(const i32x4 (&acc)[2][2][4][2], const Unit& u, int wr, int wc, int fr, int fq) const {
        const int row0 = u.pm * BM + wr * 64 + fr; const int col0 = u.pn * HALF + wc * 32 + 8 * fq, ccol0 = u.pn * BM + wc * 32 + 8 * fq;
        float r8[2][4];
#pragma unroll
        for (int ai = 0; ai < 2; ++ai)
#pragma unroll
            for (int m = 0; m < 4; ++m) r8[ai][m] = rs[row0 + ai * HALF + m * 16];
        f32x4 cv[2][2];
#pragma unroll
        for (int bj = 0; bj < 2; ++bj)
#pragma unroll
            for (int n = 0; n < 2; ++n) cv[bj][n] = *(const f32x4*)(cs + ccol0 + bj * HALF + 4 * n);
#pragma unroll
        for (int ai = 0; ai < 2; ++ai)
#pragma unroll
            for (int m = 0; m < 4; ++m) { const int row = row0 + ai * HALF + m * 16; const float r = r8[ai][m], r2 = r * r; bf16_t* rowp = CV + (size_t)row * 2048 + col0;
                f32x4 v0, v1;
#pragma unroll
                for (int j = 0; j < 4; ++j) { v0[j] = ((float)acc[ai][0][m][0][j] * cv[0][0][j]) * ((float)acc[ai][1][m][0][j] * cv[1][0][j]) * r2;
                                              v1[j] = ((float)acc[ai][0][m][1][j] * cv[0][1][j]) * ((float)acc[ai][1][m][1][j] * cv[1][1][j]) * r2; }
                u32x4 w; w.x = cvt_pk_bf16(v0[0], v0[1]); w.y = cvt_pk_bf16(v0[2], v0[3]); w.z = cvt_pk_bf16(v1[0], v1[1]); w.w = cvt_pk_bf16(v1[2], v1[3]);
                *(u32x4*)rowp = w; }
    }
};
struct EpiResidI8 {
    static constexpr bool PERM = true, AFTER_DRAIN = false, I8 = true;
    const bf16_t* baseh; bf16_t* out; const float* gvec; int gstride; const float* rs; const float* cs;
    __device__ __forceinline__ void operator()(const i32x4 (&acc)[2][2][4][2], const Unit& u, int wr, int wc, int fr, int fq) const {
        const int row0 = u.pm * BM + wr * 64 + fr, col0 = u.pn * BM + wc * 32 + 8 * fq; const int b = u.pm >> 6;
        float r8[2][4];
#pragma unroll
        for (int ai = 0; ai < 2; ++ai)
#pragma unroll
            for (int m = 0; m < 4; ++m) r8[ai][m] = rs[row0 + ai * HALF + m * 16];
        f32x4 gv[2][2];
#pragma unroll
        for (int bj = 0; bj < 2; ++bj)
#pragma unroll
            for (int n = 0; n < 2; ++n) gv[bj][n] = *(const f32x4*)(gvec + (size_t)b * gstride + col0 + bj * HALF + n * 4) * *(const f32x4*)(cs + col0 + bj * HALF + n * 4);
#pragma unroll
        for (int aim = 0; aim < 4; ++aim) { const int ai = aim >> 1, mh = (aim & 1) * 2;
            u32x4 bs[2][2];
#pragma unroll
            for (int mm = 0; mm < 2; ++mm)
#pragma unroll
                for (int bj = 0; bj < 2; ++bj) bs[mm][bj] = *(const u32x4*)(baseh + (size_t)(row0 + ai * HALF + (mh + mm) * 16) * 2048 + col0 + bj * HALF);
#pragma unroll
            for (int mm = 0; mm < 2; ++mm) { const int m = mh + mm; const int row = row0 + ai * HALF + m * 16; const float r = r8[ai][m]; const size_t off = (size_t)row * 2048 + col0;
#pragma unroll
                for (int bj = 0; bj < 2; ++bj) { const u32x4 bb = bs[mm][bj]; f32x4 o0, o1;
                    o0[0] = __uint_as_float(bb.x << 16) + gv[bj][0][0] * (r * (float)acc[ai][bj][m][0][0]); o0[1] = __uint_as_float(bb.x & 0xffff0000u) + gv[bj][0][1] * (r * (float)acc[ai][bj][m][0][1]);
                    o0[2] = __uint_as_float(bb.y << 16) + gv[bj][0][2] * (r * (float)acc[ai][bj][m][0][2]); o0[3] = __uint_as_float(bb.y & 0xffff0000u) + gv[bj][0][3] * (r * (float)acc[ai][bj][m][0][3]);
                    o1[0] = __uint_as_float(bb.z << 16) + gv[bj][1][0] * (r * (float)acc[ai][bj][m][1][0]); o1[1] = __uint_as_float(bb.z & 0xffff0000u) + gv[bj][1][1] * (r * (float)acc[ai][bj][m][1][1]);
                    o1[2] = __uint_as_float(bb.w << 16) + gv[bj][1][2] * (r * (float)acc[ai][bj][m][1][2]); o1[3] = __uint_as_float(bb.w & 0xffff0000u) + gv[bj][1][3] * (r * (float)acc[ai][bj][m][1][3]);
                    u32x4 w; w.x = cvt_pk_bf16(o0[0], o0[1]); w.y = cvt_pk_bf16(o0[2], o0[3]); w.z = cvt_pk_bf16(o1[0], o1[1]); w.w = cvt_pk_bf16(o1[2], o1[3]);
                    *(u32x4*)(out + off + bj * HALF) = w; } } }
    }
};
struct EpiPlainBf16 {
    static constexpr bool PERM = true, AFTER_DRAIN = false, I8 = false;
    bf16_t* O; int ldc;
    __device__ __forceinline__ void operator()(const f32x4 (&acc)[2][2][4][2], const Unit& u, int wr, int wc, int fr, int fq) const {
        const int row0 = u.pm * BM + wr * 64 + fr; const int col0 = u.pn * BM + wc * 32 + 8 * fq;
#pragma unroll
        for (int ai = 0; ai < 2; ++ai)
#pragma unroll
            for (int m = 0; m < 4; ++m) { bf16_t* rowp = O + (size_t)(row0 + ai * HALF + m * 16) * ldc + col0;
#pragma unroll
                for (int bj = 0; bj < 2; ++bj) { const f32x4 v0 = acc[ai][bj][m][0], v1 = acc[ai][bj][m][1];
                    u32x4 w; w.x = cvt_pk_bf16(v0[0], v0[1]); w.y = cvt_pk_bf16(v0[2], v0[3]); w.z = cvt_pk_bf16(v1[0], v1[1]); w.w = cvt_pk_bf16(v1[2], v1[3]);
                    *(u32x4*)(rowp + bj * HALF) = w; } }
    }
};
struct EpiCv {
    static constexpr bool PERM = true, AFTER_DRAIN = false, I8 = false;
    bf16_t* CV;
    __device__ __forceinline__ void operator()(const f32x4 (&acc)[2][2][4][2], const Unit& u, int wr, int wc, int fr, int fq) const {
        const int row0 = u.pm * BM + wr * 64 + fr; const int col0 = u.pn * HALF + wc * 32 + 8 * fq;
#pragma unroll
        for (int ai = 0; ai < 2; ++ai)
#pragma unroll
            for (int m = 0; m < 4; ++m) { bf16_t* rowp = CV + (size_t)(row0 + ai * HALF + m * 16) * 2048 + col0;
                const f32x4 v0 = acc[ai][0][m][0] * acc[ai][1][m][0], v1 = acc[ai][0][m][1] * acc[ai][1][m][1];
                u32x4 w; w.x = cvt_pk_bf16(v0[0], v0[1]); w.y = cvt_pk_bf16(v0[2], v0[3]); w.z = cvt_pk_bf16(v1[0], v1[1]); w.w = cvt_pk_bf16(v1[2], v1[3]);
                *(u32x4*)rowp = w; }
    }
};
template <bool BASE_F32> struct EpiResidBf {
    static constexpr bool PERM = true, AFTER_DRAIN = false, I8 = false;
    const float* basef; const bf16_t* baseh; bf16_t* out; const float* gvec; int gstride;
    __device__ __forceinline__ void operator()(const f32x4 (&acc)[2][2][4][2], const Unit& u, int wr, int wc, int fr, int fq) const {
        const int row0 = u.pm * BM + wr * 64 + fr, col0 = u.pn * BM + wc * 32 + 8 * fq; const int b = u.pm >> 6;
        f32x4 gv[2][2];
#pragma unroll
        for (int bj = 0; bj < 2; ++bj)
#pragma unroll
            for (int n = 0; n < 2; ++n) gv[bj][n] = *(const f32x4*)(gvec + (size_t)b * gstride + col0 + bj * HALF + n * 4);
#pragma unroll
        for (int aim = 0; aim < 4; ++aim) { const int ai = aim >> 1, mh = (aim & 1) * 2;
            f32x4 pf0[2][2], pf1[2][2]; u32x4 ph[2][2];
#pragma unroll
            for (int mm = 0; mm < 2; ++mm)
#pragma unroll
                for (int bj = 0; bj < 2; ++bj) { const size_t off = (size_t)(row0 + ai * HALF + (mh + mm) * 16) * 2048 + col0 + bj * HALF;
                    if (BASE_F32) { pf0[mm][bj] = *(const f32x4*)(basef + off); pf1[mm][bj] = *(const f32x4*)(basef + off + 4); } else ph[mm][bj] = *(const u32x4*)(baseh + off); }
#pragma unroll
            for (int mm = 0; mm < 2; ++mm) { const int m = mh + mm; const size_t off = (size_t)(row0 + ai * HALF + m * 16) * 2048 + col0;
#pragma unroll
                for (int bj = 0; bj < 2; ++bj) { f32x4 b0, b1;
                    if (BASE_F32) { b0 = pf0[mm][bj]; b1 = pf1[mm][bj]; }
                    else { const u32x4 bb = ph[mm][bj];
                        b0 = (f32x4){__uint_as_float(bb.x << 16), __uint_as_float(bb.x & 0xffff0000u), __uint_as_float(bb.y << 16), __uint_as_float(bb.y & 0xffff0000u)};
                        b1 = (f32x4){__uint_as_float(bb.z << 16), __uint_as_float(bb.z & 0xffff0000u), __uint_as_float(bb.w << 16), __uint_as_float(bb.w & 0xffff0000u)}; }
                    const f32x4 o0 = b0 + gv[bj][0] * acc[ai][bj][m][0], o1 = b1 + gv[bj][1] * acc[ai][bj][m][1];
                    u32x4 w; w.x = cvt_pk_bf16(o0[0], o0[1]); w.y = cvt_pk_bf16(o0[2], o0[3]); w.z = cvt_pk_bf16(o1[0], o1[1]); w.w = cvt_pk_bf16(o1[2], o1[3]);
                    *(u32x4*)(out + off + bj * HALF) = w; } } }
    }
};


template <class Epi, class Sched, bool ALIGN_EPI = false, bool SP2 = false>
__device__ __forceinline__ void gemm_phase(PG8_LAS unsigned char* lds, const Gemm g, const Sched& S, const Epi& E) {
    const int tid = threadIdx.x, wid = __builtin_amdgcn_readfirstlane(tid >> 6), lane = tid & 63, wr = wid >> 2, wc = wid & 3, fr = lane & 15, fq = lane >> 4;
    const int K = g.K, nt = K / BK;
    unsigned voffA[2], voffB[2];
#pragma unroll
    for (int i = 0; i < 2; ++i) { int R, C; stage_rc(tid * 16 + i * 8192, R, C); const int Rb = Epi::PERM ? ((R & ~31) + perm32(R & 31)) : R;
        voffA[i] = (unsigned)(R * K + C) * 2u; voffB[i] = (unsigned)(Rb * K + C) * 2u; }
    const size_t kstep = (size_t)(BK * 2);
    const size_t hstep = (size_t)HALF * K * 2;
    const size_t tstep = 2 * hstep;
    const unsigned ldsw = (unsigned)wid * 1024u;
    const int aoff = lds_byte(wr * 64 + fr, fq * 8), boff = lds_byte(wc * 32 + fr, fq * 8);
#define PG8_SA(b, h) (((b) * 2 + (h)) * HTB)
#define PG8_SB(b, h) ((4 + (b) * 2 + (h)) * HTB)
#define PG8_STAGE(bufoff, gbase, voff) do { _Pragma("unroll") for (int _i = 0; _i < 2; ++_i) \
        __builtin_amdgcn_global_load_lds((const unsigned*)((const char*)(gbase) + (voff)[_i]), (PG8_LAS unsigned*)(lds + (bufoff) + ldsw + _i * 8192), 16, 0, 0); } while (0)
#define PG8_LDA(dst, b, h) do { _Pragma("unroll") for (int m = 0; m < 4; ++m) _Pragma("unroll") for (int k = 0; k < 2; ++k) dst[m][k] = *(const PG8_LAS bf16x8*)(lds + PG8_SA(b, h) + aoff + m * 2048 + k * 1024); } while (0)
#define PG8_LDB(dst, b, h) do { _Pragma("unroll") for (int n = 0; n < 2; ++n) _Pragma("unroll") for (int k = 0; k < 2; ++k) dst[n][k] = *(const PG8_LAS bf16x8*)(lds + PG8_SB(b, h) + boff + n * 2048 + k * 1024); } while (0)
#define PG8_MMA(ai, bj, At, Bt) do { __builtin_amdgcn_s_setprio(1); _Pragma("unroll") for (int m = 0; m < 4; ++m) _Pragma("unroll") for (int n = 0; n < 2; ++n) _Pragma("unroll") for (int k = 0; k < 2; ++k) \
        { if constexpr (Epi::I8) acc[ai][bj][m][n] = __builtin_amdgcn_mfma_i32_16x16x64_i8(__builtin_bit_cast(i32x4, Bt[n][k]), __builtin_bit_cast(i32x4, At[m][k]), acc[ai][bj][m][n], 0, 0, 0); \
          else acc[ai][bj][m][n] = __builtin_amdgcn_mfma_f32_16x16x32_bf16(Bt[n][k], At[m][k], acc[ai][bj][m][n], 0, 0, 0); } __builtin_amdgcn_s_setprio(0); } while (0)
#define PG8_WAIT_V(n) asm volatile("s_waitcnt vmcnt(" #n ")" ::: "memory")
#define PG8_WAIT_L(n) asm volatile("s_waitcnt lgkmcnt(" #n ")" ::: "memory")
#define PG8_BAR __builtin_amdgcn_s_barrier()
#define PG8_SCHED __builtin_amdgcn_sched_barrier(0)
    Unit cur, nxt; int ui = 0;
    if (!S.next(0, cur)) return;
    typedef typename AccSel<Epi::I8>::type acc_t;
    acc_t acc[2][2][4][2];
#pragma unroll
    for (int a = 0; a < 2; ++a)
#pragma unroll
        for (int b = 0; b < 2; ++b)
#pragma unroll
            for (int m = 0; m < 4; ++m)
#pragma unroll
                for (int n = 0; n < 2; ++n) acc[a][b][m][n] = (acc_t){0, 0, 0, 0};
    bf16x8 At[4][2], B0[2][2], B1[2][2];
    const char* cA = (const char*)g.A + (size_t)cur.pm * tstep; const char* cB = (const char*)g.Bt + (size_t)cur.pn * tstep;
    S.a_ready(cur);
    if constexpr (SP2) {
        PG8_STAGE(PG8_SB(0, 0), cB, voffB); PG8_STAGE(PG8_SB(0, 1), cB + hstep, voffB); PG8_STAGE(PG8_SA(0, 0), cA, voffA); PG8_STAGE(PG8_SA(0, 1), cA + hstep, voffA);
        if (wr == 1) PG8_BAR;
        PG8_WAIT_V(2); PG8_BAR;
        PG8_STAGE(PG8_SB(1, 0), cB + kstep, voffB); PG8_STAGE(PG8_SA(1, 0), cA + kstep, voffA); PG8_STAGE(PG8_SB(1, 1), cB + hstep + kstep, voffB);
        PG8_WAIT_V(6); PG8_BAR;
    } else {
        PG8_STAGE(PG8_SB(0, 0), cB, voffB); PG8_STAGE(PG8_SA(0, 0), cA, voffA); PG8_STAGE(PG8_SB(0, 1), cB + hstep, voffB); PG8_STAGE(PG8_SA(0, 1), cA + hstep, voffA);
        if (wr == 1) PG8_BAR;
        PG8_WAIT_V(4); PG8_BAR;
        PG8_STAGE(PG8_SB(1, 0), cB + kstep, voffB); PG8_STAGE(PG8_SA(1, 0), cA + kstep, voffA); PG8_STAGE(PG8_SB(1, 1), cB + hstep + kstep, voffB);
        PG8_WAIT_V(6); PG8_BAR;
    }
    for (;;) {
        const bool has_next = S.next(ui + 1, nxt);
        const char* nA = has_next ? (const char*)g.A + (size_t)nxt.pm * tstep : cA; const char* nB = has_next ? (const char*)g.Bt + (size_t)nxt.pn * tstep : cB;
        for (int t = 0; t < nt; t += 2) {
            const bool last = (t == nt - 2);
            const char* a1 = cA + (size_t)(t + 1) * kstep;
            const char* a2 = last ? nA : cA + (size_t)(t + 2) * kstep; const char* b2 = last ? nB : cB + (size_t)(t + 2) * kstep;
            const char* a3 = a2 + kstep; const char* b3 = b2 + kstep;
            if (last && has_next) S.a_ready(nxt);
            if constexpr (SP2) {
            PG8_LDB(B0, 0, 0); PG8_LDB(B1, 0, 1); PG8_SCHED; PG8_LDA(At, 0, 0); PG8_STAGE(PG8_SA(1, 1), a1 + hstep, voffA);
            PG8_WAIT_V(8); PG8_WAIT_L(0); PG8_BAR; PG8_MMA(0, 0, At, B0); PG8_MMA(0, 1, At, B1); PG8_BAR; PG8_SCHED;
            PG8_LDA(At, 0, 1); PG8_STAGE(PG8_SB(0, 0), b2, voffB); PG8_STAGE(PG8_SB(0, 1), b2 + hstep, voffB); PG8_STAGE(PG8_SA(0, 0), a2, voffA);
            PG8_WAIT_V(8); PG8_WAIT_L(0); PG8_BAR; PG8_MMA(1, 0, At, B0); PG8_MMA(1, 1, At, B1); PG8_BAR; PG8_SCHED;
            PG8_LDB(B0, 1, 0); PG8_LDB(B1, 1, 1); PG8_SCHED; PG8_LDA(At, 1, 0); PG8_STAGE(PG8_SA(0, 1), a2 + hstep, voffA);
            PG8_WAIT_V(8); PG8_WAIT_L(0); PG8_BAR; PG8_MMA(0, 0, At, B0); PG8_MMA(0, 1, At, B1); PG8_BAR; PG8_SCHED;
            PG8_LDA(At, 1, 1); PG8_STAGE(PG8_SB(1, 0), b3, voffB); PG8_STAGE(PG8_SB(1, 1), b3 + hstep, voffB); PG8_STAGE(PG8_SA(1, 0), a3, voffA);
            PG8_WAIT_V(8); PG8_WAIT_L(0); PG8_BAR; PG8_MMA(1, 0, At, B0); PG8_MMA(1, 1, At, B1); PG8_BAR; PG8_SCHED;
            } else {
            PG8_LDB(B0, 0, 0); PG8_SCHED; PG8_LDA(At, 0, 0); PG8_STAGE(PG8_SA(1, 1), a1 + hstep, voffA);
            PG8_WAIT_L(8); PG8_BAR; PG8_WAIT_L(0); PG8_MMA(0, 0, At, B0); PG8_BAR; PG8_SCHED;
            PG8_LDB(B1, 0, 1); PG8_STAGE(PG8_SB(0, 0), b2, voffB);
            PG8_BAR; PG8_WAIT_L(0); PG8_MMA(0, 1, At, B1); PG8_BAR;
            PG8_LDA(At, 0, 1); PG8_STAGE(PG8_SA(0, 0), a2, voffA);
            PG8_BAR; PG8_WAIT_L(0); PG8_MMA(1, 0, At, B0); PG8_BAR; PG8_SCHED;
            PG8_STAGE(PG8_SB(0, 1), b2 + hstep, voffB);
            PG8_WAIT_V(6); PG8_BAR; PG8_MMA(1, 1, At, B1); PG8_BAR;
            PG8_LDB(B0, 1, 0); PG8_SCHED; PG8_LDA(At, 1, 0); PG8_STAGE(PG8_SA(0, 1), a2 + hstep, voffA);
            PG8_WAIT_L(8); PG8_BAR; PG8_WAIT_L(0); PG8_MMA(0, 0, At, B0); PG8_BAR; PG8_SCHED;
            PG8_LDB(B1, 1, 1); PG8_STAGE(PG8_SB(1, 0), b3, voffB);
            PG8_BAR; PG8_WAIT_L(0); PG8_MMA(0, 1, At, B1); PG8_BAR;
            PG8_LDA(At, 1, 1); PG8_STAGE(PG8_SA(1, 0), a3, voffA);
            PG8_BAR; PG8_WAIT_L(0); PG8_MMA(1, 0, At, B0); PG8_BAR; PG8_SCHED;
            PG8_STAGE(PG8_SB(1, 1), b3 + hstep, voffB);
            PG8_WAIT_V(6); PG8_BAR; PG8_MMA(1, 1, At, B1); PG8_BAR;
            }
        }
        if constexpr (ALIGN_EPI) { if (wr == 0) PG8_BAR; }
        if constexpr (!Epi::AFTER_DRAIN) { E(acc, cur, wr, wc, fr, fq); S.done(cur); }
        if (!has_next) break;
#pragma unroll
        for (int a = 0; a < 2; ++a)
#pragma unroll
            for (int b = 0; b < 2; ++b)
#pragma unroll
                for (int m = 0; m < 4; ++m)
#pragma unroll
                    for (int n = 0; n < 2; ++n) acc[a][b][m][n] = (acc_t){0, 0, 0, 0};
        cur = nxt; cA = nA; cB = nB; ++ui;
        if constexpr (ALIGN_EPI) { if (wr == 1) PG8_BAR; }
    }
    PG8_WAIT_V(0);
    if constexpr (!ALIGN_EPI) { if (wr == 0) PG8_BAR; }
    PG8_BAR;
    if constexpr (Epi::AFTER_DRAIN) { E.fused(acc, cur, wr, wc, fr, fq, lds, wid, lane); S.done(cur); }
#undef PG8_SA
#undef PG8_SB
#undef PG8_STAGE
#undef PG8_LDA
#undef PG8_LDB
#undef PG8_MMA
#undef PG8_WAIT_V
#undef PG8_WAIT_L
#undef PG8_BAR
#undef PG8_SCHED
}
}
#define XB_TMO      128
#define XB_XCNT(j)  (256  + 64 * (j))
#define XB_XSUB(j)  (1280 + 64 * (j))
#define XB_XGEN(j)  (2304 + 64 * (j))
#define XB_TOP      3328
#define XB_TOPGEN   3392
#define XCD_BAR_WORDS 3456
#define XB_SPIN_CAP (1u << 18)
#define LAS __attribute__((address_space(3)))

__device__ __forceinline__ unsigned xb_ld(unsigned* p)              { return __hip_atomic_load(p, __ATOMIC_RELAXED, __HIP_MEMORY_SCOPE_AGENT); }
__device__ __forceinline__ unsigned xb_add(unsigned* p, unsigned v) { return __hip_atomic_fetch_add(p, v, __ATOMIC_RELAXED, __HIP_MEMORY_SCOPE_AGENT); }
__device__ __forceinline__ unsigned xb_xcc_id() { return (unsigned)__builtin_amdgcn_s_getreg((3 << 11) | 20) & 0xFu; }
#define XB_SPIN(cond, bar) do { unsigned _sp = 0; while (cond) { __builtin_amdgcn_s_sleep(1); \
    if ((++_sp & 255u) == 0u) { if (xb_ld(&(bar)[XB_TMO])) break; if (_sp > XB_SPIN_CAP) { atomicAdd(&(bar)[XB_TMO], 1u); break; } } } } while (0)

struct XcdBarrier {
    unsigned* bar; unsigned x;
    volatile LAS unsigned* st;
};

__device__ __forceinline__ XcdBarrier xcd_barrier_post(unsigned* bar, volatile LAS unsigned* st) {
    XcdBarrier b; b.bar = bar; b.x = xb_xcc_id(); b.st = st;
    if (threadIdx.x == 0) (void)xb_add(&bar[XB_XCNT(b.x)], 1u);
    return b;
}
__device__ __forceinline__ void xcd_barrier_complete(unsigned* bar, unsigned x, unsigned& nloc, unsigned& nx) {
    const unsigned G = gridDim.x * gridDim.y * gridDim.z;
    unsigned sum, cnt, mine, sp = 0u;
    for (;;) {
        sum = 0u; cnt = 0u; mine = 0u;
#pragma unroll
        for (unsigned j = 0; j < 16; ++j) { const unsigned c = xb_ld(&bar[XB_XCNT(j)]); sum += c; cnt += (c > 0u) ? 1u : 0u; mine = (j == x) ? c : mine; }
        if (sum == G) break;
        __builtin_amdgcn_s_sleep(1);
        if ((++sp & 255u) == 0u) { if (xb_ld(&bar[XB_TMO])) break; if (sp > XB_SPIN_CAP) { atomicAdd(&bar[XB_TMO], 1u); break; } }
    }
    nloc = mine > 0u ? mine : 1u; nx = cnt > 0u ? cnt : 1u;
}

__device__ __forceinline__ void xcd_barrier(const XcdBarrier& b) {
    asm volatile("s_waitcnt vmcnt(0)" ::: "memory");
    __syncthreads();
    if (threadIdx.x == 0) {
        unsigned* bar = b.bar;
        __builtin_amdgcn_s_waitcnt(0);
        unsigned nloc = b.st[0], nx = b.st[1];
        if (nloc == 0u) { xcd_barrier_complete(bar, b.x, nloc, nx); b.st[0] = nloc; b.st[1] = nx; }
        const unsigned old = xb_add(&bar[XB_XSUB(b.x)], 1u);
        const unsigned gen = old / nloc;
        if (old + 1u == (gen + 1u) * nloc) {
            __builtin_amdgcn_fence(__ATOMIC_RELEASE, "agent");
            asm volatile("s_waitcnt vmcnt(0)" ::: "memory");
            const unsigned og = xb_add(&bar[XB_TOP], 1u);
            const unsigned tg = og / nx;
            if (og + 1u == (tg + 1u) * nx) xb_add(&bar[XB_TOPGEN], 1u);
            else XB_SPIN(xb_ld(&bar[XB_TOPGEN]) == tg, bar);
            __builtin_amdgcn_fence(__ATOMIC_ACQUIRE, "agent");
            xb_add(&bar[XB_XGEN(b.x)], 1u);
            asm volatile("s_waitcnt vmcnt(0)" ::: "memory");
        } else {
            XB_SPIN(xb_ld(&bar[XB_XGEN(b.x)]) == gen, bar);
            __builtin_amdgcn_fence(__ATOMIC_ACQUIRE, "agent");
            asm volatile("s_waitcnt vmcnt(0)" ::: "memory");
        }
    }
    __syncthreads();
}
constexpr int D = 2048, NBATCH = 2, SEQ = 16384, T = NBATCH * SEQ, CTXL = 256, TC = NBATCH * CTXL;
constexpr float EPS = 1e-6f;
constexpr int NTHREADS = 512, NWAVES = 8;
constexpr float LOG2E = 1.4426950408889634f;

constexpr size_t MiB = 1u << 20;
constexpr size_t WS_CTL = 0, CTL_BYTES = 1 * MiB;
constexpr size_t WS_MOD = 1 * MiB;
constexpr size_t WS_MODC = WS_MOD + 256 * 1024;
constexpr size_t WS_SUMA = 2 * MiB;
constexpr size_t WS_SUMB = WS_SUMA + 256 * 1024;
constexpr size_t WS_CSA = WS_SUMA + 576 * 1024, WS_CSB = WS_SUMA + 704 * 1024;
constexpr size_t WS_H0 = WS_SUMA + 512 * 1024;
constexpr size_t WS_GW = 3 * MiB;
constexpr size_t WS_KEYS = 5 * MiB;
constexpr size_t WS_WIN0 = 6 * MiB, WS_WOUT0 = 22 * MiB, WS_WIN1 = 30 * MiB, WS_WOUT1 = 54 * MiB, WS_WQ = 62 * MiB;
constexpr size_t WS_HC = 78 * MiB, WS_XBC = 80 * MiB, WS_IDX = 82 * MiB, WS_GATE = 98 * MiB;
constexpr size_t WS_SCL = 114 * MiB;
constexpr size_t WS_U = 128 * MiB, WS_V = 192 * MiB;
constexpr size_t WS_H = 384 * MiB, WS_GG = 512 * MiB, WS_XB = 640 * MiB, WS_XR = 768 * MiB  , WS_END = 896 * MiB;
constexpr size_t WS_WE = WS_XB + 96 * MiB;
constexpr size_t WS_WSC = WS_XB + 112 * MiB;
constexpr size_t WS_HQ = WS_XB;
constexpr size_t WS_ENT = 480 * MiB;
constexpr size_t WS_POS = WS_XB + 80 * MiB;
constexpr size_t WS_HSC = WS_XB + 113 * MiB;
constexpr size_t WS_SEG = WS_XB + 114 * MiB;
constexpr size_t WS_PART = 256 * MiB;
constexpr int POOLU = 20480;
constexpr int NPOOL = (T / 128) * POOLU;
constexpr size_t WS_HSA = 115 * MiB;
constexpr size_t WS_CS0 = 116 * MiB;
constexpr size_t WS_WIN0C = WS_WIN0 + 8 * MiB;
constexpr int CW_BAR = 4096;

constexpr int SCRATCH_BYTES = 131072, MISC_OFF = SCRATCH_BYTES, LDS_BYTES = 147456;

#define LAS __attribute__((address_space(3)))
using pg8::bf16_t; using pg8::bf16x8; using pg8::f32x4; using pg8::u32x4;
typedef unsigned u32x2 __attribute__((ext_vector_type(2)));
struct __attribute__((packed, aligned(4))) u32x3 { unsigned x, y, z; };
typedef __bf16 bf16v2 __attribute__((ext_vector_type(2)));

__device__ __forceinline__ float bflo(unsigned u) { return __uint_as_float(u << 16); }
__device__ __forceinline__ float bfhi(unsigned u) { return __uint_as_float(u & 0xffff0000u); }
__device__ __forceinline__ unsigned pk2(float lo, float hi) { return pg8::cvt_pk_bf16(lo, hi); }
__device__ __forceinline__ float wave_sum(float v) {
#pragma unroll
    for (int o = 1; o < 64; o <<= 1) v += __shfl_xor(v, o);
    return v;
}
__device__ __forceinline__ float dot2bf(unsigned a, unsigned b, float c) { return __builtin_amdgcn_fdot2_f32_bf16(__builtin_bit_cast(bf16v2, a), __builtin_bit_cast(bf16v2, b), c, false); }
__device__ __forceinline__ float silu_f(float v) { return v / (1.0f + __expf(-v)); }
__device__ __forceinline__ float sigmoid_f(float z) { return __builtin_amdgcn_rcpf(1.0f + __builtin_amdgcn_exp2f(-z * LOG2E)); }
#define DPP_ROR(x, n) __builtin_amdgcn_update_dpp(0, (x), 0x120 + (n), 0xf, 0xf, false)
__device__ __forceinline__ unsigned row_max_u32(unsigned m) {
    m = max(m, (unsigned)DPP_ROR((int)m, 8)); m = max(m, (unsigned)DPP_ROR((int)m, 4)); m = max(m, (unsigned)DPP_ROR((int)m, 2)); m = max(m, (unsigned)DPP_ROR((int)m, 1)); return m; }
__device__ __forceinline__ float row_sum_f32(float v) {
    v += __int_as_float(DPP_ROR(__float_as_int(v), 8)); v += __int_as_float(DPP_ROR(__float_as_int(v), 4)); v += __int_as_float(DPP_ROR(__float_as_int(v), 2)); v += __int_as_float(DPP_ROR(__float_as_int(v), 1)); return v; }
__device__ __forceinline__ float wave_sum_rows(float v) {
    v = row_sum_f32(v);
    const float a = __int_as_float(__builtin_amdgcn_readlane(__float_as_int(v), 0)), b = __int_as_float(__builtin_amdgcn_readlane(__float_as_int(v), 16));
    const float c = __int_as_float(__builtin_amdgcn_readlane(__float_as_int(v), 32)), d = __int_as_float(__builtin_amdgcn_readlane(__float_as_int(v), 48));
    return (a + b) + (c + d);
}

__device__ __forceinline__ void p0_transpose_item(const float* W, int K, int N, int ldw, bf16_t* WT, int row_off, LAS float* scr, int item, int lane, float scale = 1.0f) {
    const int nblk = N / 32, kb = item / nblk, nb = item % nblk, k0 = 64 * kb, n0 = 32 * nb;
#pragma unroll 8
    for (int i = 0; i < 32; ++i) { const int kk = 2 * i + (lane >> 5); scr[kk * 33 + (lane & 31)] = W[(size_t)(k0 + kk) * ldw + n0 + (lane & 31)] * scale; }
    asm volatile("s_waitcnt lgkmcnt(0)" ::: "memory");
    const int c = lane & 7;
#pragma unroll
    for (int j = 0; j < 4; ++j) { const int n = (lane >> 3) + 8 * j; const LAS float* s = scr + (8 * c) * 33 + n;
        u32x4 o; o.x = pk2(s[0 * 33], s[1 * 33]); o.y = pk2(s[2 * 33], s[3 * 33]); o.z = pk2(s[4 * 33], s[5 * 33]); o.w = pk2(s[6 * 33], s[7 * 33]);
        *(u32x4*)(WT + (size_t)(row_off + n0 + n) * K + k0 + 8 * c) = o; }
    asm volatile("s_waitcnt lgkmcnt(0)" ::: "memory");
}
__device__ __forceinline__ void p0_convert(const float* src, bf16_t* dst, size_t n, size_t gtid, size_t nthr) {
#pragma unroll 4
    for (size_t i = gtid * 8; i < n; i += nthr * 8) { const f32x4 a = *(const f32x4*)(src + i), b = *(const f32x4*)(src + i + 4);
        u32x4 o; o.x = pk2(a.x, a.y); o.y = pk2(a.z, a.w); o.z = pk2(b.x, b.y); o.w = pk2(b.z, b.w); *(u32x4*)(dst + i) = o; }
}
__device__ __forceinline__ void p0_row_load(f32x4 (&v)[2][4], const float* src, int lane) {
#pragma unroll
    for (int c = 0; c < 2; ++c)
#pragma unroll
        for (int j = 0; j < 4; ++j) v[c][j] = *(const f32x4*)(src + 1024 * c + 16 * lane + 4 * j);
}
__device__ __forceinline__ void p0_row_quant(const f32x4 (&v)[2][4], unsigned char* dst, float* scale_out, int bias, int lane, bool to_lds, int erow, LAS unsigned char* lds) {
    float am = 0.f;
#pragma unroll
    for (int c = 0; c < 2; ++c)
#pragma unroll
        for (int j = 0; j < 4; ++j) am = fmaxf(am, fmaxf(fmaxf(fabsf(v[c][j].x), fabsf(v[c][j].y)), fmaxf(fabsf(v[c][j].z), fabsf(v[c][j].w))));
#pragma unroll
    for (int o = 1; o < 64; o <<= 1) am = fmaxf(am, __shfl_xor(am, o));
    const float sc = am > 0.f ? am * (1.0f / 127.0f) : 1.0f, inv = 1.0f / sc;
    if (lane == 0) *scale_out = sc;
#pragma unroll
    for (int c = 0; c < 2; ++c) { u32x4 o;
#pragma unroll
        for (int j = 0; j < 4; ++j) { const f32x4 x = v[c][j];
            const unsigned q0 = (unsigned)((int)rintf(x.x * inv) + bias) & 255u, q1 = (unsigned)((int)rintf(x.y * inv) + bias) & 255u, q2 = (unsigned)((int)rintf(x.z * inv) + bias) & 255u, q3 = (unsigned)((int)rintf(x.w * inv) + bias) & 255u;
            o[j] = q0 | (q1 << 8) | (q2 << 16) | (q3 << 24); }
        if (!to_lds) *(u32x4*)(dst + 1024 * c + 16 * lane) = o;
        else *(LAS u32x4*)(lds + erow * 2048 + 1024 * c + 16 * lane) = o; }
}
__device__ __forceinline__ void p0_quant_row(const float* src, unsigned char* dst, float* scale_out, int bias, int lane, bool to_lds, int erow, LAS unsigned char* lds) {
    f32x4 v[2][4]; p0_row_load(v, src, lane); p0_row_quant(v, dst, scale_out, bias, lane, to_lds, erow, lds);
}
__device__ __forceinline__ void p0_quant_strip(LAS unsigned char* lds, const float* W, int N, int col0, unsigned char* WT8, float* cs, int row_off, int tid) {
    LAS float* red = (LAS float*)lds; LAS float* inv = (LAS float*)(lds + 4096);
    const int lane = tid & 63, w = tid >> 6;
    { float m0 = 0.f, m1 = 0.f; const float* Wp = W + col0 + 2 * lane;
#pragma unroll 8
      for (int k = 256 * w; k < 256 * w + 256; ++k) { const float2 x = *(const float2*)(Wp + (size_t)k * N); m0 = fmaxf(m0, fabsf(x.x)); m1 = fmaxf(m1, fabsf(x.y)); }
      red[w * 128 + 2 * lane] = m0; red[w * 128 + 2 * lane + 1] = m1; }
    __syncthreads();
    if (tid < 128) { float am = 0.f;
#pragma unroll
        for (int ww = 0; ww < 8; ++ww) am = fmaxf(am, red[ww * 128 + tid]);
        const float sc = am > 0.f ? am * (1.0f / 127.0f) : 1.0f; cs[row_off + tid] = sc; inv[tid] = 1.0f / sc; }
    __syncthreads();
    LAS float* scr = (LAS float*)(lds + 8192 + w * 8448);
    for (int it = w; it < 128; it += NWAVES) { const int k0 = 64 * (it >> 2), n0 = 32 * (it & 3);
#pragma unroll 8
        for (int i = 0; i < 32; ++i) { const int kk = 2 * i + (lane >> 5); scr[kk * 33 + (lane & 31)] = W[(size_t)(k0 + kk) * N + col0 + n0 + (lane & 31)]; }
        asm volatile("s_waitcnt lgkmcnt(0)" ::: "memory");
        const int c = lane & 3;
#pragma unroll
        for (int j = 0; j < 2; ++j) { const int n = (lane >> 2) + 16 * j; const float iv = inv[n0 + n]; const LAS float* sp = scr + (16 * c) * 33 + n; u32x4 o;
#pragma unroll
            for (int d = 0; d < 4; ++d) o[d] = ((unsigned)(int)rintf(sp[(4 * d + 0) * 33] * iv) & 255u) | (((unsigned)(int)rintf(sp[(4 * d + 1) * 33] * iv) & 255u) << 8)
                                             | (((unsigned)(int)rintf(sp[(4 * d + 2) * 33] * iv) & 255u) << 16) | (((unsigned)(int)rintf(sp[(4 * d + 3) * 33] * iv) & 255u) << 24);
            *(u32x4*)(WT8 + (size_t)(row_off + n0 + n) * 2048 + k0 + 16 * c) = o; }
        asm volatile("s_waitcnt lgkmcnt(0)" ::: "memory"); }
    __syncthreads();
}
__device__ __forceinline__ void p0_gemv(LAS unsigned char* lds, const float* c, const float* cctx, const float* w_mod, const float* b_mod, float* MOD, float* MODC, int item, int tid) {
    LAS float* sv = (LAS float*)lds; LAS float* red = (LAS float*)(lds + 24576);
    for (int i = tid; i < 2048; i += NTHREADS) { sv[i] = silu_f(c[i]); sv[2048 + i] = silu_f(c[2048 + i]); sv[4096 + i] = silu_f(cctx[i]); }
    __syncthreads();
    const int layer = item / 96, col0 = (item % 96) * 128, w = tid >> 6, l = tid & 63;
    const float* W = w_mod + (size_t)layer * 2048 * 12288 + col0 + 2 * l;
    float a00 = 0.f, a01 = 0.f, a10 = 0.f, a11 = 0.f, a20 = 0.f, a21 = 0.f;
#pragma unroll 8
    for (int k = 256 * w; k < 256 * w + 256; ++k) { const float2 wv = *(const float2*)(W + (size_t)k * 12288); const float s0 = sv[k], s1 = sv[2048 + k], s2 = sv[4096 + k];
        a00 += s0 * wv.x; a01 += s0 * wv.y; a10 += s1 * wv.x; a11 += s1 * wv.y; a20 += s2 * wv.x; a21 += s2 * wv.y; }
    red[(w * 3 + 0) * 128 + 2 * l] = a00; red[(w * 3 + 0) * 128 + 2 * l + 1] = a01;
    red[(w * 3 + 1) * 128 + 2 * l] = a10; red[(w * 3 + 1) * 128 + 2 * l + 1] = a11;
    red[(w * 3 + 2) * 128 + 2 * l] = a20; red[(w * 3 + 2) * 128 + 2 * l + 1] = a21;
    __syncthreads();
    if (tid < 384) { const int r = tid >> 7, cc = tid & 127; float s = 0.f;
#pragma unroll
        for (int ww = 0; ww < 8; ++ww) s += red[(ww * 3 + r) * 128 + cc];
        const int col = col0 + cc; const float val = s + b_mod[layer * 12288 + col];
        if (r < 2) MOD[(layer * 2 + r) * 12288 + col] = val; else if (layer == 0 && col < 4096) MODC[col] = val; }
    __syncthreads();
}

__device__ __forceinline__ void norm_row_store(const float* xrow, const LAS float* Gv, const LAS float* Sv, bf16_t* orow, int lane) {
    f32x4 v[8]; float ss = 0.f;
#pragma unroll
    for (int j = 0; j < 8; ++j) { v[j] = *(const f32x4*)(xrow + 4 * lane + 256 * j); ss += (v[j].x * v[j].x + v[j].y * v[j].y) + (v[j].z * v[j].z + v[j].w * v[j].w); }
    ss = wave_sum(ss);
    const float rstd = rsqrtf(ss * (1.0f / D) + EPS);
#pragma unroll
    for (int j = 0; j < 8; ++j) { const f32x4 g = *(const LAS f32x4*)(Gv + 4 * lane + 256 * j), s = *(const LAS f32x4*)(Sv + 4 * lane + 256 * j);
        const f32x4 o = v[j] * rstd * g + s; u32x2 p; p.x = pk2(o.x, o.y); p.y = pk2(o.z, o.w); *(u32x2*)(orow + 4 * lane + 256 * j) = p; }
}
__device__ __forceinline__ void norm_row_store_q(const float* xrow, const LAS float* Gv, const LAS float* Sv, bf16_t* orow, unsigned* hqrow, float* hsc, int lane) {
    f32x4 v[8]; float ss = 0.f;
#pragma unroll
    for (int j = 0; j < 8; ++j) { v[j] = *(const f32x4*)(xrow + 4 * lane + 256 * j); ss += (v[j].x * v[j].x + v[j].y * v[j].y) + (v[j].z * v[j].z + v[j].w * v[j].w); }
    ss = wave_sum(ss);
    const float rstd = rsqrtf(ss * (1.0f / D) + EPS); float am = 0.f;
#pragma unroll
    for (int j = 0; j < 8; ++j) { const f32x4 g = *(const LAS f32x4*)(Gv + 4 * lane + 256 * j), s = *(const LAS f32x4*)(Sv + 4 * lane + 256 * j);
        const f32x4 o = v[j] * rstd * g + s; v[j] = o; u32x2 p; p.x = pk2(o.x, o.y); p.y = pk2(o.z, o.w); *(u32x2*)(orow + 4 * lane + 256 * j) = p;
        am = fmaxf(am, fmaxf(fmaxf(fabsf(o.x), fabsf(o.y)), fmaxf(fabsf(o.z), fabsf(o.w)))); }
#pragma unroll
    for (int o = 1; o < 64; o <<= 1) am = fmaxf(am, __shfl_xor(am, o));
    const float hs = am > 0.f ? am * (1.0f / 127.0f) : 1.0f, inv = 1.0f / hs;
    if (lane == 0) *hsc = hs;
#pragma unroll
    for (int j = 0; j < 8; ++j) { const f32x4 o = v[j];
        hqrow[64 * j + lane] = ((unsigned)(int)rintf(o.x * inv) & 255u) | (((unsigned)(int)rintf(o.y * inv) & 255u) << 8) | (((unsigned)(int)rintf(o.z * inv) & 255u) << 16) | (((unsigned)(int)rintf(o.w * inv) & 255u) << 24); }
}
__device__ __forceinline__ void norm_row_q8(const float* xrow, const LAS float* Gv, const LAS float* Sv, unsigned* hqrow, float* hsc, int lane) {
    f32x4 v[8]; float ss = 0.f;
#pragma unroll
    for (int j = 0; j < 8; ++j) { v[j] = *(const f32x4*)(xrow + 4 * lane + 256 * j); ss += (v[j].x * v[j].x + v[j].y * v[j].y) + (v[j].z * v[j].z + v[j].w * v[j].w); }
    ss = wave_sum(ss);
    const float rstd = rsqrtf(ss * (1.0f / D) + EPS); float am = 0.f;
#pragma unroll
    for (int j = 0; j < 8; ++j) { const f32x4 g = *(const LAS f32x4*)(Gv + 4 * lane + 256 * j), sft = *(const LAS f32x4*)(Sv + 4 * lane + 256 * j);
        const f32x4 o = v[j] * rstd * g + sft; v[j] = o; am = fmaxf(am, fmaxf(fmaxf(fabsf(o.x), fabsf(o.y)), fmaxf(fabsf(o.z), fabsf(o.w)))); }
#pragma unroll
    for (int o = 1; o < 64; o <<= 1) am = fmaxf(am, __shfl_xor(am, o));
    const float hs = am > 0.f ? am * (1.0f / 127.0f) : 1.0f, inv = 1.0f / hs;
    if (lane == 0) *hsc = hs;
#pragma unroll
    for (int j = 0; j < 8; ++j) { const f32x4 o = v[j];
        hqrow[64 * j + lane] = ((unsigned)(int)rintf(o.x * inv) & 255u) | (((unsigned)(int)rintf(o.y * inv) & 255u) << 8) | (((unsigned)(int)rintf(o.z * inv) & 255u) << 16) | (((unsigned)(int)rintf(o.w * inv) & 255u) << 24); }
}
__device__ __forceinline__ float load_row_h(const bf16_t* xrow, float (&v)[4][8], int lane) {
    float ss = 0.f;
#pragma unroll
    for (int j = 0; j < 4; ++j) { const u32x4 x = *(const u32x4*)(xrow + 8 * lane + 512 * j);
        v[j][0] = bflo(x.x); v[j][1] = bfhi(x.x); v[j][2] = bflo(x.y); v[j][3] = bfhi(x.y); v[j][4] = bflo(x.z); v[j][5] = bfhi(x.z); v[j][6] = bflo(x.w); v[j][7] = bfhi(x.w);
#pragma unroll
        for (int i = 0; i < 8; ++i) ss += v[j][i] * v[j][i]; }
    return wave_sum(ss);
}
template <bool QUANT, bool BF16OUT = true>
__device__ __forceinline__ void norm_row_store_h(const bf16_t* xrow, const LAS float* Gv, const LAS float* Sv, bf16_t* orow, unsigned* hqrow, float* hsc, int lane) {
    float v[4][8]; const float ss = load_row_h(xrow, v, lane);
    const float rstd = rsqrtf(ss * (1.0f / D) + EPS); float am = 0.f;
#pragma unroll
    for (int j = 0; j < 4; ++j) { const int e = 8 * lane + 512 * j; const f32x4 g0 = *(const LAS f32x4*)(Gv + e), g1 = *(const LAS f32x4*)(Gv + e + 4), s0 = *(const LAS f32x4*)(Sv + e), s1 = *(const LAS f32x4*)(Sv + e + 4);
        v[j][0] = v[j][0] * rstd * g0.x + s0.x; v[j][1] = v[j][1] * rstd * g0.y + s0.y; v[j][2] = v[j][2] * rstd * g0.z + s0.z; v[j][3] = v[j][3] * rstd * g0.w + s0.w;
        v[j][4] = v[j][4] * rstd * g1.x + s1.x; v[j][5] = v[j][5] * rstd * g1.y + s1.y; v[j][6] = v[j][6] * rstd * g1.z + s1.z; v[j][7] = v[j][7] * rstd * g1.w + s1.w;
        u32x4 p; p.x = pk2(v[j][0], v[j][1]); p.y = pk2(v[j][2], v[j][3]); p.z = pk2(v[j][4], v[j][5]); p.w = pk2(v[j][6], v[j][7]); if (BF16OUT) *(u32x4*)(orow + e) = p;
        if (QUANT) {
#pragma unroll
            for (int i = 0; i < 8; ++i) am = fmaxf(am, fabsf(v[j][i])); } }
    if (QUANT) {
#pragma unroll
        for (int o = 1; o < 64; o <<= 1) am = fmaxf(am, __shfl_xor(am, o));
        const float hs = am > 0.f ? am * (1.0f / 127.0f) : 1.0f, inv = 1.0f / hs;
        if (lane == 0) *hsc = hs;
#pragma unroll
        for (int j = 0; j < 4; ++j) { u32x2 q;
            q.x = ((unsigned)(int)rintf(v[j][0] * inv) & 255u) | (((unsigned)(int)rintf(v[j][1] * inv) & 255u) << 8) | (((unsigned)(int)rintf(v[j][2] * inv) & 255u) << 16) | (((unsigned)(int)rintf(v[j][3] * inv) & 255u) << 24);
            q.y = ((unsigned)(int)rintf(v[j][4] * inv) & 255u) | (((unsigned)(int)rintf(v[j][5] * inv) & 255u) << 8) | (((unsigned)(int)rintf(v[j][6] * inv) & 255u) << 16) | (((unsigned)(int)rintf(v[j][7] * inv) & 255u) << 24);
            *(u32x2*)(hqrow + 2 * lane + 128 * j) = q; } }
}
__device__ __forceinline__ void norm_row_final_h(const bf16_t* xrow, const float* g, float* orow, int lane) {
    float v[4][8]; const float ss = load_row_h(xrow, v, lane);
    const float rstd = rsqrtf(ss * (1.0f / D) + EPS);
#pragma unroll
    for (int j = 0; j < 4; ++j) { const int e = 8 * lane + 512 * j; const f32x4 g0 = *(const f32x4*)(g + e), g1 = *(const f32x4*)(g + e + 4);
        f32x4 o0, o1; o0.x = v[j][0] * rstd * g0.x; o0.y = v[j][1] * rstd * g0.y; o0.z = v[j][2] * rstd * g0.z; o0.w = v[j][3] * rstd * g0.w;
        o1.x = v[j][4] * rstd * g1.x; o1.y = v[j][5] * rstd * g1.y; o1.z = v[j][6] * rstd * g1.z; o1.w = v[j][7] * rstd * g1.w;
        *(f32x4*)(orow + e) = o0; *(f32x4*)(orow + e + 4) = o1; }
}
__device__ __forceinline__ void fill_mod_lds(LAS float* Gs, LAS float* Ss, const float* g, const float* mod, int shift_idx, int scale_idx, int tid) {
    for (int i = tid; i < 2 * D; i += NTHREADS) { const int b = i >> 11, d = i & 2047; const float* mb = mod + (size_t)b * 12288;
        Gs[i] = g[d] * (1.0f + mb[scale_idx * D + d]); Ss[i] = mb[shift_idx * D + d]; }
}
__device__ __forceinline__ void ctx_gemm_tile(const bf16_t* HC, const bf16_t* Bt, bf16_t* XBC, int tile, int tid) {
    const int lane = tid & 63, w = tid >> 6, n = lane & 15, q = lane >> 4, rt = tile >> 4, ct = tile & 15;
    const bf16_t* a0 = HC + (size_t)(rt * 32 + n) * D + 8 * q; const bf16_t* a1 = a0 + (size_t)16 * D;
    const bf16_t* bp = Bt + (size_t)(ct * 128 + 16 * w + n) * D + 8 * q;
    f32x4 acc0 = {0.f, 0.f, 0.f, 0.f}, acc1 = {0.f, 0.f, 0.f, 0.f};
#pragma unroll 1
    for (int k0 = 0; k0 < D; k0 += 256) { bf16x8 A0[8], A1[8], B[8];
#pragma unroll
        for (int s8 = 0; s8 < 8; ++s8) { A0[s8] = *(const bf16x8*)(a0 + k0 + 32 * s8); A1[s8] = *(const bf16x8*)(a1 + k0 + 32 * s8); B[s8] = *(const bf16x8*)(bp + k0 + 32 * s8); }
#pragma unroll
        for (int s8 = 0; s8 < 8; ++s8) { acc0 = __builtin_amdgcn_mfma_f32_16x16x32_bf16(A0[s8], B[s8], acc0, 0, 0, 0); acc1 = __builtin_amdgcn_mfma_f32_16x16x32_bf16(A1[s8], B[s8], acc1, 0, 0, 0); } }
    bf16_t* o = XBC + (size_t)(rt * 32 + 4 * q) * D + ct * 128 + 16 * w + n;
#pragma unroll
    for (int i = 0; i < 4; ++i) { o[(size_t)i * D] = (bf16_t)(pk2(acc0[i], 0.f) & 0xffffu); o[(size_t)(16 + i) * D] = (bf16_t)(pk2(acc1[i], 0.f) & 0xffffu); }
}
constexpr int SC_RAW = 0, SC_XC = 18432, SC_Y = 35840, SC_CARRY = 69632, SC_CW = 70656  , SC_PITCH = 272, SC_YPITCH = 528;

__device__ __forceinline__ void scan_load_raw(u32x4 (&pre)[3], const bf16_t* src, int t0, bool is_ctx, int tid) {
#pragma unroll
    for (int j = 0; j < 3; ++j) { const int cidx = tid + NTHREADS * j, rr = (cidx >> 4) - 2, c16 = cidx & 15, tok = t0 + rr;
        const bool valid = (cidx < 1072) && (is_ctx ? (tok >= 0 && tok < CTXL) : (rr >= 0 && rr < 64));
        const u32x4 z = *(const u32x4*)(src + (ptrdiff_t)(valid ? tok : t0) * D + 8 * c16);
        pre[j] = valid ? z : (u32x4){0u, 0u, 0u, 0u}; }
}
__device__ __forceinline__ void gate_ab(float za, float zx, float sp8l, float xcv, float& a, float& b) {
    const float r = __builtin_amdgcn_rcpf(1.0f + __builtin_amdgcn_exp2f(za)), ig = __builtin_amdgcn_rcpf(1.0f + __builtin_amdgcn_exp2f(zx));
    a = __builtin_amdgcn_exp2f(sp8l * r);
    const float om = __builtin_fmaf(-a, a, 1.0f);
    b = __builtin_amdgcn_sqrtf(om) * ig * xcv;
}

template <int PASS, int DIR, bool CONV>
__device__ __forceinline__ void scan_sweep(LAS unsigned char* lds, const bf16_t* src, int t_begin, int ntiles, bool is_ctx, const bf16_t* gwd,
                                           float ba, float bx, float sp8, float S_in, float& S_out, float& P_out,
                                           bf16_t* Mrow, const bf16_t* GGrow, int tid) {
    const int lane = tid & 63, w = tid >> 6, n = lane & 15, q = lane >> 4, cg = tid & 15, tq = tid >> 4;
    bf16x8 Bf[2][4];
#pragma unroll
    for (int g = 0; g < 2; ++g)
#pragma unroll
        for (int ks = 0; ks < 4; ++ks) Bf[g][ks] = *(const bf16x8*)(gwd + (size_t)g * 16 * 16384 + (16 * w + n) * 128 + 32 * ks + 8 * q);
    float S = S_in, P = 1.0f;
    u32x4 pre[3];
    if (CONV) scan_load_raw(pre, src, t_begin + 64 * (DIR ? ntiles - 1 : 0), is_ctx, tid);
    else {
#pragma unroll
        for (int jj = 0; jj < 2; ++jj) pre[jj] = *(const u32x4*)(src + (size_t)(t_begin + 64 * (DIR ? ntiles - 1 : 0) + tq + 32 * jj) * D + 8 * cg); }
    for (int it = 0; it < ntiles; ++it) {
        const int ti = DIR ? ntiles - 1 - it : it, t0 = t_begin + 64 * ti;
        const int tin = (it + 1 < ntiles) ? (DIR ? ti - 1 : ti + 1) : ti;
        const int xcoff = CONV ? SC_XC : ((it & 1) ? SC_RAW : SC_XC);
        if (CONV) {
#pragma unroll
            for (int j = 0; j < 3; ++j) { const int cidx = tid + NTHREADS * j; if (cidx < 1072) *(LAS u32x4*)(lds + SC_RAW + (cidx >> 4) * SC_PITCH + (cidx & 15) * 16) = pre[j]; }
            __syncthreads();
            scan_load_raw(pre, src, t_begin + 64 * tin, is_ctx, tid);
#pragma unroll
            for (int jj = 0; jj < 2; ++jj) { const int tt = tq + 32 * jj; float xc[8];
                { const f32x4 c0 = *(const LAS f32x4*)(lds + SC_CW + (4 * 128 + 8 * cg) * 4), c1 = *(const LAS f32x4*)(lds + SC_CW + (4 * 128 + 8 * cg + 4) * 4);
                  xc[0] = c0.x; xc[1] = c0.y; xc[2] = c0.z; xc[3] = c0.w; xc[4] = c1.x; xc[5] = c1.y; xc[6] = c1.z; xc[7] = c1.w; }
#pragma unroll
                for (int k = 0; k < 4; ++k) { const u32x4 rv = *(const LAS u32x4*)(lds + SC_RAW + (tt + k) * SC_PITCH + cg * 16);
                    const f32x4 w0 = *(const LAS f32x4*)(lds + SC_CW + (k * 128 + 8 * cg) * 4), w1 = *(const LAS f32x4*)(lds + SC_CW + (k * 128 + 8 * cg + 4) * 4);
                    xc[0] += w0.x * bflo(rv.x); xc[1] += w0.y * bfhi(rv.x); xc[2] += w0.z * bflo(rv.y); xc[3] += w0.w * bfhi(rv.y);
                    xc[4] += w1.x * bflo(rv.z); xc[5] += w1.y * bfhi(rv.z); xc[6] += w1.z * bflo(rv.w); xc[7] += w1.w * bfhi(rv.w); }
                u32x4 o; o.x = pk2(xc[0], xc[1]); o.y = pk2(xc[2], xc[3]); o.z = pk2(xc[4], xc[5]); o.w = pk2(xc[6], xc[7]);
                *(LAS u32x4*)(lds + SC_XC + tt * SC_PITCH + cg * 16) = o;
                if (!is_ctx) *(u32x4*)(const_cast<bf16_t*>(src) + (size_t)(t0 + tt) * D + 8 * cg) = o; }
            __syncthreads();
        } else {
#pragma unroll
            for (int jj = 0; jj < 2; ++jj) *(LAS u32x4*)(lds + xcoff + (tq + 32 * jj) * SC_PITCH + cg * 16) = pre[jj];
            __syncthreads();
#pragma unroll
            for (int jj = 0; jj < 2; ++jj) pre[jj] = *(const u32x4*)(src + (size_t)(t_begin + 64 * tin + tq + 32 * jj) * D + 8 * cg);
        }
        u32x4 yfp[2], ggp[2];
        if (PASS == 2 && DIR == 1) {
#pragma unroll
            for (int jj = 0; jj < 2; ++jj) { const size_t gi = (size_t)(t0 + tq + 32 * jj) * D + 8 * cg; yfp[jj] = *(const u32x4*)(Mrow + gi); ggp[jj] = *(const u32x4*)(GGrow + gi); } }
        f32x4 acc_a[4], acc_x[4];
#pragma unroll
        for (int mt = 0; mt < 4; ++mt) { acc_a[mt] = (f32x4){ba, ba, ba, ba}; acc_x[mt] = (f32x4){bx, bx, bx, bx};
#pragma unroll
            for (int ks = 0; ks < 4; ++ks) { const bf16x8 Af = *(const LAS bf16x8*)(lds + xcoff + (16 * mt + n) * SC_PITCH + (32 * ks + 8 * q) * 2);
                acc_a[mt] = __builtin_amdgcn_mfma_f32_16x16x32_bf16(Af, Bf[0][ks], acc_a[mt], 0, 0, 0);
                acc_x[mt] = __builtin_amdgcn_mfma_f32_16x16x32_bf16(Af, Bf[1][ks], acc_x[mt], 0, 0, 0); } }
#pragma unroll
        for (int mi = 0; mi < 4; ++mi) { const int mt = DIR ? 3 - mi : mi;
            float a[4], b[4];
#pragma unroll
            for (int i = 0; i < 4; ++i) { const unsigned short xh = *(const LAS unsigned short*)(lds + xcoff + (16 * mt + 4 * q + i) * SC_PITCH + (16 * w + n) * 2);
                gate_ab(acc_a[mt][i], acc_x[mt][i], sp8, __uint_as_float((unsigned)xh << 16), a[i], b[i]); }
            const float A4 = (a[0] * a[1]) * (a[2] * a[3]); float l;
            if (DIR == 0) { l = b[0]; l = a[1] * l + b[1]; l = a[2] * l + b[2]; l = a[3] * l + b[3]; }
            else          { l = b[3]; l = a[2] * l + b[2]; l = a[1] * l + b[1]; l = a[0] * l + b[0]; }
            float Aq[4], Bq[4];
#pragma unroll
            for (int qq = 0; qq < 4; ++qq) { Aq[qq] = __shfl(A4, n + 16 * qq); Bq[qq] = __shfl(l, n + 16 * qq); }
            float c = S, mine = S;
#pragma unroll
            for (int s = 0; s < 4; ++s) { const int qq = DIR ? 3 - s : s; if (qq == q) mine = c; c = Aq[qq] * c + Bq[qq]; }
            S = c; P *= (Aq[0] * Aq[1]) * (Aq[2] * Aq[3]);
            if (PASS == 2) { float y[4], h = mine;
                if (DIR == 0) { h = a[0] * h + b[0]; y[0] = h; h = a[1] * h + b[1]; y[1] = h; h = a[2] * h + b[2]; y[2] = h; h = a[3] * h + b[3]; y[3] = h; }
                else          { h = a[3] * h + b[3]; y[3] = h; h = a[2] * h + b[2]; y[2] = h; h = a[1] * h + b[1]; y[1] = h; h = a[0] * h + b[0]; y[0] = h; }
#pragma unroll
                for (int i = 0; i < 4; ++i) *(LAS float*)(lds + SC_Y + (16 * mt + 4 * q + i) * SC_YPITCH + (16 * w + n) * 4) = y[i]; }
        }
        if (PASS == 2) {
            __syncthreads();
#pragma unroll
            for (int jj = 0; jj < 2; ++jj) { const int row = tq + 32 * jj; const LAS f32x4* yp = (const LAS f32x4*)(lds + SC_Y + row * SC_YPITCH + cg * 32);
                f32x4 y0 = yp[0], y1 = yp[1]; const size_t gi = (size_t)(t0 + row) * D + 8 * cg;
                if (DIR == 1) { const u32x4 f = yfp[jj], g = ggp[jj];
                    y0.x = (y0.x + bflo(f.x)) * bflo(g.x); y0.y = (y0.y + bfhi(f.x)) * bfhi(g.x); y0.z = (y0.z + bflo(f.y)) * bflo(g.y); y0.w = (y0.w + bfhi(f.y)) * bfhi(g.y);
                    y1.x = (y1.x + bflo(f.z)) * bflo(g.z); y1.y = (y1.y + bfhi(f.z)) * bfhi(g.z); y1.z = (y1.z + bflo(f.w)) * bflo(g.w); y1.w = (y1.w + bfhi(f.w)) * bfhi(g.w); }
                u32x4 o; o.x = pk2(y0.x, y0.y); o.y = pk2(y0.z, y0.w); o.z = pk2(y1.x, y1.y); o.w = pk2(y1.z, y1.w);
                *(u32x4*)(Mrow + gi) = o; }
        }
    }
    S_out = S; P_out = P;
}

template <int PASS>
__device__ __forceinline__ void scan_unit(LAS unsigned char* lds, const float* conv_w, const float* conv_b, const float* b_a, const float* b_x, const float* lam,
                                          unsigned char* ws, bool is_ctx, int b, int hd, int r, int tid) {
    const int lane = tid & 63, w = tid >> 6, n = lane & 15, q = lane >> 4;
    const bf16_t* GW = (const bf16_t*)(ws + WS_GW);
    float* SUMA = (float*)(ws + WS_SUMA); float* SUMB = (float*)(ws + WS_SUMB); float* H0 = (float*)(ws + WS_H0);
    for (int i = tid; i < 640; i += NTHREADS) { const int k = i >> 7, ch = hd * 128 + (i & 127); *(LAS float*)(lds + SC_CW + i * 4) = (k < 4) ? conv_w[k * D + ch] : conv_b[ch]; }
    __syncthreads();
    const int gch = hd * 128 + 16 * w + n;
    const bf16_t* src = is_ctx ? (const bf16_t*)(ws + WS_XBC) + (size_t)b * CTXL * D + hd * 128 : (const bf16_t*)(ws + WS_XB) + (size_t)b * SEQ * D + hd * 128;
    const int t_begin = is_ctx ? 0 : r * 2048, ntiles = is_ctx ? 4 : 32;
    bf16_t* Mrow = (bf16_t*)(ws + WS_H) + (size_t)b * SEQ * D + hd * 128; const bf16_t* GGrow = (const bf16_t*)(ws + WS_GG) + (size_t)b * SEQ * D + hd * 128;
    if (PASS == 2) {
        if (tid < 256) { const int dir = tid >> 7, ch = hd * 128 + (tid & 127); float S = 0.f;
            { const float* CSA = (const float*)(ws + WS_CSA); const float* CSB = (const float*)(ws + WS_CSB);
              if (dir == 0) { for (int k = 0; k < 4; ++k) S = CSA[(size_t)((0 * 2 + b) * 4 + k) * D + ch] * S + CSB[(size_t)((0 * 2 + b) * 4 + k) * D + ch]; }
              else          { for (int k = 3; k >= 0; --k) S = CSA[(size_t)((1 * 2 + b) * 4 + k) * D + ch] * S + CSB[(size_t)((1 * 2 + b) * 4 + k) * D + ch]; } }
            if (dir == 0) { for (int rr = 0; rr < r; ++rr) S = SUMA[((0 * 2 + b) * 8 + rr) * D + ch] * S + SUMB[((0 * 2 + b) * 8 + rr) * D + ch]; }
            else          { for (int rr = 7; rr > r; --rr) S = SUMA[((1 * 2 + b) * 8 + rr) * D + ch] * S + SUMB[((1 * 2 + b) * 8 + rr) * D + ch]; }
            *(LAS float*)(lds + SC_CARRY + tid * 4) = S; }
        __syncthreads();
    }
#pragma unroll
    for (int dir = 0; dir < 2; ++dir) {
        const float ba = -LOG2E * b_a[dir * D + gch], bx = -LOG2E * b_x[dir * D + gch];
        const float sp8 = -LOG2E * 8.0f * log1pf(expf(-lam[dir * D + gch]));
        const bf16_t* gwd = GW + (size_t)((dir * 2) * 16 + hd) * 16384;
        float S_in = 0.f, S_out, P_out;
        if (PASS == 2) S_in = *(const LAS float*)(lds + SC_CARRY + (dir * 128 + 16 * w + n) * 4);
        if (PASS == 1 && is_ctx) { if (dir == 0) scan_sweep<PASS, 0, true>(lds, src, t_begin, ntiles, true, gwd, ba, bx, sp8, S_in, S_out, P_out, Mrow, GGrow, tid);
                                   else          scan_sweep<PASS, 1, true>(lds, src, t_begin, ntiles, true, gwd, ba, bx, sp8, S_in, S_out, P_out, Mrow, GGrow, tid); }
        else if (PASS == 1 && dir == 0) scan_sweep<PASS, 0, true>(lds, src, t_begin, ntiles, false, gwd, ba, bx, sp8, S_in, S_out, P_out, Mrow, GGrow, tid);
        else if (dir == 0) scan_sweep<PASS, 0, false>(lds, src, t_begin, ntiles, false, gwd, ba, bx, sp8, S_in, S_out, P_out, Mrow, GGrow, tid);
        else               scan_sweep<PASS, 1, false>(lds, src, t_begin, ntiles, false, gwd, ba, bx, sp8, S_in, S_out, P_out, Mrow, GGrow, tid);
        if (PASS == 1 && q == 0) {
            if (is_ctx) H0[(dir * 2 + b) * D + gch] = S_out;
            else { SUMA[((dir * 2 + b) * 8 + r) * D + gch] = P_out; SUMB[((dir * 2 + b) * 8 + r) * D + gch] = S_out; } }
        asm volatile("s_waitcnt vmcnt(0)" ::: "memory");
        __syncthreads();
        if (PASS == 1 && dir == 0) {
            __builtin_amdgcn_fence(__ATOMIC_ACQUIRE, "agent");
            asm volatile("s_waitcnt vmcnt(0)" ::: "memory");
            __syncthreads(); }
    }
}
__device__ __forceinline__ void scan_ctx_tile(LAS unsigned char* lds, const float* conv_w, const float* conv_b, const float* b_a, const float* b_x, const float* lam,
                                              unsigned char* ws, int b, int hd, int dir, int tile, int tid) {
    const int lane = tid & 63, w = tid >> 6, n = lane & 15, q = lane >> 4;
    const bf16_t* GW = (const bf16_t*)(ws + WS_GW);
    __syncthreads();
    for (int i = tid; i < 640; i += NTHREADS) { const int k = i >> 7, ch = hd * 128 + (i & 127); *(LAS float*)(lds + SC_CW + i * 4) = (k < 4) ? conv_w[k * D + ch] : conv_b[ch]; }
    __syncthreads();
    const int gch = hd * 128 + 16 * w + n;
    const bf16_t* src = (const bf16_t*)(ws + WS_XBC) + (size_t)b * CTXL * D + hd * 128;
    bf16_t* Mrow = (bf16_t*)(ws + WS_H) + (size_t)b * SEQ * D + hd * 128; const bf16_t* GGrow = (const bf16_t*)(ws + WS_GG) + (size_t)b * SEQ * D + hd * 128;
    const float ba = -LOG2E * b_a[dir * D + gch], bx = -LOG2E * b_x[dir * D + gch];
    const float sp8 = -LOG2E * 8.0f * log1pf(expf(-lam[dir * D + gch]));
    const bf16_t* gwd = GW + (size_t)((dir * 2) * 16 + hd) * 16384;
    float S_out, P_out;
    if (dir == 0) scan_sweep<1, 0, true>(lds, src, 64 * tile, 1, true, gwd, ba, bx, sp8, 0.f, S_out, P_out, Mrow, GGrow, tid);
    else          scan_sweep<1, 1, true>(lds, src, 64 * tile, 1, true, gwd, ba, bx, sp8, 0.f, S_out, P_out, Mrow, GGrow, tid);
    if (q == 0) { ((float*)(ws + WS_CSA))[(size_t)((dir * 2 + b) * 4 + tile) * D + gch] = P_out; ((float*)(ws + WS_CSB))[(size_t)((dir * 2 + b) * 4 + tile) * D + gch] = S_out; }
    asm volatile("s_waitcnt vmcnt(0)" ::: "memory");
    __syncthreads();
}
__device__ __forceinline__ void sc_conv_mul(const bf16_t* BG, const bf16_t* CV, const float* conv_w, const float* conv_b, bf16_t* M, int gtid, int nthr) {
    const int cgp = gtid & 255, ch0 = 8 * cgp; float cw[3][8], cb[8];
#pragma unroll
    for (int j = 0; j < 8; ++j) { cb[j] = conv_b[ch0 + j];
#pragma unroll
        for (int k = 0; k < 3; ++k) cw[k][j] = conv_w[k * D + ch0 + j]; }
    for (int t = gtid >> 8; t < T; t += (nthr >> 8)) { const int tl = t & 63; const size_t gi = (size_t)t * D + ch0;
        u32x4 c[3]; c[0] = (u32x4){0u, 0u, 0u, 0u}; c[2] = c[0];
        if (tl > 0) c[0] = *(const u32x4*)(CV + gi - D);
        c[1] = *(const u32x4*)(CV + gi);
        if (tl < 63) c[2] = *(const u32x4*)(CV + gi + D);
        const u32x4 g = *(const u32x4*)(BG + gi);
        float y[8];
#pragma unroll
        for (int j = 0; j < 8; ++j) y[j] = cb[j];
#pragma unroll
        for (int k = 0; k < 3; ++k) { y[0] += cw[k][0] * bflo(c[k].x); y[1] += cw[k][1] * bfhi(c[k].x); y[2] += cw[k][2] * bflo(c[k].y); y[3] += cw[k][3] * bfhi(c[k].y);
            y[4] += cw[k][4] * bflo(c[k].z); y[5] += cw[k][5] * bfhi(c[k].z); y[6] += cw[k][6] * bflo(c[k].w); y[7] += cw[k][7] * bfhi(c[k].w); }
        u32x4 o; o.x = pk2(y[0] * bflo(g.x), y[1] * bfhi(g.x)); o.y = pk2(y[2] * bflo(g.y), y[3] * bfhi(g.y)); o.z = pk2(y[4] * bflo(g.z), y[5] * bfhi(g.z)); o.w = pk2(y[6] * bflo(g.w), y[7] * bfhi(g.w));
        *(u32x4*)(M + gi) = o; }
}

__device__ __forceinline__ void sc_conv_mul_row(const bf16_t* BG, const bf16_t* CV, const LAS float* cwl, unsigned* mq, float* msc, int t, int lane) {
    const int tl = t & 63; const int tm = (tl > 0) ? t - 1 : t, tp = (tl < 63) ? t + 1 : t;
    const float zm = (tl > 0) ? 1.f : 0.f, zp = (tl < 63) ? 1.f : 0.f;
    const float rbg = *msc;
    float v[4][8]; float am = 0.f;
#pragma unroll
    for (int j = 0; j < 4; ++j) { const int e = 8 * lane + 512 * j;
        const u32x4 c0 = *(const u32x4*)(CV + (size_t)tm * D + e), c1 = *(const u32x4*)(CV + (size_t)t * D + e), c2 = *(const u32x4*)(CV + (size_t)tp * D + e), g = *(const u32x4*)(BG + (size_t)t * D + e);
        float y[8];
#pragma unroll
        for (int h = 0; h < 2; ++h) { const f32x4 w0 = *(const LAS f32x4*)(cwl + e + 4 * h), w1 = *(const LAS f32x4*)(cwl + D + e + 4 * h), w2 = *(const LAS f32x4*)(cwl + 2 * D + e + 4 * h), bb = *(const LAS f32x4*)(cwl + 3 * D + e + 4 * h);
            const unsigned a0 = h ? c0.z : c0.x, a1 = h ? c0.w : c0.y, b0 = h ? c1.z : c1.x, b1 = h ? c1.w : c1.y, d0 = h ? c2.z : c2.x, d1 = h ? c2.w : c2.y;
            y[4 * h + 0] = bb.x + zm * w0.x * bflo(a0) + w1.x * bflo(b0) + zp * w2.x * bflo(d0); y[4 * h + 1] = bb.y + zm * w0.y * bfhi(a0) + w1.y * bfhi(b0) + zp * w2.y * bfhi(d0);
            y[4 * h + 2] = bb.z + zm * w0.z * bflo(a1) + w1.z * bflo(b1) + zp * w2.z * bflo(d1); y[4 * h + 3] = bb.w + zm * w0.w * bfhi(a1) + w1.w * bfhi(b1) + zp * w2.w * bfhi(d1); }
        v[j][0] = y[0] * bflo(g.x); v[j][1] = y[1] * bfhi(g.x); v[j][2] = y[2] * bflo(g.y); v[j][3] = y[3] * bfhi(g.y); v[j][4] = y[4] * bflo(g.z); v[j][5] = y[5] * bfhi(g.z); v[j][6] = y[6] * bflo(g.w); v[j][7] = y[7] * bfhi(g.w);
#pragma unroll
        for (int i = 0; i < 8; ++i) am = fmaxf(am, fabsf(v[j][i])); }
#pragma unroll
    for (int o = 1; o < 64; o <<= 1) am = fmaxf(am, __shfl_xor(am, o));
    const float sc = am > 0.f ? am * (1.0f / 127.0f) : 1.0f, inv = 1.0f / sc;
    if (lane == 0) *msc = sc * rbg;
#pragma unroll
    for (int j = 0; j < 4; ++j) { u32x2 q;
        q.x = ((unsigned)(int)rintf(v[j][0] * inv) & 255u) | (((unsigned)(int)rintf(v[j][1] * inv) & 255u) << 8) | (((unsigned)(int)rintf(v[j][2] * inv) & 255u) << 16) | (((unsigned)(int)rintf(v[j][3] * inv) & 255u) << 24);
        q.y = ((unsigned)(int)rintf(v[j][4] * inv) & 255u) | (((unsigned)(int)rintf(v[j][5] * inv) & 255u) << 8) | (((unsigned)(int)rintf(v[j][6] * inv) & 255u) << 16) | (((unsigned)(int)rintf(v[j][7] * inv) & 255u) << 24);
        *(u32x2*)(mq + 2 * lane + 128 * j) = q; }
}

__device__ __forceinline__ unsigned gmix(unsigned el) { return ((el >> 2) ^ (el >> 7) ^ ((el & 3u) * 11u)) & 31u; }
__device__ __forceinline__ unsigned ord_f32(float f) { const unsigned u = __float_as_uint(f); return u ^ ((unsigned)((int)u >> 31) | 0x80000000u); }
__device__ __forceinline__ float unord_f32(unsigned o) { return __uint_as_float((o & 0x80000000u) ? (o ^ 0x80000000u) : ~o); }
__device__ __forceinline__ bool stair_ij(int reg, int n, int& i, int& j) {
    bool ok = true; i = 0; j = 0;
    if (reg == 0) { i = 0; j = n; }
    else if (reg == 1) { if (n < 8) { i = 1; j = n; } else if (n < 13) { i = 2; j = n - 8; } else ok = false; }
    else if (reg == 2) { if (n < 4) { i = 3; j = n; } else if (n < 7) { i = 4; j = n - 4; } else if (n < 9) { i = 5; j = n - 7; } else if (n < 11) { i = 6; j = n - 9; } else if (n < 13) { i = 7; j = n - 11; } else { i = 8 + (n - 13); j = 0; } }
    else { if (n < 5) { i = 11 + n; j = 0; } else ok = false; }
    return ok;
}
constexpr int SEL_KT = 0, SEL_PITCH = 272, SEL_KTBYTES = 34816, SEL_LIST = 73728  ;
__device__ __forceinline__ void peer_select_unit(LAS unsigned char* lds, const bf16_t* Q, const bf16_t* KEYS, const float* HSC, int* IDX, float* GATE, unsigned* ENT, unsigned* POS, unsigned* SEG, int unit, int tid) {
    const int lane = tid & 63, w = tid >> 6, n = lane & 15, q = lane >> 4, rowbase = lane & 48;
    const int tok0 = unit * 128 + 16 * w;
    int stA0[4], stA1[4]; unsigned stTag[4], stOk[4];
#pragma unroll
    for (int reg = 0; reg < 4; ++reg) { int ci, cj; const bool ok = stair_ij(reg, n, ci, cj); stA0[reg] = (rowbase + ci) * 4; stA1[reg] = (rowbase + cj) * 4; stTag[reg] = (unsigned)(255 - (16 * ci + cj)); stOk[reg] = ok ? 0xffffffffu : 0u; }
    u32x4 kn[4]; bf16x8 An[4];
#pragma unroll
    for (int j = 0; j < 4; ++j) kn[j] = *(const u32x4*)(KEYS + (size_t)(tid + NTHREADS * j) * 8);
#pragma unroll
    for (int ks = 0; ks < 4; ++ks) An[ks] = *(const bf16x8*)(Q + (size_t)(tok0 + n) * D + 32 * ks + 8 * q);
    for (int h = 0; h < 8; ++h) {
        unsigned topk[2][4];
#pragma unroll
        for (int p = 0; p < 2; ++p) {
            const int ktoff = SEL_KT + p * SEL_KTBYTES;
            bf16x8 Aq[4];
#pragma unroll
            for (int ks = 0; ks < 4; ++ks) Aq[ks] = An[ks];
#pragma unroll
            for (int j = 0; j < 4; ++j) { const int cidx = tid + NTHREADS * j; *(LAS u32x4*)(lds + ktoff + (cidx >> 4) * SEL_PITCH + (cidx & 15) * 16) = kn[j]; }
            __syncthreads();
            { const int hpn = (2 * h + p + 1 < 16) ? 2 * h + p + 1 : 15;
              const bf16_t* kp = KEYS + (size_t)hpn * 16384;
#pragma unroll
              for (int j = 0; j < 4; ++j) kn[j] = *(const u32x4*)(kp + (size_t)(tid + NTHREADS * j) * 8);
#pragma unroll
              for (int ks = 0; ks < 4; ++ks) An[ks] = *(const bf16x8*)(Q + (size_t)(tok0 + n) * D + hpn * 128 + 32 * ks + 8 * q); }
            f32x4 acc[8];
#pragma unroll
            for (int nt = 0; nt < 8; ++nt) { acc[nt] = (f32x4){0.f, 0.f, 0.f, 0.f};
#pragma unroll
                for (int ks = 0; ks < 4; ++ks) { const bf16x8 Bk = *(const LAS bf16x8*)(lds + ktoff + (16 * nt + n) * SEL_PITCH + (32 * ks + 8 * q) * 2);
                    acc[nt] = __builtin_amdgcn_mfma_f32_16x16x32_bf16(Aq[ks], Bk, acc[nt], 0, 0, 0); } }
#pragma unroll
            for (int i2 = 0; i2 < 4; i2 += 2) { unsigned hd[2]; unsigned pt[2];
#pragma unroll
                for (int s2 = 0; s2 < 2; ++s2) { unsigned kv[8];
#pragma unroll
                    for (int nt = 0; nt < 8; ++nt) kv[nt] = (ord_f32(acc[nt][i2 + s2]) & ~127u) | (unsigned)(127 - (16 * nt + n));
#define CE(a, b) { const unsigned hi_ = max(kv[a], kv[b]), lo_ = min(kv[a], kv[b]); kv[a] = hi_; kv[b] = lo_; }
                    CE(0, 1) CE(2, 3) CE(4, 5) CE(6, 7)  CE(0, 2) CE(1, 3) CE(4, 6) CE(5, 7)  CE(1, 2) CE(5, 6) CE(0, 4) CE(3, 7)  CE(1, 5) CE(2, 6)  CE(1, 4) CE(3, 6)  CE(2, 4) CE(3, 5)  CE(3, 4)
#undef CE
                    pt[s2] = (unsigned)(SEL_LIST + w * 4608 + s2 * 2304 + lane * 4);
#pragma unroll
                    for (int r = 0; r < 8; ++r) *(LAS unsigned*)(lds + pt[s2] + 256 * r) = kv[r];
                    *(LAS unsigned*)(lds + pt[s2] + 256 * 8) = 0u;
                    hd[s2] = kv[0]; }
                unsigned res0 = 0u, res1 = 0u;
#pragma unroll 1
                for (int rnd = 0; rnd < 16; ++rnd) {
                    const unsigned m0 = row_max_u32(hd[0]), m1 = row_max_u32(hd[1]);
                    pt[0] += (hd[0] == m0) ? 256u : 0u; pt[1] += (hd[1] == m1) ? 256u : 0u;
                    hd[0] = *(const LAS unsigned*)(lds + pt[0]); hd[1] = *(const LAS unsigned*)(lds + pt[1]);
                    res0 = (n == rnd) ? m0 : res0; res1 = (n == rnd) ? m1 : res1; }
                topk[p][i2] = res0; topk[p][i2 + 1] = res1; }
        }
#pragma unroll
        for (int i2 = 0; i2 < 4; i2 += 2) { unsigned hd[2], pt[2], res[2] = {0u, 0u};
#pragma unroll
            for (int s2 = 0; s2 < 2; ++s2) { const unsigned v0 = topk[0][i2 + s2], v1 = topk[1][i2 + s2]; unsigned cv[4];
#pragma unroll
                for (int reg = 0; reg < 4; ++reg) {
                    const unsigned a0 = (unsigned)__builtin_amdgcn_ds_bpermute(stA0[reg], (int)v0), a1 = (unsigned)__builtin_amdgcn_ds_bpermute(stA1[reg], (int)v1);
                    const float sm = unord_f32(a0 & ~127u) + unord_f32(a1 & ~127u);
                    cv[reg] = ((ord_f32(sm) & ~255u) | stTag[reg]) & stOk[reg]; }
#define CE(a, b) { const unsigned hi_ = max(cv[a], cv[b]), lo_ = min(cv[a], cv[b]); cv[a] = hi_; cv[b] = lo_; }
                CE(0, 1) CE(2, 3) CE(0, 2) CE(1, 3) CE(1, 2)
#undef CE
                pt[s2] = (unsigned)(SEL_LIST + w * 4608 + s2 * 2304 + lane * 4);
#pragma unroll
                for (int r = 0; r < 4; ++r) *(LAS unsigned*)(lds + pt[s2] + 256 * r) = cv[r];
                *(LAS unsigned*)(lds + pt[s2] + 256 * 4) = 0u;
                hd[s2] = cv[0]; }
#pragma unroll 1
            for (int rnd = 0; rnd < 16; ++rnd) {
                const unsigned m0 = row_max_u32(hd[0]), m1 = row_max_u32(hd[1]);
                pt[0] += (hd[0] == m0) ? 256u : 0u; pt[1] += (hd[1] == m1) ? 256u : 0u;
                hd[0] = *(const LAS unsigned*)(lds + pt[0]); hd[1] = *(const LAS unsigned*)(lds + pt[1]);
                res[0] = (n == rnd) ? m0 : res[0]; res[1] = (n == rnd) ? m1 : res[1]; }
#pragma unroll
            for (int s2 = 0; s2 < 2; ++s2) { const int i = i2 + s2; const unsigned v0 = topk[0][i], v1 = topk[1][i], rs = res[s2];
                const int flat = 255 - (int)(rs & 255u), fi = flat >> 4, fj = flat & 15;
                const unsigned k0 = (unsigned)__builtin_amdgcn_ds_bpermute((rowbase + fi) * 4, (int)v0), k1 = (unsigned)__builtin_amdgcn_ds_bpermute((rowbase + fj) * 4, (int)v1);
                const int expert = (127 - (int)(k0 & 127u)) * 128 + (127 - (int)(k1 & 127u));
                const float sc = unord_f32(rs & ~255u);
                const float mx = __int_as_float(__builtin_amdgcn_ds_bpermute(rowbase * 4, __float_as_int(sc)));
                const float e = __builtin_amdgcn_exp2f((sc - mx) * (LOG2E * HSC[tok0 + 4 * q + i]));
                const float g = e * __builtin_amdgcn_rcpf(row_sum_f32(e));
                const size_t oi = (size_t)(tok0 + 4 * q + i) * 128 + h * 16 + n;
                IDX[oi] = expert; GATE[oi] = g; } }
    }
    asm volatile("s_waitcnt vmcnt(0)" ::: "memory");
    __syncthreads();
    volatile LAS unsigned* hist = (volatile LAS unsigned*)(lds + 69632); LAS unsigned* pref = (LAS unsigned*)(lds + 69632) + 256; LAS unsigned* tot = (LAS unsigned*)(lds + 69632) + 512;
    if (tid < 256) hist[tid] = 0u;
    __syncthreads();
    unsigned myj[32], pads[16];
#pragma unroll
    for (int tt = 0; tt < 16; ++tt) {
#pragma unroll
        for (int hf = 0; hf < 2; ++hf) { const int i = 2 * tt + hf, p = (16 * w + tt) * 128 + hf * 64 + lane; const unsigned e = (unsigned)IDX[(size_t)unit * 16384 + p] & 16383u;
            myj[i] = e | (__hip_atomic_fetch_add((LAS unsigned*)(lds + 69632) + w * 32 + (int)((e & 31u) ^ gmix(e >> 5)), 1u, __ATOMIC_RELAXED, __HIP_MEMORY_SCOPE_WORKGROUP) << 14); }
        const unsigned c = hist[w * 32 + (lane & 31)]; const bool pad = (lane < 32) && (c & 1u);
        pads[tt] = pad ? c : 0xffffffffu;
        if (pad) hist[w * 32 + lane] = c + 1u; }
    __syncthreads();
    if (tid < 32) { unsigned t = 0u;
#pragma unroll
        for (int ww = 0; ww < 8; ++ww) t += hist[ww * 32 + tid];
        tot[tid] = t; }
    __syncthreads();
    if (tid < 32) { unsigned off = 0u; for (int j = 0; j < tid; ++j) off += tot[j];
        SEG[((size_t)unit * 32 + tid) * 2] = (unsigned)unit * (unsigned)POOLU + off; SEG[((size_t)unit * 32 + tid) * 2 + 1] = tot[tid];
#pragma unroll
        for (int ww = 0; ww < 8; ++ww) { pref[ww * 32 + tid] = off; off += hist[ww * 32 + tid]; } }
    __syncthreads();
#pragma unroll
    for (int i = 0; i < 32; ++i) { const int p = (16 * w + (i >> 1)) * 128 + (i & 1) * 64 + lane; const unsigned e = myj[i] & 16383u, j = (e & 31u) ^ gmix(e >> 5);
        const unsigned pos = (unsigned)unit * (unsigned)POOLU + pref[w * 32 + (int)j] + (myj[i] >> 14);
        ENT[pos] = ((unsigned)unit * 128u + ((unsigned)p >> 7)) | ((e >> 5) << 15); POS[(size_t)unit * 16384 + p] = pos; }
    if (lane < 32) { const unsigned pb_ = (unsigned)unit * (unsigned)POOLU + pref[w * 32 + lane];
#pragma unroll
        for (int tt = 0; tt < 16; ++tt) if (pads[tt] != 0xffffffffu) ENT[pb_ + pads[tt]] = (unsigned)unit * 128u + (unsigned)(16 * w + tt); }
    __syncthreads();
}
constexpr int EX_G1 = 0, EX_S1 = 16384, EX_G2 = 32768;
constexpr int EXG = 4;
#define DPP_ROR_I(x, n) __builtin_amdgcn_update_dpp(0, (x), 0x120 + (n), 0xf, 0xf, false)
__device__ __forceinline__ int wave_isum(int v) {
    v += DPP_ROR_I(v, 8); v += DPP_ROR_I(v, 4); v += DPP_ROR_I(v, 2); v += DPP_ROR_I(v, 1);
    return (__builtin_amdgcn_readlane(v, 0) + __builtin_amdgcn_readlane(v, 16)) + (__builtin_amdgcn_readlane(v, 32) + __builtin_amdgcn_readlane(v, 48));
}
__device__ __forceinline__ void ex_load_rows(u32x4 (&buf)[EXG][2], const unsigned char* tab, int e0reg, int e1reg, int grp, int lane) {
    const int ereg = (grp < 16) ? e0reg : e1reg; const int k0 = (grp & 15) * EXG;
#pragma unroll
    for (int j = 0; j < EXG; ++j) { const int e = __builtin_amdgcn_readlane(ereg, k0 + j) & 16383; const u32x4* rp = (const u32x4*)(tab + (size_t)e * D) + lane;
        buf[j][0] = rp[0]; buf[j][1] = rp[64]; }
}
__device__ __forceinline__ void ex_dots(const u32x4 (&buf)[EXG][2], const u32x4 (&hq)[2], int& d0, int& d1, int grp, int lane) {
#pragma unroll
    for (int j = 0; j < EXG; ++j) { int a = 0;
#pragma unroll
        for (int c = 0; c < 2; ++c) { a = __builtin_amdgcn_sdot4((int)buf[j][c].x, (int)hq[c].x, a, false); a = __builtin_amdgcn_sdot4((int)buf[j][c].y, (int)hq[c].y, a, false);
            a = __builtin_amdgcn_sdot4((int)buf[j][c].z, (int)hq[c].z, a, false); a = __builtin_amdgcn_sdot4((int)buf[j][c].w, (int)hq[c].w, a, false); }
        a = wave_isum(a);
        const int kk = grp * EXG + j;
        d0 = (lane == kk) ? a : d0; d1 = (lane + 64 == kk) ? a : d1; }
}
__device__ __forceinline__ void peer_u_phase(const bf16_t* H, const int* IDX, const float* GATE, const unsigned char* U, const float* SU, const float* SV, unsigned* WE, float* WSC, int bx, int G, int wave, int lane) {
    for (int tt = bx * 64 + wave * 8; tt < T; tt += ((tt & 7) == 7) ? (G * 64 - 7) : 1) { const int t = tt;
        u32x4 hq[2]; float hs;
        { u32x4 hv[2][2]; float am = 0.f;
#pragma unroll
          for (int c = 0; c < 2; ++c) { const u32x4* hp = (const u32x4*)(H + (size_t)t * D + 1024 * c + 16 * lane); hv[c][0] = hp[0]; hv[c][1] = hp[1];
#pragma unroll
              for (int i = 0; i < 2; ++i)
#pragma unroll
                  for (int d = 0; d < 4; ++d) am = fmaxf(am, fmaxf(fabsf(bflo(hv[c][i][d])), fabsf(bfhi(hv[c][i][d])))); }
#pragma unroll
          for (int o = 1; o < 64; o <<= 1) am = fmaxf(am, __shfl_xor(am, o));
          hs = am > 0.f ? am * (1.0f / 127.0f) : 1.0f; const float inv = 1.0f / hs;
#pragma unroll
          for (int c = 0; c < 2; ++c)
#pragma unroll
              for (int i = 0; i < 2; ++i)
#pragma unroll
                  for (int dd = 0; dd < 2; ++dd) { const unsigned p0 = hv[c][i][2 * dd], p1 = hv[c][i][2 * dd + 1];
                      const unsigned q0 = (unsigned)(int)rintf(bflo(p0) * inv) & 255u, q1 = (unsigned)(int)rintf(bfhi(p0) * inv) & 255u, q2 = (unsigned)(int)rintf(bflo(p1) * inv) & 255u, q3 = (unsigned)(int)rintf(bfhi(p1) * inv) & 255u;
                      hq[c][2 * i + dd] = q0 | (q1 << 8) | (q2 << 16) | (q3 << 24); } }
        const int e0 = IDX[(size_t)t * 128 + lane] & 16383, e1 = IDX[(size_t)t * 128 + 64 + lane] & 16383;
        const float g0 = GATE[(size_t)t * 128 + lane], g1 = GATE[(size_t)t * 128 + 64 + lane];
        const float su0 = SU[e0], su1 = SU[e1], sv0 = SV[e0], sv1 = SV[e1];
        int d0 = 0, d1 = 0;
        u32x4 bA[EXG][2], bB[EXG][2];
        ex_load_rows(bA, U, e0, e1, 0, lane);
#pragma unroll 1
        for (int g = 0; g < 32; g += 2) {
            ex_load_rows(bB, U, e0, e1, g + 1, lane); ex_dots(bA, hq, d0, d1, g, lane);
            ex_load_rows(bA, U, e0, e1, (g + 2 < 32) ? g + 2 : 31, lane); ex_dots(bB, hq, d0, d1, g + 1, lane); }
        asm volatile("s_waitcnt vmcnt(0)" ::: "memory");
        const float w0 = g0 * pg8::gelu_tanh((float)d0 * su0 * hs) * sv0, w1 = g1 * pg8::gelu_tanh((float)d1 * su1 * hs) * sv1;
        float wam = fmaxf(fabsf(w0), fabsf(w1));
#pragma unroll
        for (int o = 1; o < 64; o <<= 1) wam = fmaxf(wam, __shfl_xor(wam, o));
        const float wsc = wam > 0.f ? wam * (1.0f / 127.0f) : 1.0f, winv = 1.0f / wsc;
        const int q0 = (int)rintf(w0 * winv) & 255, q1 = (int)rintf(w1 * winv) & 255;
#define QB(v, j) __builtin_amdgcn_update_dpp(0, (v), (j) * 0x55, 0xf, 0xf, false)
        u32x4 qa, qb;
        qa.x = (unsigned)(q0 | (QB(q0, 1) << 8) | (QB(q0, 2) << 16) | (QB(q0, 3) << 24)); qa.y = (unsigned)(e0 | (QB(e0, 1) << 16)); qa.z = (unsigned)(QB(e0, 2) | (QB(e0, 3) << 16)); qa.w = 0u;
        qb.x = (unsigned)(q1 | (QB(q1, 1) << 8) | (QB(q1, 2) << 16) | (QB(q1, 3) << 24)); qb.y = (unsigned)(e1 | (QB(e1, 1) << 16)); qb.z = (unsigned)(QB(e1, 2) | (QB(e1, 3) << 16)); qb.w = 0u;
#undef QB
        if ((lane & 3) == 0) { u32x4* qp = (u32x4*)WE + (size_t)(t >> 6) * 2048 + (t & 63);
            qp[(lane >> 2) * 64] = qa; qp[(16 + (lane >> 2)) * 64] = qb; }
        if (lane == 0) WSC[t] = wsc;
    }
}
__device__ __forceinline__ void peer_u_lds(LAS unsigned char* lds, const unsigned char* U, const unsigned char* HQ, const unsigned* ENT, const unsigned* SEG, int* PART, int j, int sl, int tid) {
#pragma unroll 4
    for (int i = 0; i < 16; ++i) { const int id = tid + NTHREADS * i, el = id >> 4, c = id & 15;
        *(LAS u32x4*)(lds + el * 256 + 16 * c) = *(const u32x4*)(U + (size_t)(el * 32 + (int)(((unsigned)j ^ gmix((unsigned)el)) & 31u)) * D + 256 * sl + 16 * c); }
    __syncthreads();
    const int lane = tid & 63, w = __builtin_amdgcn_readfirstlane(tid >> 6), p4 = lane & 3, eq = lane >> 2;
    const unsigned char* hqb = HQ + 256 * sl;
    unsigned lco[4];
    const int fb = (eq & 7) >> 1;
    int* part = PART + (size_t)sl * NPOOL;
#pragma unroll
    for (int i = 0; i < 4; ++i) lco[i] = (unsigned)(64 * (i ^ fb) + 16 * p4);
    int offv = 0, cntv = 0;
    if (lane < 32) { offv = (int)SEG[((size_t)(w + 8 * lane) * 32 + j) * 2]; cntv = (int)(SEG[((size_t)(w + 8 * lane) * 32 + j) * 2 + 1] >> 1); }
    struct Trip { int si, b0, off, cnt; };
    auto first_trip = [&](Trip& tr) { tr.si = 0; tr.b0 = 0; tr.off = __builtin_amdgcn_readlane(offv, 0); tr.cnt = __builtin_amdgcn_readlane(cntv, 0);
        while (tr.si < 32 && tr.b0 >= tr.cnt) { ++tr.si; if (tr.si < 32) { tr.off = __builtin_amdgcn_readlane(offv, tr.si); tr.cnt = __builtin_amdgcn_readlane(cntv, tr.si); tr.b0 = 0; } } };
    auto next_trip = [&](Trip& tr) { if (tr.si >= 32) return; tr.b0 += 64;
        while (tr.si < 32 && tr.b0 >= tr.cnt) { ++tr.si; if (tr.si < 32) { tr.off = __builtin_amdgcn_readlane(offv, tr.si); tr.cnt = __builtin_amdgcn_readlane(cntv, tr.si); tr.b0 = 0; } } };
#define QBC(v, sb) ((unsigned)__builtin_amdgcn_update_dpp(0, (int)(v), (sb) * 0x55, 0xf, 0xf, false))
#define LOAD_OWN(dst, tr) do { const int idx = (tr).b0 + 16 * p4 + eq; const bool ok = (tr).si < 32 && idx < (tr).cnt; (dst) = *(const u32x2*)(ENT + (ok ? (unsigned)((tr).off + 2 * idx) : 0u)); } while (0)
#define HQ_SB(dst, o, sb) do { const unsigned tof_ = (QBC((o).x, sb) & 32767u) << 11; _Pragma("unroll") for (int i = 0; i < 4; ++i) (dst)[sb][i] = *(const u32x4*)(hqb + (tof_ + lco[i])); } while (0)
#define LOAD_HQ(dst, o) do { HQ_SB(dst, o, 0); HQ_SB(dst, o, 1); HQ_SB(dst, o, 2); HQ_SB(dst, o, 3); } while (0)
#define SB_BODY(sb, o, hb_, hbn_, on_) do { \
        HQ_SB(hbn_, on_, sb);     \
        const unsigned el0 = QBC((o).x, sb) >> 15, el1 = QBC((o).y, sb) >> 15; int acc0 = 0, acc1 = 0; \
        _Pragma("unroll") for (int i = 0; i < 4; ++i) { const u32x4 ua = *(const LAS u32x4*)(lds + (el0 * 256u + lco[i])), ub = *(const LAS u32x4*)(lds + (el1 * 256u + lco[i])); \
            acc0 = __builtin_amdgcn_sdot4((int)ua.x, (int)(hb_)[sb][i].x, acc0, false); acc1 = __builtin_amdgcn_sdot4((int)ub.x, (int)(hb_)[sb][i].x, acc1, false); \
            acc0 = __builtin_amdgcn_sdot4((int)ua.y, (int)(hb_)[sb][i].y, acc0, false); acc1 = __builtin_amdgcn_sdot4((int)ub.y, (int)(hb_)[sb][i].y, acc1, false); \
            acc0 = __builtin_amdgcn_sdot4((int)ua.z, (int)(hb_)[sb][i].z, acc0, false); acc1 = __builtin_amdgcn_sdot4((int)ub.z, (int)(hb_)[sb][i].z, acc1, false); \
            acc0 = __builtin_amdgcn_sdot4((int)ua.w, (int)(hb_)[sb][i].w, acc0, false); acc1 = __builtin_amdgcn_sdot4((int)ub.w, (int)(hb_)[sb][i].w, acc1, false); } \
        acc0 += __builtin_amdgcn_update_dpp(0, acc0, 0xB1, 0xf, 0xf, false); acc1 += __builtin_amdgcn_update_dpp(0, acc1, 0xB1, 0xf, 0xf, false); \
        acc0 += __builtin_amdgcn_update_dpp(0, acc0, 0x4E, 0xf, 0xf, false); acc1 += __builtin_amdgcn_update_dpp(0, acc1, 0x4E, 0xf, 0xf, false); \
        res0_ = (p4 == sb) ? acc0 : res0_; res1_ = (p4 == sb) ? acc1 : res1_; } while (0)
#define COMPUTE(tr, o, hb_, hbn_, on_) do { int res0_ = 0, res1_ = 0; SB_BODY(0, o, hb_, hbn_, on_); SB_BODY(1, o, hb_, hbn_, on_); SB_BODY(2, o, hb_, hbn_, on_); SB_BODY(3, o, hb_, hbn_, on_); \
        const int idx = (tr).b0 + 16 * p4 + eq; if ((tr).si < 32 && idx < (tr).cnt) { u32x2 r_; r_.x = (unsigned)res0_; r_.y = (unsigned)res1_; *(u32x2*)(part + ((tr).off + 2 * idx)) = r_; } } while (0)
    Trip tA, tB, tC;
    first_trip(tA); tB = tA; next_trip(tB); tC = tB; next_trip(tC);
    u32x2 oA, oB, oC; u32x4 h0[4][4], h1[4][4];
    LOAD_OWN(oA, tA); LOAD_OWN(oB, tB);
    LOAD_HQ(h0, oA);
    while (tA.si < 32) {
        LOAD_OWN(oC, tC); COMPUTE(tA, oA, h0, h1, oB);
        tA = tB; tB = tC; next_trip(tC); oA = oB; oB = oC;
        if (tA.si >= 32) break;
        LOAD_OWN(oC, tC); COMPUTE(tA, oA, h1, h0, oB);
        tA = tB; tB = tC; next_trip(tC); oA = oB; oB = oC;
    }
#undef QBC
#undef LOAD_OWN
#undef HQ_SB
#undef LOAD_HQ
#undef SB_BODY
#undef COMPUTE
    asm volatile("s_waitcnt vmcnt(0)" ::: "memory");
    __syncthreads();
}
__device__ __forceinline__ void peer_reduce_unit(LAS unsigned char* lds, const int* IDX, const float* GATE, const unsigned* POS, const int* PART, const float* HSC, const float* SU, const float* SV, unsigned* WE, float* WSC, int unit, int tid) {
    const int lane = tid & 63, w = tid >> 6;
    LAS int* dl = (LAS int*)lds; const unsigned pbase = (unsigned)unit * (unsigned)POOLU;
    __syncthreads();
    for (int i = tid; i < POOLU / 4; i += NTHREADS) { pg8::i32x4 acc = *(const pg8::i32x4*)(PART + (size_t)pbase + 4 * i);
#pragma unroll
        for (int s8 = 1; s8 < 8; ++s8) acc += *(const pg8::i32x4*)(PART + (size_t)s8 * NPOOL + pbase + 4 * i);
        *(LAS pg8::i32x4*)(dl + 4 * i) = acc; }
    __syncthreads();
    constexpr int TU = 4;
    for (int i0 = 0; i0 < 16; i0 += TU) {
        int e0[TU], e1[TU]; float g0[TU], g1[TU]; unsigned p0[TU], p1[TU]; float hs[TU];
#pragma unroll
        for (int u = 0; u < TU; ++u) { const size_t tb = (size_t)(unit * 128 + w * 16 + i0 + u) * 128;
            e0[u] = IDX[tb + lane] & 16383; e1[u] = IDX[tb + 64 + lane] & 16383; g0[u] = GATE[tb + lane]; g1[u] = GATE[tb + 64 + lane]; p0[u] = POS[tb + lane]; p1[u] = POS[tb + 64 + lane];
            hs[u] = HSC[unit * 128 + w * 16 + i0 + u]; }
        int d0[TU], d1[TU]; float su0[TU], su1[TU], sv0[TU], sv1[TU];
#pragma unroll
        for (int u = 0; u < TU; ++u) { d0[u] = dl[p0[u] - pbase]; d1[u] = dl[p1[u] - pbase];
            su0[u] = SU[e0[u]]; su1[u] = SU[e1[u]]; sv0[u] = SV[e0[u]]; sv1[u] = SV[e1[u]]; }
#pragma unroll
        for (int u = 0; u < TU; ++u) { const int t = unit * 128 + w * 16 + i0 + u;
            const float w0 = g0[u] * pg8::gelu_tanh((float)d0[u] * su0[u] * hs[u]) * sv0[u], w1 = g1[u] * pg8::gelu_tanh((float)d1[u] * su1[u] * hs[u]) * sv1[u];
            float wam = fmaxf(fabsf(w0), fabsf(w1));
#pragma unroll
            for (int o = 1; o < 64; o <<= 1) wam = fmaxf(wam, __shfl_xor(wam, o));
            const float wsc = wam > 0.f ? wam * (1.0f / 127.0f) : 1.0f, winv = 1.0f / wsc;
            const int q0 = (int)rintf(w0 * winv) & 255, q1 = (int)rintf(w1 * winv) & 255;
#define QB(v, jj) __builtin_amdgcn_update_dpp(0, (v), (jj) * 0x55, 0xf, 0xf, false)
            u32x4 qa, qb; const int ea = e0[u], eb = e1[u];
            qa.x = (unsigned)(q0 | (QB(q0, 1) << 8) | (QB(q0, 2) << 16) | (QB(q0, 3) << 24)); qa.y = (unsigned)(ea | (QB(ea, 1) << 16)); qa.z = (unsigned)(QB(ea, 2) | (QB(ea, 3) << 16)); qa.w = 0u;
            qb.x = (unsigned)(q1 | (QB(q1, 1) << 8) | (QB(q1, 2) << 16) | (QB(q1, 3) << 24)); qb.y = (unsigned)(eb | (QB(eb, 1) << 16)); qb.z = (unsigned)(QB(eb, 2) | (QB(eb, 3) << 16)); qb.w = 0u;
#undef QB
            if ((lane & 3) == 0) { u32x3* qp = (u32x3*)WE + (size_t)(t >> 6) * 2048 + (t & 63);
                u32x3 a3, b3; a3.x = qa.x; a3.y = qa.y; a3.z = qa.z; b3.x = qb.x; b3.y = qb.y; b3.z = qb.z; qp[(lane >> 2) * 64] = a3; qp[(16 + (lane >> 2)) * 64] = b3; }
            if (lane == 0) WSC[t] = wsc; }
    }
}
__device__ __forceinline__ unsigned lo16x8(unsigned x) { unsigned r; const unsigned three = 3u; asm("v_lshlrev_b32_sdwa %0, %1, %2 dst_sel:DWORD dst_unused:UNUSED_PAD src0_sel:DWORD src1_sel:WORD_0" : "=v"(r) : "v"(three), "v"(x)); return r; }
__device__ __forceinline__ void peer_v_slice(LAS unsigned char* lds, const unsigned char* VSl, const unsigned* WE, const float* WSC, bf16_t* XR, const float* g2mod, int sl, int tid) {
    { const u32x4* src = (const u32x4*)(VSl + (size_t)sl * 131072);
#pragma unroll 4
      for (int i = 0; i < 16; ++i) { const int idx = tid + NTHREADS * i; *(LAS u32x4*)(lds + idx * 16) = src[idx]; } }
    __syncthreads();
    const int lane = tid & 63, w = tid >> 6;
    constexpr int VQ = 16;
    const int rot = 37 * (sl >> 3);
    u32x3 cur[VQ], nxt[VQ];
    { const u32x3* wp0 = (const u32x3*)WE + (size_t)((w + rot) & (T / 64 - 1)) * 2048 + lane;
#pragma unroll
      for (int i = 0; i < VQ; ++i) cur[i] = wp0[64 * i]; }
    for (int tbi = w; tbi < T / 64; tbi += NWAVES) {
        const int tb = (tbi + rot) & (T / 64 - 1);
        const int tbn = (((tbi + NWAVES < T / 64) ? tbi + NWAVES : tbi) + rot) & (T / 64 - 1);
        const int t = tb * 64 + lane, b = t >> 14;
        const float wsc = WSC[t];
        u32x4* xr = (u32x4*)(XR + (size_t)t * D + 8 * sl); const float* gp = g2mod + (size_t)b * 12288 + 8 * sl;
        const u32x4 xx = *xr; const f32x4 ga = *(const f32x4*)gp, gb = *(const f32x4*)(gp + 4);
        int acc[8];
#pragma unroll
        for (int j = 0; j < 8; ++j) acc[j] = 0;
#define V_HALF(CUR, NXT, WPN) do { { const u32x3* wpn = (WPN); _Pragma("unroll") for (int i = 0; i < VQ; ++i) (NXT)[i] = wpn[64 * i]; } \
            _Pragma("unroll") for (int sb = 0; sb < VQ; sb += 4) { u32x2 row[4][4]; \
                _Pragma("unroll") for (int i = 0; i < 4; ++i) { row[i][0] = *(const LAS u32x2*)(lds + lo16x8((CUR)[sb + i].y)); row[i][1] = *(const LAS u32x2*)(lds + ((CUR)[sb + i].y >> 16) * 8); \
                    row[i][2] = *(const LAS u32x2*)(lds + lo16x8((CUR)[sb + i].z)); row[i][3] = *(const LAS u32x2*)(lds + ((CUR)[sb + i].z >> 16) * 8); } \
                _Pragma("unroll") for (int i = 0; i < 4; ++i) { const int wq = (int)(CUR)[sb + i].x; \
                      \
                    _Pragma("unroll") for (int hh = 0; hh < 2; ++hh) { const unsigned r0 = row[i][0][hh], r1 = row[i][1][hh], r2 = row[i][2][hh], r3 = row[i][3][hh]; \
                        const unsigned t0 = __builtin_amdgcn_perm(r1, r0, 0x05010400u), t1 = __builtin_amdgcn_perm(r1, r0, 0x07030602u); \
                        const unsigned t2 = __builtin_amdgcn_perm(r3, r2, 0x05010400u), t3 = __builtin_amdgcn_perm(r3, r2, 0x07030602u); \
                        const unsigned c0 = __builtin_amdgcn_perm(t2, t0, 0x05040100u), c1 = __builtin_amdgcn_perm(t2, t0, 0x07060302u); \
                        const unsigned c2 = __builtin_amdgcn_perm(t3, t1, 0x05040100u), c3 = __builtin_amdgcn_perm(t3, t1, 0x07060302u); \
                        acc[4 * hh + 0] = __builtin_amdgcn_sdot4((int)c0, wq, acc[4 * hh + 0], false); acc[4 * hh + 1] = __builtin_amdgcn_sdot4((int)c1, wq, acc[4 * hh + 1], false); \
                        acc[4 * hh + 2] = __builtin_amdgcn_sdot4((int)c2, wq, acc[4 * hh + 2], false); acc[4 * hh + 3] = __builtin_amdgcn_sdot4((int)c3, wq, acc[4 * hh + 3], false); } } \
                __builtin_amdgcn_sched_barrier(0); } } while (0)
        V_HALF(cur, nxt, (const u32x3*)WE + (size_t)tb * 2048 + lane + 64 * VQ);
        V_HALF(nxt, cur, (const u32x3*)WE + (size_t)tbn * 2048 + lane);
#undef V_HALF
        u32x4 o; o.x = pk2(bflo(xx.x) + ga.x * (wsc * (float)acc[0]), bfhi(xx.x) + ga.y * (wsc * (float)acc[1])); o.y = pk2(bflo(xx.y) + ga.z * (wsc * (float)acc[2]), bfhi(xx.y) + ga.w * (wsc * (float)acc[3]));
        o.z = pk2(bflo(xx.z) + gb.x * (wsc * (float)acc[4]), bfhi(xx.z) + gb.y * (wsc * (float)acc[5])); o.w = pk2(bflo(xx.w) + gb.z * (wsc * (float)acc[6]), bfhi(xx.w) + gb.w * (wsc * (float)acc[7]));
        *xr = o;
    }
    __syncthreads();
}
__device__ __forceinline__ void norm_row_final(float* xrow, const float* g, int lane) {
    f32x4 v[8]; float ss = 0.f;
#pragma unroll
    for (int j = 0; j < 8; ++j) { v[j] = *(const f32x4*)(xrow + 4 * lane + 256 * j); ss += (v[j].x * v[j].x + v[j].y * v[j].y) + (v[j].z * v[j].z + v[j].w * v[j].w); }
    ss = wave_sum(ss);
    const float rstd = rsqrtf(ss * (1.0f / D) + EPS);
#pragma unroll
    for (int j = 0; j < 8; ++j) { const f32x4 gg = *(const f32x4*)(g + 4 * lane + 256 * j); *(f32x4*)(xrow + 4 * lane + 256 * j) = v[j] * rstd * gg; }
}

constexpr int NPHASES = 23;
struct Args { const float* in[26]; float* out; unsigned char* ws; int ph_lo, ph_hi; };

__global__ void __launch_bounds__(NTHREADS, 2) fwd_kernel(Args args) {
    extern __shared__ __attribute__((aligned(16))) unsigned char lds_raw[];
    (void)lds_raw;
    LAS unsigned char* lds = (LAS unsigned char*)(uintptr_t)0u;
    int tid = threadIdx.x; const int lane = tid & 63, wave = __builtin_amdgcn_readfirstlane(tid >> 6);
    const int G = gridDim.x, bx = blockIdx.x;
    const int gw = bx * NWAVES + wave, ngw = G * NWAVES, gtid = bx * NTHREADS + tid, nthr = G * NTHREADS;
    unsigned char* ws = args.ws;
    for (int u = tid; u < (LDS_BYTES - MISC_OFF) / 4; u += NTHREADS) ((LAS unsigned*)(lds + MISC_OFF))[u] = 0u;
    __syncthreads();
    const int lo = args.ph_lo, hi = args.ph_hi;
    unsigned* barw = (unsigned*)(ws + WS_CTL) + CW_BAR;
    XcdBarrier bar; bar.bar = barw; bar.x = 0; bar.st = (volatile LAS unsigned*)(lds + MISC_OFF + 32);
    if (hi - lo > 1) bar = xcd_barrier_post(barw, (volatile LAS unsigned*)(lds + MISC_OFF + 32));
#ifndef PHMASK
#define PHMASK 0xFFFFFFu
#endif
#define IN(k) (lo <= (k) && (k) < hi)
#define ON(j) (((PHMASK) >> (j)) & 1u)
#define SEAM(k) do { if (IN(k) && IN((k) + 1)) xcd_barrier(bar); asm volatile("" : "+v"(tid)); } while (0)

    float* MOD = (float*)(ws + WS_MOD); float* MODC = (float*)(ws + WS_MODC);
    bf16_t* HB = (bf16_t*)(ws + WS_H); bf16_t* GGB = (bf16_t*)(ws + WS_GG); bf16_t* XBB = (bf16_t*)(ws + WS_XB);
    bf16_t* HC = (bf16_t*)(ws + WS_HC); bf16_t* XBC = (bf16_t*)(ws + WS_XBC);
    bf16_t* XR = (bf16_t*)(ws + WS_XR);

    if (ON(0) && IN(0)) {
        if (G == 256) { if (bx < 128) for (int item = bx; item < 192; item += 128) p0_gemv(lds, args.in[1], args.in[3], args.in[4], args.in[5], MOD, MODC, item, tid); }
        else for (int item = bx; item < 192; item += G) p0_gemv(lds, args.in[1], args.in[3], args.in[4], args.in[5], MOD, MODC, item, tid);
        for (int it = (G == 256) ? ((bx >= 128) ? bx - 128 : 128) : (G - 1 - bx); it < 128; it += G) {
            if (it >= 112) p0_quant_strip(lds, args.in[21], D, 128 * (it - 112), ws + WS_WOUT1, (float*)(ws + WS_CS0) + 4096 + 6144 + 2 * D, 128 * (it - 112), tid);
            else if (it >= 80) { const int L = (it - 80) >> 4, st = (it - 80) & 15;
                p0_quant_strip(lds, args.in[22] + (size_t)L * D * D, D, 128 * st, ws + WS_WQ + (size_t)L * D * D, (float*)(ws + WS_CS0) + 4096 + 6144 + L * D, 128 * st, tid); }
            else if (it < 32) p0_quant_strip(lds, args.in[9], 4096, 128 * it, ws + WS_WIN0, (float*)(ws + WS_CS0), 128 * it, tid);
            else { const int col0 = 128 * (it - 32); int nb;
                if (col0 < 2048) nb = col0; else if (col0 < 4096) nb = 2048 + ((col0 - 2048) >> 7) * 256; else nb = 2048 + ((col0 - 4096) >> 7) * 256 + 128;
                p0_quant_strip(lds, args.in[18], 6144, col0, ws + WS_WIN1, (float*)(ws + WS_CS0) + 4096, nb, tid); } }
        LAS float* scr = (LAS float*)(lds + wave * 16384);
        constexpr int I_WOUT = 32 * 64, I_GATE = 64 * 8;
        constexpr int NITEMS = I_WOUT + I_WOUT + I_GATE;
        for (int it = gw; it < NITEMS; it += ngw) {
            int r = it;
            if (r < I_WOUT) { p0_transpose_item(args.in[9] + 2048, D, D, 4096, (bf16_t*)(ws + WS_WIN0C), 0, scr, r, lane); continue; } r -= I_WOUT;
            if (r < I_WOUT) { p0_transpose_item(args.in[17], D, D, D, (bf16_t*)(ws + WS_WOUT0), 0, scr, r, lane); continue; } r -= I_WOUT;
            { const int mtx = r >> 3, dir = mtx >> 5, g = (mtx >> 4) & 1, h = mtx & 15;
              const float* srcw = (g == 0 ? args.in[12] : args.in[14]) + (size_t)(dir * 16 + h) * 16384;
              p0_transpose_item(srcw, 128, 128, 128, (bf16_t*)(ws + WS_GW) + (size_t)mtx * 16384, 0, scr, r & 7, lane, -LOG2E); }
        }
        { f32x4 ra[2][4], rb[2][4];
          p0_row_load(ra, args.in[24] + (size_t)gw * D, lane);
          for (int row = gw; row < 2 * 16384; row += 2 * ngw) {
              const int r1 = row + ngw, r1c = (r1 < 2 * 16384) ? r1 : row, r2 = (row + 2 * ngw < 2 * 16384) ? row + 2 * ngw : row;
              p0_row_load(rb, args.in[24] + (size_t)r1c * D, lane);
              p0_row_quant(ra, ws + WS_U + (size_t)row * D, (float*)(ws + WS_SCL) + row, 0, lane, false, 0, lds);
              p0_row_load(ra, args.in[24] + (size_t)r2 * D, lane);
              if (r1 < 2 * 16384) p0_row_quant(rb, ws + WS_U + (size_t)r1 * D, (float*)(ws + WS_SCL) + r1, 0, lane, false, 0, lds); } }
        for (int grp = bx; grp < 2 * 1024; grp += G) {
            __syncthreads();
            { f32x4 ra[2][4], rb[2][4]; const int r16 = wave * 2, rr = grp * 16 + r16;
              p0_row_load(ra, args.in[25] + (size_t)rr * D, lane); p0_row_load(rb, args.in[25] + (size_t)(rr + 1) * D, lane);
              p0_row_quant(ra, (unsigned char*)nullptr, (float*)(ws + WS_SCL) + 32768 + rr, 0, lane, true, r16, lds);
              p0_row_quant(rb, (unsigned char*)nullptr, (float*)(ws + WS_SCL) + 32768 + rr + 1, 0, lane, true, r16 + 1, lds); }
            __syncthreads();
            unsigned char* vbase = ws + WS_V + (size_t)(grp >> 10) * 16384 * D; const int e0g = (grp & 1023) * 16;
#pragma unroll
            for (int i = 0; i < 8; ++i) { const int idx = tid + NTHREADS * i, sl = idx >> 4, ee = idx & 15;
                const u32x2 v8 = *(const LAS u32x2*)(lds + ee * 2048 + sl * 8);
                *(u32x2*)(vbase + ((size_t)sl * 16384 + e0g + ee) * 8) = v8; }
        }
        __syncthreads();
    }
    SEAM(0);
    if (ON(1) && IN(1)) {
        LAS float* Gs = (LAS float*)lds; LAS float* Ss = (LAS float*)(lds + 16384); LAS float* Gc = (LAS float*)(lds + 32768); LAS float* Sc = (LAS float*)(lds + 40960);
        fill_mod_lds(Gs, Ss, args.in[6], MOD, 0, 1, tid);
        for (int i = tid; i < D; i += NTHREADS) { Gc[i] = args.in[6][i] * (1.0f + MODC[D + i]); Sc[i] = MODC[i]; }
        __syncthreads();
        for (int m = gw; m < T; m += ngw) { const int b = m >> 14; norm_row_q8(args.in[0] + (size_t)m * D, Gs + b * D, Ss + b * D, (unsigned*)(ws + WS_H) + (size_t)m * 512, (float*)(ws + WS_HSA) + m, lane); }
        for (int m = gw; m < TC; m += ngw) norm_row_store(args.in[2] + (size_t)m * D, Gc, Sc, HC + (size_t)m * D, lane);
        for (size_t i = (size_t)gtid * 8; i < (size_t)2 * 8 * 2 * 128 * 128; i += (size_t)nthr * 8) { const int L_ = (int)(i >> 18), hp = (int)(i >> 14) & 15, d0 = (int)i & 127;
            const float* cq = (const float*)(ws + WS_CS0) + 4096 + 6144 + L_ * D + hp * 128 + d0; const f32x4 c0 = *(const f32x4*)cq, c1 = *(const f32x4*)(cq + 4);
            const f32x4 a = *(const f32x4*)(args.in[23] + i) * c0, b = *(const f32x4*)(args.in[23] + i + 4) * c1;
            u32x4 o; o.x = pk2(a.x, a.y); o.y = pk2(a.z, a.w); o.z = pk2(b.x, b.y); o.w = pk2(b.z, b.w); *(u32x4*)((bf16_t*)(ws + WS_KEYS) + i) = o; }
        __syncthreads();
    }
    SEAM(1);
    if (ON(2) && IN(2)) {
        { pg8::Gemm g{HB, (const bf16_t*)(ws + WS_WIN0), T, 4096, D / 2}; pg8::StaticOrder S; S.init(T, 4096, G, bx);
          pg8::EpiGateXbI8 E{GGB, XBB, (const float*)(ws + WS_HSA), (const float*)(ws + WS_CS0)};
          pg8::gemm_phase<pg8::EpiGateXbI8, pg8::StaticOrder, true, true>(lds, g, S, E); }
        for (int tile = bx; tile < 256; tile += G) ctx_gemm_tile(HC, (const bf16_t*)(ws + WS_WIN0C), XBC, tile, tid);
    }
    SEAM(2);
    if (ON(3) && IN(3)) {
        for (int u = bx; u < 256; u += G) scan_unit<1>(lds, args.in[10], args.in[11], args.in[13], args.in[15], args.in[16], ws, false, u >> 7, (u >> 3) & 15, u & 7, tid);
        for (int u = bx; u < 256; u += G) scan_ctx_tile(lds, args.in[10], args.in[11], args.in[13], args.in[15], args.in[16], ws, u >> 7, (u >> 3) & 15, (u >> 2) & 1, u & 3, tid);
    }
    SEAM(3);
    if (ON(4) && IN(4)) {
        for (int u = bx; u < 256; u += G) scan_unit<2>(lds, args.in[10], args.in[11], args.in[13], args.in[15], args.in[16], ws, false, u >> 7, (u >> 3) & 15, u & 7, tid);
    }
    SEAM(4);
    {
    constexpr int pb = 5;
    const float* modL = MOD + (size_t)0 * 2 * 12288;
    if (ON(17) && IN(pb)) {
        pg8::Gemm g{HB, (const bf16_t*)(ws + WS_WOUT0), T, D, D}; pg8::StaticOrder S; S.init(T, D, G, bx);
        pg8::EpiResidBf<true> E{args.in[0], nullptr, XR, modL + 2 * D, 12288};
        pg8::gemm_phase<pg8::EpiResidBf<true>, pg8::StaticOrder, true, true>(lds, g, S, E);
    }
    SEAM(pb);
    if (ON(18) && IN(pb + 1)) {
        LAS float* Gs = (LAS float*)lds; LAS float* Ss = (LAS float*)(lds + 16384);
        fill_mod_lds(Gs, Ss, args.in[7] + (size_t)0 * D, modL, 3, 4, tid);
        __syncthreads();
        for (int m = gw; m < T; m += ngw) { const int b = m >> 14; norm_row_store_h<true, false>(XR + (size_t)m * D, Gs + b * D, Ss + b * D, nullptr, (unsigned*)(ws + WS_HQ) + (size_t)m * 512, (float*)(ws + WS_HSC) + m, lane); }
        __syncthreads();
    }
    SEAM(pb + 1);
    if (ON(19) && IN(pb + 2)) {
        pg8::Gemm g{(const bf16_t*)(ws + WS_HQ), (const bf16_t*)(ws + WS_WQ + (size_t)0 * D * D), T, D, D / 2}; pg8::StaticOrder S; S.init(T, D, G, bx);
        pg8::EpiRawI8 E{GGB, D};
        pg8::gemm_phase<pg8::EpiRawI8, pg8::StaticOrder, true, true>(lds, g, S, E);
    }
    SEAM(pb + 2);
    if (ON(20) && IN(pb + 3)) {
        for (int u = bx; u < T / 128; u += G) peer_select_unit(lds, GGB, (const bf16_t*)(ws + WS_KEYS) + (size_t)0 * 262144, (const float*)(ws + WS_HSC), (int*)(ws + WS_IDX), (float*)(ws + WS_GATE), (unsigned*)(ws + WS_ENT), (unsigned*)(ws + WS_POS), (unsigned*)(ws + WS_SEG), u, tid);
        __syncthreads();
    }
    SEAM(pb + 3);
    if (ON(21) && IN(pb + 4)) {
        for (int un = bx; un < 256; un += G) peer_u_lds(lds, ws + WS_U + (size_t)0 * 16384 * D, ws + WS_HQ, (const unsigned*)(ws + WS_ENT), (const unsigned*)(ws + WS_SEG), (int*)(ws + WS_PART), (G == 256) ? (un >> 3) : (un & 31), (G == 256) ? (un & 7) : (un >> 5), tid);
    }
    SEAM(pb + 4);
    if (ON(21) && IN(pb + 5)) {
        for (int un = bx; un < T / 128; un += G) peer_reduce_unit(lds, (const int*)(ws + WS_IDX), (const float*)(ws + WS_GATE), (const unsigned*)(ws + WS_POS), (const int*)(ws + WS_PART), (const float*)(ws + WS_HSC),
                                                              (const float*)(ws + WS_SCL) + 0 * 16384, (const float*)(ws + WS_SCL) + (2 + 0) * 16384, (unsigned*)(ws + WS_WE), (float*)(ws + WS_WSC), un, tid);
    }
    SEAM(pb + 5);
    if (ON(22) && IN(pb + 6)) {
        for (int sl_ = bx; sl_ < 256; sl_ += G) { const int sl = (G == 256) ? ((sl_ & 7) * 32 + (sl_ >> 3)) : sl_; peer_v_slice(lds, ws + WS_V + (size_t)0 * 16384 * D, (const unsigned*)(ws + WS_WE), (const float*)(ws + WS_WSC), XR, modL + 5 * D, sl, tid); }
    }
    SEAM(pb + 6);
    if (ON(23) && IN(pb + 7)) {
        LAS float* Gs = (LAS float*)lds; LAS float* Ss = (LAS float*)(lds + 16384);
        fill_mod_lds(Gs, Ss, args.in[6] + D, MOD + (size_t)2 * 12288, 0, 1, tid);
        __syncthreads();
        for (int m = gw; m < T; m += ngw) { const int b = m >> 14; norm_row_store_h<true, false>(XR + (size_t)m * D, Gs + b * D, Ss + b * D, nullptr, (unsigned*)(ws + WS_H) + (size_t)m * 512, (float*)(ws + WS_HSA) + m, lane); }
        __syncthreads();
    }
    SEAM(pb + 7);
    }
    if (ON(10) && IN(13)) {
        { pg8::Gemm g{HB, (const bf16_t*)(ws + WS_WIN1), T, D, D / 2}; pg8::StaticOrder S; S.init(T, D, G, bx);
          pg8::EpiRawI8 E{GGB, D};
          pg8::gemm_phase<pg8::EpiRawI8, pg8::StaticOrder, true, true>(lds, g, S, E); }
        { pg8::Gemm g{HB, (const bf16_t*)(ws + WS_WIN1 + (size_t)2048 * 2048), T, 4096, D / 2}; pg8::StaticOrder S; S.init(T, 4096, G, bx);
          pg8::EpiCvI8 E{XBB, (const float*)(ws + WS_HSA), (const float*)(ws + WS_CS0) + 4096 + 2048};
          pg8::gemm_phase<pg8::EpiCvI8, pg8::StaticOrder, true, true>(lds, g, S, E); }
    }
    SEAM(13);
    if (ON(11) && IN(14)) {
        LAS float* cwl = (LAS float*)lds;
        for (int i = tid; i < 4 * D; i += NTHREADS) cwl[i] = ((i < 3 * D) ? args.in[19][i] : args.in[20][i - 3 * D]) * ((const float*)(ws + WS_CS0))[4096 + (i & (D - 1))];
        __syncthreads();
        for (int m = gw; m < T; m += ngw) sc_conv_mul_row(GGB, XBB, cwl, (unsigned*)(ws + WS_H) + (size_t)m * 512, (float*)(ws + WS_HSA) + m, m, lane);
        __syncthreads();
    }
    SEAM(14);
    {
    constexpr int pb = 15;
    const float* modL = MOD + (size_t)1 * 2 * 12288;
    if (ON(17) && IN(pb)) {
        pg8::Gemm g{HB, (const bf16_t*)(ws + WS_WOUT1), T, D, D / 2}; pg8::StaticOrder S; S.init(T, D, G, bx);
        pg8::EpiResidI8 E{XR, XR, modL + 2 * D, 12288, (const float*)(ws + WS_HSA), (const float*)(ws + WS_CS0) + 4096 + 6144 + 2 * D};
        pg8::gemm_phase<pg8::EpiResidI8, pg8::StaticOrder, true, true>(lds, g, S, E);
    }
    SEAM(pb);
    if (ON(18) && IN(pb + 1)) {
        LAS float* Gs = (LAS float*)lds; LAS float* Ss = (LAS float*)(lds + 16384);
        fill_mod_lds(Gs, Ss, args.in[7] + (size_t)1 * D, modL, 3, 4, tid);
        __syncthreads();
        for (int m = gw; m < T; m += ngw) { const int b = m >> 14; norm_row_store_h<true, false>(XR + (size_t)m * D, Gs + b * D, Ss + b * D, nullptr, (unsigned*)(ws + WS_HQ) + (size_t)m * 512, (float*)(ws + WS_HSC) + m, lane); }
        __syncthreads();
    }
    SEAM(pb + 1);
    if (ON(19) && IN(pb + 2)) {
        pg8::Gemm g{(const bf16_t*)(ws + WS_HQ), (const bf16_t*)(ws + WS_WQ + (size_t)1 * D * D), T, D, D / 2}; pg8::StaticOrder S; S.init(T, D, G, bx);
        pg8::EpiRawI8 E{GGB, D};
        pg8::gemm_phase<pg8::EpiRawI8, pg8::StaticOrder, true, true>(lds, g, S, E);
    }
    SEAM(pb + 2);
    if (ON(20) && IN(pb + 3)) {
        for (int u = bx; u < T / 128; u += G) peer_select_unit(lds, GGB, (const bf16_t*)(ws + WS_KEYS) + (size_t)1 * 262144, (const float*)(ws + WS_HSC), (int*)(ws + WS_IDX), (float*)(ws + WS_GATE), (unsigned*)(ws + WS_ENT), (unsigned*)(ws + WS_POS), (unsigned*)(ws + WS_SEG), u, tid);
        __syncthreads();
    }
    SEAM(pb + 3);
    if (ON(21) && IN(pb + 4)) {
        for (int un = bx; un < 256; un += G) peer_u_lds(lds, ws + WS_U + (size_t)1 * 16384 * D, ws + WS_HQ, (const unsigned*)(ws + WS_ENT), (const unsigned*)(ws + WS_SEG), (int*)(ws + WS_PART), (G == 256) ? (un >> 3) : (un & 31), (G == 256) ? (un & 7) : (un >> 5), tid);
    }
    SEAM(pb + 4);
    if (ON(21) && IN(pb + 5)) {
        for (int un = bx; un < T / 128; un += G) peer_reduce_unit(lds, (const int*)(ws + WS_IDX), (const float*)(ws + WS_GATE), (const unsigned*)(ws + WS_POS), (const int*)(ws + WS_PART), (const float*)(ws + WS_HSC),
                                                              (const float*)(ws + WS_SCL) + 1 * 16384, (const float*)(ws + WS_SCL) + (2 + 1) * 16384, (unsigned*)(ws + WS_WE), (float*)(ws + WS_WSC), un, tid);
    }
    SEAM(pb + 5);
    if (ON(22) && IN(pb + 6)) {
        for (int sl_ = bx; sl_ < 256; sl_ += G) { const int sl = (G == 256) ? ((sl_ & 7) * 32 + (sl_ >> 3)) : sl_; peer_v_slice(lds, ws + WS_V + (size_t)1 * 16384 * D, (const unsigned*)(ws + WS_WE), (const float*)(ws + WS_WSC), XR, modL + 5 * D, sl, tid); }
    }
    SEAM(pb + 6);
    if (ON(23) && IN(pb + 7)) { for (int m = gw; m < T; m += ngw) norm_row_final_h(XR + (size_t)m * D, args.in[8], args.out + (size_t)m * D, lane); }
    }
#undef IN
#undef SEAM
}

#ifndef MK_PER_PHASE
#define MK_PER_PHASE 0
#endif
extern "C" void kernel_launch(void* const* d_in, const int* in_sizes, int n_in, void* d_out, int out_size, void* d_ws, size_t ws_size, hipStream_t stream) {
    static int grid = 0;
    if (grid == 0) {
        if (n_in != 26 || out_size != T * D || ws_size < WS_END) { fprintf(stderr, "kernel_launch: unexpected shapes (n_in %d, out %d, ws %zu)\n", n_in, out_size, ws_size); grid = -1; return; }
        int dev = 0, cus = 0;
        if (hipGetDevice(&dev) != hipSuccess || hipDeviceGetAttribute(&cus, hipDeviceAttributeMultiprocessorCount, dev) != hipSuccess) { grid = -1; return; }
        if (hipFuncSetAttribute((const void*)fwd_kernel, hipFuncAttributeMaxDynamicSharedMemorySize, LDS_BYTES) != hipSuccess) { fprintf(stderr, "kernel_launch: hipFuncSetAttribute failed\n"); grid = -1; return; }
        int per_cu = 0;
        if (hipOccupancyMaxActiveBlocksPerMultiprocessor(&per_cu, (const void*)fwd_kernel, NTHREADS, LDS_BYTES) != hipSuccess || per_cu < 1) fprintf(stderr, "kernel_launch: occupancy query reports %d\n", per_cu);
        (void)hipGetLastError();
        grid = cus;
    }
    if (grid < 0) return;
    (void)hipMemsetAsync((char*)d_ws + WS_CTL, 0, CTL_BYTES, stream);
    Args a{};
    for (int i = 0; i < 26; ++i) a.in[i] = (const float*)d_in[i];
    a.out = (float*)d_out; a.ws = (unsigned char*)d_ws;
#if MK_PER_PHASE
    for (int p = 0; p < NPHASES; ++p) { a.ph_lo = p; a.ph_hi = p + 1; hipLaunchKernelGGL(fwd_kernel, dim3(grid), dim3(NTHREADS), LDS_BYTES, stream, a); }
#else
    a.ph_lo = 0; a.ph_hi = NPHASES;
    hipLaunchKernelGGL(fwd_kernel, dim3(grid), dim3(NTHREADS), LDS_BYTES, stream, a);
#endif
}
```
